# Optimizing an MI355X kernel written in HIP

```python
import math
import jax
import jax.numpy as jnp
from jax import lax
import numpy as np

D_MODEL = 1024
BATCH = 8
SEQ = 2048
DEPTH = 4

GRID_W = 64
CTX_LEN = 256
N_MIXERS = 4
N_CYCLES = DEPTH // N_MIXERS
Q_BLOCK = 128
ROPE_THETA = 10000.0
NORM_EPS = 1e-6
NEG_INF = -1e30

A_HEADS = 8
A_HEAD_DIM = 64
B_HEADS = 16
B_KV_HEADS = 4
B_HEAD_DIM = 64
B_WINDOW = 128
C_HEADS = 8
C_Q_RANK = 384
C_KV_RANK = 256
C_NOPE_DIM = 128
C_ROPE_DIM = 64
C_V_DIM = 128
D_HEADS = 8
D_KV_HEADS = 4
D_HEAD_DIM = 128
D_FF = 2816
CONV_W = 3

kernel_name = 'hybrid_interleaved_diffusion_trunk'


def rms_norm(x, g):
    xf = x.astype(jnp.float32)
    y = xf * lax.rsqrt(jnp.mean(xf * xf, axis=-1, keepdims=True) + NORM_EPS)
    return (y * g.astype(jnp.float32)).astype(x.dtype)


def modulate(x, g, shift, scale):
    return rms_norm(x, g) * (1.0 + scale) + shift


def axial_rope_tables(n_tokens, rot_dim):
    n_rows = n_tokens // GRID_W
    rows = jnp.repeat(jnp.arange(n_rows, dtype=jnp.float32), GRID_W)
    cols = jnp.tile(jnp.arange(GRID_W, dtype=jnp.float32), n_rows)
    n_freq = rot_dim // 4
    inv_freq = ROPE_THETA ** (-jnp.arange(n_freq, dtype=jnp.float32) / n_freq)
    ang = jnp.concatenate([rows[:, None] * inv_freq, cols[:, None] * inv_freq], axis=-1)
    return jnp.cos(ang), jnp.sin(ang)


def apply_rope(x, cos, sin):
    x1, x2 = jnp.split(x, 2, axis=-1)
    c = cos[:, None, :].astype(x.dtype)
    s = sin[:, None, :].astype(x.dtype)
    return jnp.concatenate([x1 * c - x2 * s, x1 * s + x2 * c], axis=-1)


def sweep_query_blocks(fn, q):
    b, s = q.shape[:2]
    nb = s // Q_BLOCK
    qb = jnp.moveaxis(q.reshape(b, nb, Q_BLOCK, *q.shape[2:]), 1, 0)
    out = lax.map(lambda a: fn(a[0], a[1]), (jnp.arange(nb), qb))
    return jnp.moveaxis(out, 0, 1).reshape(b, s, *out.shape[3:])


def gqa_attend(q, k, v, scale, mask=None, sink=None):
    b, nq, h, dh = q.shape
    hkv = k.shape[2]
    g = h // hkv
    qg = q.reshape(b, nq, hkv, g, dh)
    s = jnp.einsum('bqhgd,bkhd->bhgqk', qg, k).astype(jnp.float32) * scale
    if mask is not None:
        s = jnp.where(mask, s, NEG_INF)
    if sink is None:
        p = jax.nn.softmax(s, axis=-1)
    else:
        sink_col = jnp.broadcast_to(sink.astype(jnp.float32).reshape(1, hkv, g, 1, 1), s.shape[:-1] + (1,))
        p = jax.nn.softmax(jnp.concatenate([s, sink_col], axis=-1), axis=-1)[..., :-1]
    o = jnp.einsum('bhgqk,bkhd->bqhgd', p.astype(v.dtype), v)
    return o.reshape(b, nq, h, v.shape[-1])


def merge_heads(o, w_o):
    return o.reshape(o.shape[0], o.shape[1], -1) @ w_o


def mixer_diff(h_ctx, h_lat, layer_idx, need_ctx, w_qkv, w_o, lq1, lk1, lq2, lk2, subln_g):
    lambda_init = 0.8 - 0.6 * math.exp(-0.3 * layer_idx)
    f32 = jnp.float32
    lam = (jnp.exp(jnp.sum(lq1.astype(f32) * lk1.astype(f32)))
           - jnp.exp(jnp.sum(lq2.astype(f32) * lk2.astype(f32))) + lambda_init)
    scale = A_HEAD_DIM ** -0.5

    def project(h):
        b, s, _ = h.shape
        q, k, v = jnp.split(h @ w_qkv, 3, axis=-1)
        return (q.reshape(b, s, 2 * A_HEADS, A_HEAD_DIM),
                k.reshape(b, s, 2 * A_HEADS, A_HEAD_DIM),
                v.reshape(b, s, A_HEADS, 2 * A_HEAD_DIM))

    def attend(q, k, v):
        s = jnp.einsum('bqhd,bkhd->bhqk', q, k).astype(jnp.float32) * scale
        p = jax.nn.softmax(s, axis=-1)
        p = p.reshape(p.shape[0], A_HEADS, 2, p.shape[2], p.shape[3])
        diff = p[:, :, 0] - lam * p[:, :, 1]
        o = jnp.einsum('bhqk,bkhd->bqhd', diff.astype(v.dtype), v)
        return rms_norm(o, subln_g) * (1.0 - lambda_init)

    qc, kc, vc = project(h_ctx)
    ql, kl, vl = project(h_lat)
    cos, sin = axial_rope_tables(h_lat.shape[1], A_HEAD_DIM)
    ql, kl = apply_rope(ql, cos, sin), apply_rope(kl, cos, sin)
    k_all = jnp.concatenate([kc, kl], axis=1)
    v_all = jnp.concatenate([vc, vl], axis=1)
    ol = sweep_query_blocks(lambda i, qb: attend(qb, k_all, v_all), ql)
    oc = merge_heads(attend(qc, kc, vc), w_o) if need_ctx else None
    return oc, merge_heads(ol, w_o)


def mixer_window(h_ctx, h_lat, need_ctx, w_qkv, w_o, sink):
    nq, nkv = B_HEADS * B_HEAD_DIM, B_KV_HEADS * B_HEAD_DIM
    scale = B_HEAD_DIM ** -0.5

    def project(h):
        b, s, _ = h.shape
        q, k, v = jnp.split(h @ w_qkv, [nq, nq + nkv], axis=-1)
        return (q.reshape(b, s, B_HEADS, B_HEAD_DIM),
                k.reshape(b, s, B_KV_HEADS, B_HEAD_DIM),
                v.reshape(b, s, B_KV_HEADS, B_HEAD_DIM))

    qc, kc, vc = project(h_ctx)
    ql, kl, vl = project(h_lat)
    n_lat = h_lat.shape[1]
    cos, sin = axial_rope_tables(n_lat, B_HEAD_DIM)
    ql, kl = apply_rope(ql, cos, sin), apply_rope(kl, cos, sin)
    pad = ((0, 0), (B_WINDOW, B_WINDOW), (0, 0), (0, 0))
    kl_pad, vl_pad = jnp.pad(kl, pad), jnp.pad(vl, pad)
    span = Q_BLOCK + 2 * B_WINDOW
    ctx_mask = jnp.ones((Q_BLOCK, kc.shape[1]), dtype=bool)

    def block(i, qb):
        start = i * Q_BLOCK
        kw = lax.dynamic_slice_in_dim(kl_pad, start, span, axis=1)
        vw = lax.dynamic_slice_in_dim(vl_pad, start, span, axis=1)
        q_pos = start + jnp.arange(Q_BLOCK)
        k_pos = start - B_WINDOW + jnp.arange(span)
        band = (jnp.abs(q_pos[:, None] - k_pos[None, :]) <= B_WINDOW) & (k_pos >= 0) & (k_pos < n_lat)
        mask = jnp.concatenate([ctx_mask, band], axis=1)
        return gqa_attend(qb, jnp.concatenate([kc, kw], axis=1), jnp.concatenate([vc, vw], axis=1),
                          scale, mask=mask, sink=sink)

    ol = sweep_query_blocks(block, ql)
    oc = merge_heads(gqa_attend(qc, kc, vc, scale, sink=sink), w_o) if need_ctx else None
    return oc, merge_heads(ol, w_o)


def mixer_mla(h_ctx, h_lat, need_ctx, w_down, q_norm_g, kv_norm_g, w_uq, w_ukv, w_o):
    scale = (C_NOPE_DIM + C_ROPE_DIM) ** -0.5

    def project(h, rope):
        b, s, _ = h.shape
        cq, ckv, k_rope = jnp.split(h @ w_down, [C_Q_RANK, C_Q_RANK + C_KV_RANK], axis=-1)
        q = (rms_norm(cq, q_norm_g) @ w_uq).reshape(b, s, C_HEADS, C_NOPE_DIM + C_ROPE_DIM)
        kv = (rms_norm(ckv, kv_norm_g) @ w_ukv).reshape(b, s, C_HEADS, C_NOPE_DIM + C_V_DIM)
        q_nope, q_rope = jnp.split(q, [C_NOPE_DIM], axis=-1)
        k_nope, v = jnp.split(kv, [C_NOPE_DIM], axis=-1)
        k_rope = k_rope[:, :, None, :]
        if rope is not None:
            q_rope = apply_rope(q_rope, *rope)
            k_rope = apply_rope(k_rope, *rope)
        q = jnp.concatenate([q_nope, q_rope], axis=-1)
        k = jnp.concatenate([k_nope, jnp.broadcast_to(k_rope, (b, s, C_HEADS, C_ROPE_DIM))], axis=-1)
        return q, k, v

    qc, kc, vc = project(h_ctx, None)
    ql, kl, vl = project(h_lat, axial_rope_tables(h_lat.shape[1], C_ROPE_DIM))
    k_all = jnp.concatenate([kc, kl], axis=1)
    v_all = jnp.concatenate([vc, vl], axis=1)
    ol = sweep_query_blocks(lambda i, qb: gqa_attend(qb, k_all, v_all, scale), ql)
    oc = merge_heads(gqa_attend(qc, kc, vc, scale), w_o) if need_ctx else None
    return oc, merge_heads(ol, w_o)


def mixer_qknorm(h_ctx, h_lat, need_ctx, w_qkv, q_norm_g, k_norm_g, w_o):
    nq, nkv = D_HEADS * D_HEAD_DIM, D_KV_HEADS * D_HEAD_DIM
    scale = D_HEAD_DIM ** -0.5

    def project(h):
        b, s, _ = h.shape
        q, k, v = jnp.split(h @ w_qkv, [nq, nq + nkv], axis=-1)
        q = rms_norm(q.reshape(b, s, D_HEADS, D_HEAD_DIM), q_norm_g)
        k = rms_norm(k.reshape(b, s, D_KV_HEADS, D_HEAD_DIM), k_norm_g)
        return q, k, v.reshape(b, s, D_KV_HEADS, D_HEAD_DIM)

    qc, kc, vc = project(h_ctx)
    ql, kl, vl = project(h_lat)
    cos, sin = axial_rope_tables(h_lat.shape[1], D_HEAD_DIM)
    ql, kl = apply_rope(ql, cos, sin), apply_rope(kl, cos, sin)
    k_all = jnp.concatenate([kc, kl], axis=1)
    v_all = jnp.concatenate([vc, vl], axis=1)
    ol = sweep_query_blocks(lambda i, qb: gqa_attend(qb, k_all, v_all, scale), ql)
    oc = merge_heads(gqa_attend(qc, kc, vc, scale), w_o) if need_ctx else None
    return oc, merge_heads(ol, w_o)


def conv_ffn(h, w_up, conv_w, conv_b, w_down):
    s = h.shape[1]
    u = h @ w_up
    half = CONV_W // 2
    u_pad = jnp.pad(u, ((0, 0), (half, half), (0, 0)))
    y = conv_b
    for j in range(CONV_W):
        y = y + u_pad[:, j:j + s] * conv_w[j]
    a, g = jnp.split(y, 2, axis=-1)
    return (jax.nn.silu(a) * g) @ w_down


def setup_inputs(seed: int = 0) -> dict:
    key = jax.random.key(seed)
    ks = iter(jax.random.split(key, 40))

    def nrm(shape, scale):
        return jax.random.normal(next(ks), shape, jnp.float32) * scale

    def gain(shape):
        return 1.0 + nrm(shape, 0.02)

    D, L, R = D_MODEL, DEPTH, N_CYCLES
    a_width = 2 * A_HEADS * A_HEAD_DIM
    return {
        'x': nrm((BATCH, SEQ, D), 1.0),
        'c': nrm((BATCH, D), 1.0),
        'ctx': nrm((BATCH, CTX_LEN, D), 1.0),
        'c_ctx': nrm((D,), 1.0),
        'ada_w': nrm((L, D, 6 * D), 0.5 * D ** -0.5),
        'ada_b': nrm((L, 6 * D), 0.01),
        'norm1_g': gain((L, D)),
        'norm2_g': gain((L, D)),
        'ffn_up': nrm((L, D, 2 * D_FF), D ** -0.5),
        'ffn_conv_w': nrm((L, CONV_W, 2 * D_FF), CONV_W ** -0.5),
        'ffn_conv_b': nrm((L, 2 * D_FF), 0.01),
        'ffn_down': nrm((L, D_FF, D), D_FF ** -0.5),
        'a_w_qkv': nrm((R, D, 3 * a_width), D ** -0.5),
        'a_w_o': nrm((R, a_width, D), a_width ** -0.5),
        'a_lambda_q1': nrm((R, A_HEAD_DIM), 0.1),
        'a_lambda_k1': nrm((R, A_HEAD_DIM), 0.1),
        'a_lambda_q2': nrm((R, A_HEAD_DIM), 0.1),
        'a_lambda_k2': nrm((R, A_HEAD_DIM), 0.1),
        'a_subln_g': gain((R, 2 * A_HEAD_DIM)),
        'b_w_qkv': nrm((R, D, (B_HEADS + 2 * B_KV_HEADS) * B_HEAD_DIM), D ** -0.5),
        'b_w_o': nrm((R, B_HEADS * B_HEAD_DIM, D), (B_HEADS * B_HEAD_DIM) ** -0.5),
        'b_sink': nrm((R, B_HEADS), 0.5),
        'c_w_down': nrm((R, D, C_Q_RANK + C_KV_RANK + C_ROPE_DIM), D ** -0.5),
        'c_q_norm_g': gain((R, C_Q_RANK)),
        'c_kv_norm_g': gain((R, C_KV_RANK)),
        'c_w_uq': nrm((R, C_Q_RANK, C_HEADS * (C_NOPE_DIM + C_ROPE_DIM)), C_Q_RANK ** -0.5),
        'c_w_ukv': nrm((R, C_KV_RANK, C_HEADS * (C_NOPE_DIM + C_V_DIM)), C_KV_RANK ** -0.5),
        'c_w_o': nrm((R, C_HEADS * C_V_DIM, D), (C_HEADS * C_V_DIM) ** -0.5),
        'd_w_qkv': nrm((R, D, (D_HEADS + 2 * D_KV_HEADS) * D_HEAD_DIM), D ** -0.5),
        'd_q_norm_g': gain((R, D_HEAD_DIM)),
        'd_k_norm_g': gain((R, D_HEAD_DIM)),
        'd_w_o': nrm((R, D_HEADS * D_HEAD_DIM, D), (D_HEADS * D_HEAD_DIM) ** -0.5),
        'final_g': gain((D,)),
    }


def reference(x, c, ctx, c_ctx, ada_w, ada_b, norm1_g, norm2_g, ffn_up, ffn_conv_w, ffn_conv_b, ffn_down,
              a_w_qkv, a_w_o, a_lambda_q1, a_lambda_k1, a_lambda_q2, a_lambda_k2, a_subln_g,
              b_w_qkv, b_w_o, b_sink,
              c_w_down, c_q_norm_g, c_kv_norm_g, c_w_uq, c_w_ukv, c_w_o,
              d_w_qkv, d_q_norm_g, d_k_norm_g, d_w_o,
              final_g):
    silu_c = jax.nn.silu(c)
    silu_cc = jax.nn.silu(c_ctx)
    for i in range(DEPTH):
        kind, r = i % N_MIXERS, i // N_MIXERS
        need_ctx = i < DEPTH - 1
        mod_l = jnp.split((silu_c @ ada_w[i] + ada_b[i])[:, None, :], 6, axis=-1)
        mod_c = jnp.split(silu_cc @ ada_w[i] + ada_b[i], 6, axis=-1)
        hl = modulate(x, norm1_g[i], mod_l[0], mod_l[1])
        hc = modulate(ctx, norm1_g[i], mod_c[0], mod_c[1])
        if kind == 0:
            oc, ol = mixer_diff(hc, hl, i, need_ctx, a_w_qkv[r], a_w_o[r], a_lambda_q1[r], a_lambda_k1[r],
                                a_lambda_q2[r], a_lambda_k2[r], a_subln_g[r])
        elif kind == 1:
            oc, ol = mixer_window(hc, hl, need_ctx, b_w_qkv[r], b_w_o[r], b_sink[r])
        elif kind == 2:
            oc, ol = mixer_mla(hc, hl, need_ctx, c_w_down[r], c_q_norm_g[r], c_kv_norm_g[r], c_w_uq[r],
                               c_w_ukv[r], c_w_o[r])
        else:
            oc, ol = mixer_qknorm(hc, hl, need_ctx, d_w_qkv[r], d_q_norm_g[r], d_k_norm_g[r], d_w_o[r])
        x = x + mod_l[2] * ol
        x = x + mod_l[5] * conv_ffn(modulate(x, norm2_g[i], mod_l[3], mod_l[4]),
                                    ffn_up[i], ffn_conv_w[i], ffn_conv_b[i], ffn_down[i])
        if need_ctx:
            ctx = ctx + mod_c[2] * oc
            ctx = ctx + mod_c[5] * conv_ffn(modulate(ctx, norm2_g[i], mod_c[3], mod_c[4]),
                                            ffn_up[i], ffn_conv_w[i], ffn_conv_b[i], ffn_down[i])
    return rms_norm(x, final_g)
```

```cpp
#include <hip/hip_runtime.h>
#include <hip/hip_cooperative_groups.h>
#include <cstdio>
#include <cstring>
namespace cg = cooperative_groups;

#ifndef REF_ATTN
#define REF_ATTN 0
#endif
#ifndef MULTI_LAUNCH
#define MULTI_LAUNCH 0
#endif

typedef unsigned short u16;
using bf16x8 = __attribute__((ext_vector_type(8))) short;
using f32x16 = __attribute__((ext_vector_type(16))) float;
using u32x4 = __attribute__((ext_vector_type(4))) unsigned;
using u32x2 = __attribute__((ext_vector_type(2))) unsigned;
using f32x4 = __attribute__((ext_vector_type(4))) float;
using f32x2 = __attribute__((ext_vector_type(2))) float;
#define DI __device__ __forceinline__
DI int threadIdx_x_raw() { return (int)__builtin_amdgcn_workitem_id_x(); }

constexpr int DM = 1024, NBATCH = 8, SEQ = 2048, CTXL = 256, TPB = 2304, T = 18432, DFF = 2816;
constexpr int NTHR = 512;
constexpr int CLD = 260;
constexpr int STAGE_BYTES = 131072;
constexpr int BND_OFF = 128 * CLD * 4;
constexpr int RS_OFF = BND_OFF + 4 * 256 * 4;
constexpr int SMEM_BYTES = RS_OFF + 1024;
constexpr float EPS = 1e-6f;

enum { OP_PRO = 0, OP_NORM1, OP_QKV, OP_MLA_DOWN, OP_MLA_UP, OP_ATTN, OP_OPROJ, OP_NORM2, OP_FFN_UP, OP_FFN_DOWN, OP_FINAL };

struct Job { const float* src; u16* dst; const float* g; int K, N, ld, grp, gstride, off, mode, tile0; };

struct Params {
  const float *x, *c, *ctx, *c_ctx, *ada_w, *ada_b, *norm1_g, *norm2_g, *conv_w, *conv_b;
  const float *a_lq1, *a_lk1, *a_lq2, *a_lk2, *a_subln, *b_sink, *d_qg, *d_kg, *final_g;
  float *out, *Rctx, *MOD, *rope64, *rope128;
  u16 *H, *QK, *Vt, *AO, *T1, *KR, *G;
  unsigned* bar;
  u16 *Wup[4], *Wdn[4], *Wo[4];
  u16 *Wa_qkv, *Wb_qkv, *Wc_d, *Wc_uq, *Wc_uk, *Wc_uv, *Wd_qkv;
  Job jobs[20];
  int njobs, conv_tiles, nprog, ph_lo, ph_hi, pad0;
  int ltile[6];
  int prog[48];
};

DI int tidx() { int t = threadIdx_x_raw(); asm volatile("" : "+v"(t)); return t; }
DI u16 f2bf(float x) { unsigned u = __float_as_uint(x); u += 0x7fffu + ((u >> 16) & 1u); return (u16)(u >> 16); }
DI float bf2f(u16 h) { return __uint_as_float(((unsigned)h) << 16); }
DI float bflo(unsigned w) { return __uint_as_float(w << 16); }
DI float bfhi(unsigned w) { return __uint_as_float(w & 0xffff0000u); }
DI unsigned pack2(float a, float b) { unsigned r; asm("v_cvt_pk_bf16_f32 %0, %1, %2" : "=v"(r) : "v"(a), "v"(b)); return r; }
DI float wave_sum(float v) { for (int o = 32; o; o >>= 1) v += __shfl_xor(v, o); return v; }
DI float wave_max(float v) { for (int o = 32; o; o >>= 1) v = fmaxf(v, __shfl_xor(v, o)); return v; }
DI void swap32(float x, float& lo, float& hi) {
  auto r = __builtin_amdgcn_permlane32_swap(__float_as_uint(x), __float_as_uint(x), false, false);
  lo = __uint_as_float(r[0]); hi = __uint_as_float(r[1]);
}
DI float xmax32(float x) { float a, b; swap32(x, a, b); return fmaxf(a, b); }
DI float xsum32(float x) { float a, b; swap32(x, a, b); return a + b; }
DI float siluf(float v) { return v * __builtin_amdgcn_rcpf(1.f + __expf(-v)); }

DI float* rrow(const Params& p, int t) {
  int b = t / TPB, r = t - b * TPB;
  return r < CTXL ? p.Rctx + (size_t)(b * CTXL + r) * DM : p.out + (size_t)(b * SEQ + r - CTXL) * DM;
}
DI const float* xrow(const Params& p, int t) {
  int b = t / TPB, r = t - b * TPB;
  const float* px = p.x; const float* pc = p.ctx;
  asm volatile("" : "+s"(px), "+s"(pc));
  return r < CTXL ? pc + (size_t)(b * CTXL + r) * DM : px + (size_t)(b * SEQ + r - CTXL) * DM;
}
DI int modrow(int t) { int b = t / TPB, r = t - b * TPB; return r < CTXL ? 8 : b; }
DI int lat_token(int li) { int b = li >> 11; return b * TPB + CTXL + (li & 2047); }

struct CvT { const float* src; u16* dst; const float* g; int ld, K, k0, n0, col; bool ok, okcol; };
DI CvT cv_decode(const Params& p, int tile, bool ok, int t) {
  CvT c;
  int jb = 0;
  for (int q = 1; q < p.njobs; ++q) if (tile >= p.jobs[q].tile0) jb = q;
  const Job& j = p.jobs[jb];
  const int tl = tile - j.tile0;
  const int ntn = j.N >> 6;
  const int kt = tl / ntn, nt = tl - kt * ntn;
  c.k0 = kt * 64; c.n0 = nt * 64;
  const int n = c.n0 + (t & 63);
  c.okcol = true;
  if (j.mode == 1) c.col = (n >> 8) * 128 + (n & 127) + ((n >> 7) & 1) * DFF;
  else if (j.mode == 2) { c.col = n; c.okcol = n < 704; }
  else c.col = (n / j.grp) * j.gstride + (n % j.grp) + j.off;
  c.src = j.src; c.dst = j.dst; c.g = j.g; c.ld = j.ld; c.K = j.K; c.ok = ok;
  return c;
}
DI void convert_tiles(const Params& p, int tile0, int ntiles, char* smem) {
  const int tid = tidx();
  const int half = tid >> 8, t = tid & 255;
  const int nl = t & 63, kk = t >> 6;
  const int tA = tile0 + half * 2, tB = tA + 1;
  const CvT ca = cv_decode(p, tA < ntiles ? tA : 0, tA < ntiles, t), cb = cv_decode(p, tB < ntiles ? tB : 0, tB < ntiles, t);
  float* stA = (float*)smem + (half * 2) * (64 * 65); float* stB = stA + 64 * 65;
  float va[16], vb[16];
#pragma unroll
  for (int i = 0; i < 16; ++i) va[i] = (ca.ok && ca.okcol) ? ca.src[(size_t)(ca.k0 + kk + 4 * i) * ca.ld + ca.col] : 0.f;
#pragma unroll
  for (int i = 0; i < 16; ++i) vb[i] = (cb.ok && cb.okcol) ? cb.src[(size_t)(cb.k0 + kk + 4 * i) * cb.ld + cb.col] : 0.f;
#pragma unroll
  for (int i = 0; i < 16; ++i) {
    const int kl = kk + 4 * i;
    float x = va[i]; if (ca.g) x *= ca.g[ca.k0 + kl];
    stA[kl * 65 + nl] = x;
    float y = vb[i]; if (cb.g) y *= cb.g[cb.k0 + kl];
    stB[kl * 65 + nl] = y;
  }
  __syncthreads();
  {
    const int n2 = t >> 2, kc = t & 3;
    if (ca.ok) {
      unsigned w[8];
#pragma unroll
      for (int i = 0; i < 8; ++i) w[i] = pack2(stA[(kc * 16 + 2 * i) * 65 + n2], stA[(kc * 16 + 2 * i + 1) * 65 + n2]);
      u32x4* d = (u32x4*)(ca.dst + (size_t)(ca.n0 + n2) * ca.K + ca.k0 + kc * 16);
      d[0] = u32x4{w[0], w[1], w[2], w[3]}; d[1] = u32x4{w[4], w[5], w[6], w[7]};
    }
    if (cb.ok) {
      unsigned w[8];
#pragma unroll
      for (int i = 0; i < 8; ++i) w[i] = pack2(stB[(kc * 16 + 2 * i) * 65 + n2], stB[(kc * 16 + 2 * i + 1) * 65 + n2]);
      u32x4* d = (u32x4*)(cb.dst + (size_t)(cb.n0 + n2) * cb.K + cb.k0 + kc * 16);
      d[0] = u32x4{w[0], w[1], w[2], w[3]}; d[1] = u32x4{w[4], w[5], w[6], w[7]};
    }
  }
  __syncthreads();
}

DI void mod_item2(const Params& p, int item, bool ok_item, char* smem) {
  float* ss = (float*)smem;
  const int tid = tidx();
  const int half = tid >> 8, t = tid & 255;
  float* red = ss + 9 * 1024 + half * (4 * 576);
  const int layer = item / 96, n0 = (item % 96) * 64;
  for (int i = tid; i < 9 * 1024; i += NTHR) {
    int r = i >> 10, k = i & 1023;
    float v = r < 8 ? p.c[r * 1024 + k] : p.c_ctx[k];
    ss[i] = siluf(v);
  }
  __syncthreads();
  const int cq = t & 15, kg = t >> 4;
  f32x4 acc[9];
#pragma unroll
  for (int r = 0; r < 9; ++r) acc[r] = f32x4{0.f, 0.f, 0.f, 0.f};
  if (ok_item) {
    const float* w = p.ada_w + (size_t)layer * 1024 * 6144 + n0 + cq * 4 + (size_t)(kg * 64) * 6144;
#pragma unroll 1
    for (int kb = 0; kb < 64; kb += 8) {
      f32x4 wv[8];
#pragma unroll
      for (int u = 0; u < 8; ++u) wv[u] = *(const f32x4*)(w + (size_t)(kb + u) * 6144);
#pragma unroll
      for (int u = 0; u < 8; ++u) {
        const int k = kg * 64 + kb + u;
#pragma unroll
        for (int r = 0; r < 9; ++r) acc[r] += ss[r * 1024 + k] * wv[u];
      }
    }
  }
#pragma unroll
  for (int r = 0; r < 9; ++r)
#pragma unroll
    for (int e = 0; e < 4; ++e) {
      float x = acc[r][e];
      x += __shfl_xor(x, 16); x += __shfl_xor(x, 32);
      acc[r][e] = x;
    }
  const int wv4 = t >> 6, lane = t & 63;
  if (lane < 16) {
#pragma unroll
    for (int r = 0; r < 9; ++r) *(f32x4*)(red + (wv4 * 9 + r) * 64 + lane * 4) = acc[r];
  }
  __syncthreads();
  if (ok_item) {
    for (int i = t; i < 576; i += 256) {
      int c = i & 63;
      float v = red[i] + red[576 + i] + red[1152 + i] + red[1728 + i] + p.ada_b[layer * 6144 + n0 + c];
      p.MOD[((size_t)layer * 9 + (i >> 6)) * 6144 + n0 + c] = v;
    }
  }
  __syncthreads();
}

DI void sincos_acc(float ang, float& c, float& s) {
  float k = rintf(ang * 0.15915494309189535f);
  float x = fmaf(-k, 6.28318548202514648f, ang);
  x = fmaf(-k, -1.7484555e-7f, x);
  c = __cosf(x); s = __sinf(x);
}

DI void rope_item(const Params& p, int item) {
  int e = item * NTHR + tidx();
  if (e < 65536) {
    int pos = e >> 5, i = e & 31;
    int f = i & 15; float posv = (i < 16) ? (float)(pos >> 6) : (float)(pos & 63);
    float inv = exp2f(-(float)f / 16.f * 13.287712379549449f);
    float c, s; sincos_acc(posv * inv, c, s);
    p.rope64[e] = c; p.rope64[65536 + e] = s;
  } else {
    e -= 65536;
    int pos = e >> 6, i = e & 63;
    int f = i & 31; float posv = (i < 32) ? (float)(pos >> 6) : (float)(pos & 63);
    float inv = exp2f(-(float)f / 32.f * 13.287712379549449f);
    float c, s; sincos_acc(posv * inv, c, s);
    p.rope128[e] = c; p.rope128[131072 + e] = s;
  }
}

DI void prologue(const Params& p, char* smem) {
  const int n_mod2 = 48, n_rope = 384;
  const int G = gridDim.x;
#pragma unroll 1
  for (int i = blockIdx.x; i < n_mod2; i += G) mod_item2(p, 2 * i + (tidx() >> 8), true, smem);
  const int nconv0 = p.ltile[1];
  const int nct2 = (nconv0 + 3) >> 2;
  int start = (blockIdx.x + G - (n_mod2 % G)) % G;
#pragma unroll 1
  for (int i = start; i < nct2; i += G) convert_tiles(p, 4 * i, nconv0, smem);
#pragma unroll 1
  for (int i = blockIdx.x; i < n_rope; i += G) rope_item(p, i);
}

DI void norm_phase(const Params& p, int layer, int which  , bool lat_only) {
  const int lane = tidx() & 63, wave = tidx() >> 6;
  const int nrows = lat_only ? NBATCH * SEQ : T;
  const float* g = (which ? p.norm2_g : p.norm1_g) + layer * DM;
#pragma unroll 1
  for (int it = blockIdx.x; it * 16 < nrows; it += gridDim.x) {
    f32x4 v[2][4];
    int tt[2];
#pragma unroll
    for (int u = 0; u < 2; ++u) {
      int ri = it * 16 + wave * 2 + u;
      tt[u] = lat_only ? lat_token(ri) : ri;
      const float* xr = (layer == 0 && which == 0) ? xrow(p, tt[u]) : (const float*)rrow(p, tt[u]);
#pragma unroll
      for (int q = 0; q < 2; ++q) {
        v[u][2 * q] = *(const f32x4*)(xr + q * 512 + lane * 8);
        v[u][2 * q + 1] = *(const f32x4*)(xr + q * 512 + lane * 8 + 4);
      }
    }
#pragma unroll
    for (int u = 0; u < 2; ++u) {
      const int t = tt[u];
      const float* md = p.MOD + ((size_t)layer * 9 + modrow(t)) * 6144 + which * 3072;
      float ss = 0;
#pragma unroll
      for (int q = 0; q < 4; ++q) ss += v[u][q][0] * v[u][q][0] + v[u][q][1] * v[u][q][1] + v[u][q][2] * v[u][q][2] + v[u][q][3] * v[u][q][3];
      ss = wave_sum(ss);
      const float rstd = rsqrtf(ss * (1.f / DM) + EPS);
#pragma unroll
      for (int q = 0; q < 2; ++q) {
        const int cidx = q * 512 + lane * 8;
        unsigned w[4];
#pragma unroll
        for (int e = 0; e < 2; ++e) {
          const f32x4 gg = *(const f32x4*)(g + cidx + 4 * e);
          const f32x4 sh = *(const f32x4*)(md + cidx + 4 * e);
          const f32x4 sc = *(const f32x4*)(md + 1024 + cidx + 4 * e);
          const f32x4 y = v[u][2 * q + e] * rstd * gg * (sc + 1.f) + sh;
          w[2 * e] = pack2(y[0], y[1]); w[2 * e + 1] = pack2(y[2], y[3]);
        }
        *(u32x4*)(p.H + (size_t)t * DM + cidx) = u32x4{w[0], w[1], w[2], w[3]};
      }
    }
  }
}

DI void final_phase(const Params& p) {
  const int lane = tidx() & 63, wave = tidx() >> 6;
#pragma unroll 1
  for (int it = blockIdx.x; it * 8 < NBATCH * SEQ; it += gridDim.x) {
    int ri = it * 8 + wave;
    float* xr = p.out + (size_t)ri * DM;
    float4 v[4]; float ss = 0;
#pragma unroll
    for (int q = 0; q < 4; ++q) {
      v[q] = *(const float4*)(xr + q * 256 + lane * 4);
      ss += v[q].x * v[q].x + v[q].y * v[q].y + v[q].z * v[q].z + v[q].w * v[q].w;
    }
    ss = wave_sum(ss);
    float rstd = rsqrtf(ss * (1.f / DM) + EPS);
#pragma unroll
    for (int q = 0; q < 4; ++q) {
      int cidx = q * 256 + lane * 4;
      float4 gg = *(const float4*)(p.final_g + cidx);
      float4 o = {v[q].x * rstd * gg.x, v[q].y * rstd * gg.y, v[q].z * rstd * gg.z, v[q].w * rstd * gg.w};
      *(float4*)(xr + cidx) = o;
    }
  }
}

DI int swz128(int row, int chunk) { return row * 128 + ((chunk ^ ((row >> 1) & 7)) << 4); }


DI void mma_ktile(f32x16 (&acc)[4][2], unsigned a0, unsigned a1, unsigned a2, unsigned a3, unsigned b0, unsigned b1, unsigned b2, unsigned b3) {
  u32x4 f0, f1, f2, f3, f4, f5, f6, f7, f8, f9;
  asm volatile(
      "ds_read_b128 %8, %18 offset:0\n\t"
      "ds_read_b128 %9, %18 offset:4096\n\t"
      "ds_read_b128 %10, %18 offset:8192\n\t"
      "ds_read_b128 %11, %18 offset:12288\n\t"
      "ds_read_b128 %16, %22 offset:0\n\t"
      "ds_read_b128 %17, %22 offset:4096\n\t"
      "ds_read_b128 %12, %19 offset:0\n\t"
      "ds_read_b128 %13, %19 offset:4096\n\t"
      "ds_read_b128 %14, %19 offset:8192\n\t"
      "ds_read_b128 %15, %19 offset:12288\n\t"
      "s_waitcnt lgkmcnt(4)\n\t"
      "v_mfma_f32_32x32x16_bf16 %0, %8, %16, %0\n\t"
      "v_mfma_f32_32x32x16_bf16 %2, %9, %16, %2\n\t"
      "v_mfma_f32_32x32x16_bf16 %4, %10, %16, %4\n\t"
      "v_mfma_f32_32x32x16_bf16 %6, %11, %16, %6\n\t"
      "ds_read_b128 %16, %23 offset:0\n\t"
      "v_mfma_f32_32x32x16_bf16 %1, %8, %17, %1\n\t"
      "v_mfma_f32_32x32x16_bf16 %3, %9, %17, %3\n\t"
      "v_mfma_f32_32x32x16_bf16 %5, %10, %17, %5\n\t"
      "v_mfma_f32_32x32x16_bf16 %7, %11, %17, %7\n\t"
      "ds_read_b128 %17, %23 offset:4096\n\t"
      "ds_read_b128 %8, %20 offset:0\n\t"
      "ds_read_b128 %9, %20 offset:4096\n\t"
      "ds_read_b128 %10, %20 offset:8192\n\t"
      "ds_read_b128 %11, %20 offset:12288\n\t"
      "s_waitcnt lgkmcnt(5)\n\t"
      "v_mfma_f32_32x32x16_bf16 %0, %12, %16, %0\n\t"
      "v_mfma_f32_32x32x16_bf16 %2, %13, %16, %2\n\t"
      "v_mfma_f32_32x32x16_bf16 %4, %14, %16, %4\n\t"
      "v_mfma_f32_32x32x16_bf16 %6, %15, %16, %6\n\t"
      "ds_read_b128 %16, %24 offset:0\n\t"
      "s_waitcnt lgkmcnt(5)\n\t"
      "v_mfma_f32_32x32x16_bf16 %1, %12, %17, %1\n\t"
      "v_mfma_f32_32x32x16_bf16 %3, %13, %17, %3\n\t"
      "v_mfma_f32_32x32x16_bf16 %5, %14, %17, %5\n\t"
      "v_mfma_f32_32x32x16_bf16 %7, %15, %17, %7\n\t"
      "ds_read_b128 %17, %24 offset:4096\n\t"
      "ds_read_b128 %12, %21 offset:0\n\t"
      "ds_read_b128 %13, %21 offset:4096\n\t"
      "ds_read_b128 %14, %21 offset:8192\n\t"
      "ds_read_b128 %15, %21 offset:12288\n\t"
      "s_waitcnt lgkmcnt(5)\n\t"
      "v_mfma_f32_32x32x16_bf16 %0, %8, %16, %0\n\t"
      "v_mfma_f32_32x32x16_bf16 %2, %9, %16, %2\n\t"
      "v_mfma_f32_32x32x16_bf16 %4, %10, %16, %4\n\t"
      "v_mfma_f32_32x32x16_bf16 %6, %11, %16, %6\n\t"
      "ds_read_b128 %16, %25 offset:0\n\t"
      "s_waitcnt lgkmcnt(5)\n\t"
      "v_mfma_f32_32x32x16_bf16 %1, %8, %17, %1\n\t"
      "v_mfma_f32_32x32x16_bf16 %3, %9, %17, %3\n\t"
      "v_mfma_f32_32x32x16_bf16 %5, %10, %17, %5\n\t"
      "v_mfma_f32_32x32x16_bf16 %7, %11, %17, %7\n\t"
      "ds_read_b128 %17, %25 offset:4096\n\t"
      "s_waitcnt lgkmcnt(1)\n\t"
      "v_mfma_f32_32x32x16_bf16 %0, %12, %16, %0\n\t"
      "v_mfma_f32_32x32x16_bf16 %2, %13, %16, %2\n\t"
      "v_mfma_f32_32x32x16_bf16 %4, %14, %16, %4\n\t"
      "v_mfma_f32_32x32x16_bf16 %6, %15, %16, %6\n\t"
      "s_waitcnt lgkmcnt(0)\n\t"
      "v_mfma_f32_32x32x16_bf16 %1, %12, %17, %1\n\t"
      "v_mfma_f32_32x32x16_bf16 %3, %13, %17, %3\n\t"
      "v_mfma_f32_32x32x16_bf16 %5, %14, %17, %5\n\t"
      "v_mfma_f32_32x32x16_bf16 %7, %15, %17, %7\n\t"
      "s_nop 15\n\t"
      "s_nop 7\n\t"
      : "+v"(acc[0][0]), "+v"(acc[0][1]), "+v"(acc[1][0]), "+v"(acc[1][1]), "+v"(acc[2][0]), "+v"(acc[2][1]), "+v"(acc[3][0]), "+v"(acc[3][1]),
        "=&v"(f0), "=&v"(f1), "=&v"(f2), "=&v"(f3), "=&v"(f4), "=&v"(f5), "=&v"(f6), "=&v"(f7), "=&v"(f8), "=&v"(f9)
      : "v"(a0), "v"(a1), "v"(a2), "v"(a3), "v"(b0), "v"(b1), "v"(b2), "v"(b3)
      : "memory");
}

struct NoPre { DI void operator()() const {} };
struct NextTile { const u16* Ap; const u16* Bp; int vlo, vhi; };
template <bool BND, class Epi, class Pre = NoPre>
DI void gemm_tile(const u16* __restrict__ Ap, int lda, int vlo, int vhi, const u16* __restrict__ Bp, int ldb, int K,
                  char* smem, NextTile nx, Epi&& epi, Pre&& pre = Pre()) {
  const int tid = tidx(), lane = tid & 63, wave = tid >> 6;
  const int wm = wave >> 2, wn = wave & 3;
  const int lr = tid >> 3, lc = tid & 7;
  f32x16 acc[4][2];
#pragma unroll
  for (int i = 0; i < 4; ++i)
#pragma unroll
    for (int j = 0; j < 2; ++j)
#pragma unroll
      for (int r = 0; r < 16; ++r) acc[i][j][r] = 0.f;
  u32x4 ra[4], rb[4];
  const unsigned offA = (unsigned)(lr * lda + lc * 8) * 2u, offB = (unsigned)(lr * ldb + lc * 8) * 2u;
  const unsigned strA = (unsigned)lda * 128u, strB = (unsigned)ldb * 128u;
  auto gload = [&](int k0) {
    const char* Ak = (const char*)Ap + (long)k0 * 2;
    const char* Bk = (const char*)Bp + (long)k0 * 2;
#pragma unroll
    for (int i = 0; i < 4; ++i) {
      int row = lr + 64 * i;
      u32x4 z = {0u, 0u, 0u, 0u};
      if (row >= vlo && row < vhi) z = *(const u32x4*)(Ak + (offA + (unsigned)i * strA));
      ra[i] = z;
      rb[i] = *(const u32x4*)(Bk + (offB + (unsigned)i * strB));
    }
  };
  auto sstore = [&](int buf) {
    char* sA = smem + buf * 65536; char* sB = sA + 32768;
#pragma unroll
    for (int i = 0; i < 4; ++i) {
      int row = lr + 64 * i;
      *(u32x4*)(sA + swz128(row, lc)) = ra[i];
      *(u32x4*)(sB + swz128(row, lc)) = rb[i];
    }
  };
  const int nk = K >> 6;
  const int half = wave >> 2;
  const unsigned lds0 = (unsigned)(size_t)smem;
  const unsigned offl = (unsigned)((lane & 31) * 128);
  const unsigned fx = (unsigned)((lane >> 1) & 7), hh = (unsigned)(lane >> 5);
  const unsigned aw = lds0 + (unsigned)(wm * 128 * 128) + offl, bw = lds0 + 32768u + (unsigned)(wn * 64 * 128) + offl;
  const unsigned o0 = ((0u + hh) ^ fx) << 4, o1 = ((2u + hh) ^ fx) << 4, o2 = ((4u + hh) ^ fx) << 4, o3 = ((6u + hh) ^ fx) << 4;
  auto compute = [&](int buf) {
    const unsigned bo = (unsigned)buf * 65536u;
    mma_ktile(acc, aw + bo + o0, aw + bo + o1, aw + bo + o2, aw + bo + o3, bw + bo + o0, bw + bo + o1, bw + bo + o2, bw + bo + o3);
  };
  gload(0); sstore(0);
  if (nk > 1) gload(64);
  __syncthreads();
#pragma unroll 1
  for (int it = 0; it < nk; ++it) {
    if (half == 0) compute(it & 1);
    else { if (it + 1 < nk) sstore((it + 1) & 1); if (it + 2 < nk) gload((it + 2) * 64); }
    __syncthreads();
    if (half == 1) compute(it & 1);
    else { if (it + 1 < nk) sstore((it + 1) & 1); if (it + 2 < nk) gload((it + 2) * 64); }
    __syncthreads();
  }
  float* sC = (float*)smem;
  const int h = lane >> 5;
  unsigned pf0 = 0u;
  if (nx.Ap != nullptr) {
    const int prow_ = tid & 255;
    const bool isb = tid >= 256;
    const char* pp = isb ? (const char*)(nx.Bp + (long)prow_ * ldb) : (const char*)(nx.Ap + (long)prow_ * lda);
    if (isb || (prow_ >= nx.vlo && prow_ < nx.vhi)) {
      asm volatile("global_load_dword %0, %1, off\n\tglobal_load_dword %0, %1, off offset:128" : "=&v"(pf0) : "v"(pp) : "memory");
    }
  }
  pre();
  if (BND) {
    float* bnd = (float*)(smem + BND_OFF);
#pragma unroll
    for (int j = 0; j < 2; ++j) {
      const int col = wn * 64 + j * 32 + (lane & 31);
      if (h == 0) bnd[(2 * wm) * 256 + col] = acc[0][j][0];
      else bnd[(2 * wm + 1) * 256 + col] = acc[3][j][15];
    }
  }
#pragma unroll
  for (int q = 0; q < 2; ++q) {
    if (wm == q) {
#pragma unroll
      for (int i = 0; i < 4; ++i)
#pragma unroll
        for (int j = 0; j < 2; ++j)
#pragma unroll
          for (int r = 0; r < 16; ++r) {
            int rl = i * 32 + (r & 3) + 8 * (r >> 2) + 4 * h;
            int col = wn * 64 + j * 32 + (lane & 31);
            sC[rl * CLD + col] = acc[i][j][r];
          }
    }
    __syncthreads();
    epi(sC, q);
    __syncthreads();
  }
  asm volatile("s_waitcnt vmcnt(0)" :: "v"(pf0) : "memory");
}

DI void epi_store(const float* sC, int q, u16* dst, long ldd, const float* rowscale  , f32x4 cs) {
  const int lane = tidx() & 63, wave = tidx() >> 6;
#pragma unroll
  for (int rr = 0; rr < 16; ++rr) {
    const int lr = wave * 16 + rr, R = q * 128 + lr;
    f32x4 v = *(const f32x4*)(sC + lr * CLD + lane * 4);
    const float rs = rowscale ? rowscale[R] : 1.f;
    v = v * rs * cs;
    *(u32x2*)(dst + R * ldd + lane * 4) = u32x2{pack2(v[0], v[1]), pack2(v[2], v[3])};
  }
}

DI void epi_rope64(const Params& p, const float* sC, int q, u16* dst, long ldd, int tok0, int ropemask, const float* rowscale) {
  const int lane = tidx() & 63, wave = tidx() >> 6;
  const int g = lane >> 4, j = lane & 15;
  const int c1 = g * 64 + 2 * j, c2 = c1 + 32;
  const int r0 = tok0 % TPB;
  const bool rot = (r0 >= CTXL) && ((ropemask >> g) & 1);
#pragma unroll
  for (int hb = 0; hb < 2; ++hb) {
    float2 cs[8], sn[8];
    if (rot) {
#pragma unroll
      for (int rr = 0; rr < 8; ++rr) {
        const int pos = r0 - CTXL + q * 128 + wave * 16 + hb * 8 + rr;
        cs[rr] = *(const float2*)(p.rope64 + pos * 32 + 2 * j);
        sn[rr] = *(const float2*)(p.rope64 + 65536 + pos * 32 + 2 * j);
      }
    }
#pragma unroll
    for (int rr = 0; rr < 8; ++rr) {
      const int lr = wave * 16 + hb * 8 + rr, R = q * 128 + lr;
      const float rs = rowscale ? rowscale[R] : 1.f;
      float2 x1 = *(const float2*)(sC + lr * CLD + c1), x2 = *(const float2*)(sC + lr * CLD + c2);
      x1.x *= rs; x1.y *= rs; x2.x *= rs; x2.y *= rs;
      if (rot) {
        float a0 = x1.x * cs[rr].x - x2.x * sn[rr].x, a1 = x1.y * cs[rr].y - x2.y * sn[rr].y;
        float b0 = x1.x * sn[rr].x + x2.x * cs[rr].x, b1 = x1.y * sn[rr].y + x2.y * cs[rr].y;
        x1.x = a0; x1.y = a1; x2.x = b0; x2.y = b1;
      }
      *(unsigned*)(dst + R * ldd + c1) = pack2(x1.x, x1.y);
      *(unsigned*)(dst + R * ldd + c2) = pack2(x2.x, x2.y);
    }
  }
}

DI void epi_qknorm128(const Params& p, const float* sC, int q, u16* dst, long ldd, int tok0, const float* gvec) {
  const int lane = tidx() & 63, wave = tidx() >> 6;
  const int hd = lane >> 5, j = lane & 31;
  const int c1 = hd * 128 + 2 * j, c2 = c1 + 64;
  const int r0 = tok0 % TPB;
  const bool lat = r0 >= CTXL;
  const float2 g1 = *(const float2*)(gvec + 2 * j), g2 = *(const float2*)(gvec + 64 + 2 * j);
#pragma unroll
  for (int hb = 0; hb < 2; ++hb) {
    float2 cs[8], sn[8];
    if (lat) {
#pragma unroll
      for (int rr = 0; rr < 8; ++rr) {
        const int pos = r0 - CTXL + q * 128 + wave * 16 + hb * 8 + rr;
        cs[rr] = *(const float2*)(p.rope128 + pos * 64 + 2 * j);
        sn[rr] = *(const float2*)(p.rope128 + 131072 + pos * 64 + 2 * j);
      }
    }
#pragma unroll
    for (int rr = 0; rr < 8; ++rr) {
      const int lr = wave * 16 + hb * 8 + rr, R = q * 128 + lr;
      float2 x1 = *(const float2*)(sC + lr * CLD + c1), x2 = *(const float2*)(sC + lr * CLD + c2);
      float ss = x1.x * x1.x + x1.y * x1.y + x2.x * x2.x + x2.y * x2.y;
      ss += __shfl_xor(ss, 1); ss += __shfl_xor(ss, 2); ss += __shfl_xor(ss, 4); ss += __shfl_xor(ss, 8); ss += __shfl_xor(ss, 16);
      const float rstd = rsqrtf(ss * (1.f / 128.f) + EPS);
      x1.x *= rstd * g1.x; x1.y *= rstd * g1.y; x2.x *= rstd * g2.x; x2.y *= rstd * g2.y;
      if (lat) {
        float a0 = x1.x * cs[rr].x - x2.x * sn[rr].x, a1 = x1.y * cs[rr].y - x2.y * sn[rr].y;
        float b0 = x1.x * sn[rr].x + x2.x * cs[rr].x, b1 = x1.y * sn[rr].y + x2.y * cs[rr].y;
        x1.x = a0; x1.y = a1; x2.x = b0; x2.y = b1;
      }
      *(unsigned*)(dst + R * ldd + c1) = pack2(x1.x, x1.y);
      *(unsigned*)(dst + R * ldd + c2) = pack2(x2.x, x2.y);
    }
  }
}

DI void resid_load(const float* Rsrc, int q, int col0, f32x4 (&rv)[16]) {
  const int lane = tidx() & 63, wave = tidx() >> 6;
  const float* R = Rsrc + col0 + lane * 4 + (size_t)(q * 128 + wave * 16) * DM;
#pragma unroll
  for (int rr = 0; rr < 16; ++rr) rv[rr] = *(const f32x4*)(R + (size_t)rr * DM);
}
DI void epi_resid(const Params& p, const float* Rsrc, const float* sC, int q, int tok0, int col0, f32x4 g, f32x4 (&rv)[16]) {
  const int lane = tidx() & 63, wave = tidx() >> 6;
  float* R = rrow(p, tok0) + col0 + lane * 4 + (size_t)(q * 128 + wave * 16) * DM;
#pragma unroll
  for (int rr = 0; rr < 16; ++rr) {
    const f32x4 c = *(const f32x4*)(sC + (wave * 16 + rr) * CLD + lane * 4);
    *(f32x4*)(R + (size_t)rr * DM) = rv[rr] + g * c;
  }
  if (q < 1) resid_load(Rsrc, q + 1, col0, rv);
}

struct ConvW { float2 wa0, wa1, wa2, ba, wg0, wg1, wg2, bg; };
DI void conv_load(const Params& p, int layer, int nt, ConvW& w) {
  const int lane = tidx() & 63;
  const int j0 = nt * 128;
  const float* cw = p.conv_w + (size_t)layer * 3 * 5632;
  const float* cb = p.conv_b + (size_t)layer * 5632;
  const int ca = j0 + 2 * lane, cg_ = DFF + j0 + 2 * lane;
  w.wa0 = *(const float2*)(cw + ca); w.wa1 = *(const float2*)(cw + 5632 + ca); w.wa2 = *(const float2*)(cw + 2 * 5632 + ca); w.ba = *(const float2*)(cb + ca);
  w.wg0 = *(const float2*)(cw + cg_); w.wg1 = *(const float2*)(cw + 5632 + cg_); w.wg2 = *(const float2*)(cw + 2 * 5632 + cg_); w.bg = *(const float2*)(cb + cg_);
}
DI void epi_convgate(const Params& p, const float* sC, const float* bnd, int q, int tokbase, int pos0, int L, int seam, int nt, const ConvW& w) {
  const int lane = tidx() & 63, wave = tidx() >> 6;
  const int j0 = nt * 128;
  const float2 wa0 = w.wa0, wa1 = w.wa1, wa2 = w.wa2, ba = w.ba, wg0 = w.wg0, wg1 = w.wg1, wg2 = w.wg2, bg = w.bg;
#pragma unroll 1
  for (int hb = 0; hb < 2; ++hb) {
    const int lr0 = wave * 16 + hb * 8;
    float2 va[10], vg[10];
#pragma unroll
    for (int k = 0; k < 10; ++k) {
      const int lrk = lr0 - 1 + k;
      const float* rowp = lrk < 0 ? bnd + (2 * q - 1) * 256 : (lrk > 127 ? bnd + (2 * q + 2) * 256 : sC + lrk * CLD);
      va[k] = *(const float2*)(rowp + 2 * lane); vg[k] = *(const float2*)(rowp + 128 + 2 * lane);
    }
#pragma unroll
    for (int k = 0; k < 8; ++k) {
      const int R = q * 128 + lr0 + k;
      const int pos = pos0 + R;
      if (R == 0 || R == 255 || pos >= L) continue;
      f32x2 pa = {va[k].x, va[k].y}, pg = {vg[k].x, vg[k].y}, na = {va[k + 2].x, va[k + 2].y}, ng = {vg[k + 2].x, vg[k + 2].y};
      const f32x2 ca2 = {va[k + 1].x, va[k + 1].y}, cg2 = {vg[k + 1].x, vg[k + 1].y};
      if (pos == seam) { pa = f32x2{0.f, 0.f}; pg = f32x2{0.f, 0.f}; }
      if (pos + 1 == seam) { na = f32x2{0.f, 0.f}; ng = f32x2{0.f, 0.f}; }
      const f32x2 ya = f32x2{ba.x, ba.y} + f32x2{wa0.x, wa0.y} * pa + f32x2{wa1.x, wa1.y} * ca2 + f32x2{wa2.x, wa2.y} * na;
      const f32x2 yg = f32x2{bg.x, bg.y} + f32x2{wg0.x, wg0.y} * pg + f32x2{wg1.x, wg1.y} * cg2 + f32x2{wg2.x, wg2.y} * ng;
      const float ya0 = ya[0], ya1 = ya[1], yg0 = yg[0], yg1 = yg[1];
      *(unsigned*)(p.G + (size_t)(tokbase + pos) * DFF + j0 + 2 * lane) = pack2(siluf(ya0) * yg0, siluf(ya1) * yg1);
    }
  }
}

DI void tile_rstd(const Params& p, int tok0, int c0, int len, float* rs) {
  const int tid = tidx();
  const int row = tid >> 1, part = tid & 1;
  const u16* tp = p.T1 + (size_t)(tok0 + row) * 768 + c0 + part * (len >> 1);
  float ss = 0;
#pragma unroll 8
  for (int c = 0; c < (len >> 4); ++c) {
    u32x4 v = *(const u32x4*)(tp + c * 8);
#pragma unroll
    for (int j = 0; j < 4; ++j) { float a = bflo(v[j]), b = bfhi(v[j]); ss += a * a + b * b; }
  }
  ss += __shfl_xor(ss, 1);
  if (!part) rs[row] = rsqrtf(ss / (float)len + EPS);
}

DI bool xcd_tile(int round, int Mx, int NT, int GM, int& mt, int& nt) {
  const int xcd = blockIdx.x & 7, slot = blockIdx.x >> 3;
  int per = gridDim.x >> 3;
  const int j = round * per + slot;
  if (slot >= per || j >= Mx * NT) return false;
  int gsz = __builtin_amdgcn_readfirstlane(GM * NT);
  asm volatile("" : "+s"(gsz));
  const int g = j / gsz, w = j - g * gsz;
  int gm = Mx - g * GM; if (gm > GM) gm = GM;
  gm = __builtin_amdgcn_readfirstlane(gm);
  asm volatile("" : "+s"(gm));
  const int q = w / gm;
  mt = xcd * Mx + g * GM + (w - q * gm); nt = q;
  return true;
}

DI bool xcd_tile_j(int j, int ntot, int Mx, int NT, int& mt, int& nt) {
  if (j >= ntot) return false;
  const int xcd = blockIdx.x & 7;
  int mx = __builtin_amdgcn_readfirstlane(Mx);
  asm volatile("" : "+s"(mx));
  const int q = j / mx;
  mt = xcd * Mx + (j - q * mx); nt = q;
  (void)NT;
  return true;
}

DI void qkv_phase(const Params& p, int kind, char* smem) {
  const u16* W = kind == 0 ? p.Wa_qkv : kind == 1 ? p.Wb_qkv : p.Wd_qkv;
  const int nqk = kind == 0 ? 2048 : kind == 1 ? 1280 : 1536;
  const int dvt = kind == 0 ? 1024 : kind == 1 ? 256 : 512;
  const int ntq = nqk >> 8, ntv = dvt >> 8;
  const int slot = blockIdx.x >> 3, per = gridDim.x >> 3;
  if (slot >= per) return;
  const int n1 = 9 * ntq, ntot = n1 + 9 * ntv;
  auto desc = [&](int j, const u16*& Ap, const u16*& Bp, int& tok0, int& c0, bool& isv) {
    int mt, nt;
    isv = j >= n1;
    xcd_tile_j(isv ? j - n1 : j, 1 << 30, 9, 0, mt, nt);
    tok0 = mt * 256; c0 = nt * 256;
    const u16* Hp = p.H + (size_t)tok0 * DM;
    const u16* Wp = W + (size_t)((isv ? nqk : 0) + c0) * DM;
    Ap = isv ? Wp : Hp; Bp = isv ? Hp : Wp;
  };
#pragma unroll 1
  for (int j = slot; j < ntot; j += per) {
    const u16 *Ap, *Bp; int tok0, c0; bool isv;
    desc(j, Ap, Bp, tok0, c0, isv);
    NextTile nx; nx.Ap = nullptr; nx.Bp = nullptr; nx.vlo = 0; nx.vhi = 256;
    if (j + per < ntot) { int t2, c2; bool v2; desc(j + per, nx.Ap, nx.Bp, t2, c2, v2); }
    gemm_tile<false>(Ap, DM, 0, 256, Bp, DM, DM, smem, nx, [&](const float* sC, int q) {
      if (isv) epi_store(sC, q, p.Vt + (size_t)c0 * T + tok0, T, nullptr, f32x4{1.f, 1.f, 1.f, 1.f});
      else if (kind == 3) epi_qknorm128(p, sC, q, p.QK + (size_t)tok0 * nqk + c0, nqk, tok0, c0 < 1024 ? p.d_qg : p.d_kg);
      else epi_rope64(p, sC, q, p.QK + (size_t)tok0 * nqk + c0, nqk, tok0, 15, nullptr);
    });
  }
}

DI void mla_down_phase(const Params& p, char* smem) {
  int mt, nt;
#pragma unroll 1
  for (int r = 0; xcd_tile(r, 9, 3, 9, mt, nt); ++r) {
    int tok0 = mt * 256, col0 = nt * 256;
    NextTile nx; nx.Ap = nullptr; nx.Bp = nullptr; nx.vlo = 0; nx.vhi = 0;
    gemm_tile<false>(p.H + (size_t)tok0 * DM, DM, 0, 256, p.Wc_d + (size_t)col0 * DM, DM, DM, smem, nx, [&](const float* sC, int q) {
      epi_store(sC, q, p.T1 + (size_t)tok0 * 768 + col0, 768, nullptr, f32x4{1.f, 1.f, 1.f, 1.f});
    });
  }
}

DI void mla_up_phase(const Params& p, char* smem) {
  float* rs = (float*)(smem + RS_OFF);
  u16* Qb = p.QK; u16* Kb = p.QK + (size_t)T * 1536;
  const int slot = blockIdx.x >> 3, per = gridDim.x >> 3;
#pragma unroll 1
  for (int j = slot; j < 126 && slot < per; j += per) {
    int mt, nt;
    const int ty = j < 54 ? 0 : j < 90 ? 1 : 2;
    xcd_tile_j(j - (ty == 0 ? 0 : ty == 1 ? 54 : 90), 1 << 30, 9, 0, mt, nt);
    const int tok0 = mt * 256, c0 = nt * 256;
    const int K = ty == 0 ? 384 : 256;
    const u16* Tp = p.T1 + (size_t)tok0 * 768 + (ty == 0 ? 0 : 384);
    const u16* Wp = (ty == 0 ? p.Wc_uq : ty == 1 ? p.Wc_uk : p.Wc_uv) + (size_t)c0 * K;
    NextTile nx; nx.Ap = nullptr; nx.Bp = nullptr; nx.vlo = 0; nx.vhi = 0;
    gemm_tile<false>(ty == 2 ? Wp : Tp, ty == 2 ? K : 768, 0, 256, ty == 2 ? Tp : Wp, ty == 2 ? 768 : K, K, smem, nx, [&](const float* sC, int q) {
      if (q == 0) { tile_rstd(p, tok0, ty == 0 ? 0 : 384, K, rs); __syncthreads(); }
      if (ty == 0) {
        int mask = 0;
#pragma unroll
        for (int g = 0; g < 4; ++g) if (((c0 + 64 * g) % 192) == 128) mask |= 1 << g;
        epi_rope64(p, sC, q, Qb + (size_t)tok0 * 1536 + c0, 1536, tok0, mask, rs);
      } else if (ty == 1) {
        epi_store(sC, q, Kb + (size_t)tok0 * 1024 + c0, 1024, rs, f32x4{1.f, 1.f, 1.f, 1.f});
      } else {
        const int lane = tidx() & 63;
        epi_store(sC, q, p.Vt + (size_t)c0 * T + tok0, T, nullptr, *(const f32x4*)(rs + lane * 4));
      }
    });
  }
#pragma unroll 1
  for (int mt2 = blockIdx.x; mt2 < 72; mt2 += gridDim.x) {
    int tok0 = mt2 * 256;
    const bool lat = (tok0 % TPB) >= CTXL;
    for (int e = tidx(); e < 8192; e += NTHR) {
      int row = e >> 5, i = e & 31;
      const u16* tp = p.T1 + (size_t)(tok0 + row) * 768 + 640;
      float x1 = bf2f(tp[i]), x2 = bf2f(tp[i + 32]);
      if (lat) {
        int pos = (tok0 % TPB) - CTXL + row;
        float cs = p.rope64[pos * 32 + i], sn = p.rope64[65536 + pos * 32 + i];
        float y1 = x1 * cs - x2 * sn, y2 = x1 * sn + x2 * cs;
        x1 = y1; x2 = y2;
      }
      p.KR[(size_t)(tok0 + row) * 64 + i] = f2bf(x1);
      p.KR[(size_t)(tok0 + row) * 64 + i + 32] = f2bf(x2);
    }
  }
}

DI int tile_token(int mt, bool lat_only) {
  if (!lat_only) return mt * 256;
  int b = mt >> 3; return b * TPB + CTXL + (mt & 7) * 256;
}

DI void resid_gemm_phase(const Params& p, int layer, const u16* A, int lda, int K, const u16* W, int chunk, bool lat_only, char* smem, float gs) {
  const int Mx = lat_only ? 8 : 9;
  int mt, nt; bool has = xcd_tile(0, Mx, 4, Mx, mt, nt);
#pragma unroll 1
  for (int r = 0; has; ++r) {
    int mt2, nt2; const bool has2 = xcd_tile(r + 1, Mx, 4, Mx, mt2, nt2);
    const int tok0 = tile_token(mt, lat_only), col0 = nt * 256;
    NextTile nx; nx.Ap = has2 ? A + (size_t)tile_token(mt2, lat_only) * lda : nullptr; nx.Bp = W + (size_t)nt2 * 256 * K; nx.vlo = 0; nx.vhi = 256;
    const float* gate = p.MOD + ((size_t)layer * 9 + modrow(tok0)) * 6144 + chunk * 1024;
    f32x4 rv[16]; f32x4 gv;
    const float* Rsrc = (layer == 0 && chunk == 2) ? xrow(p, tok0) : (const float*)rrow(p, tok0);
    gemm_tile<false>(A + (size_t)tok0 * lda, lda, 0, 256, W + (size_t)col0 * K, K, K, smem, nx, [&](const float* sC, int q) {
      epi_resid(p, Rsrc, sC, q, tok0, col0, gv, rv);
    }, [&]() { gv = *(const f32x4*)(gate + col0 + (tidx() & 63) * 4) * gs; resid_load(Rsrc, 0, col0, rv); });
    mt = mt2; nt = nt2; has = has2;
    if (!has2 && r == 0 && chunk == 2 && layer < 3) {
      const int per = gridDim.x >> 3, slot = blockIdx.x >> 3, xcd = blockIdx.x & 7;
      const int nbusy = Mx * 4 - per;
      const int me = (slot - nbusy) * 8 + xcd;
      const int nidle = (per - nbusy) * 8;
      if (nbusy >= 0 && nbusy < per && me >= 0) {
#pragma unroll 1
        for (int i = me; i < 48; i += nidle) mod_item2(p, (layer + 1) * 96 + 2 * i + (tidx() >> 8), true, smem);
      }
    }
    if (!has2 && r == 0 && chunk == 5 && layer < 3) {
      const int per = gridDim.x >> 3, slot = blockIdx.x >> 3, xcd = blockIdx.x & 7;
      const int nbusy = Mx * 4 - per;
      const int nidle = (per - nbusy) * 8;
      const int me = (slot - nbusy) * 8 + xcd;
      const int t0 = p.ltile[layer + 1], t1 = p.ltile[layer + 2];
      if (nbusy >= 0 && nbusy < per && me >= 0) {
#pragma unroll 1
        for (int i = me; t0 + 4 * i < t1; i += nidle) convert_tiles(p, t0 + 4 * i, t1, smem);
      }
    }
  }
}

DI void ffn_up_phase(const Params& p, int layer, bool lat_only, char* smem) {
  const int tpb = lat_only ? 9 : 10;
  const int L = lat_only ? SEQ : TPB;
  const int seam = lat_only ? -1 : CTXL;
  const float* bnd = (const float*)(smem + BND_OFF);
  int mt, nt; bool has = xcd_tile(0, tpb, 22, 5, mt, nt);
#pragma unroll 1
  for (int r = 0; has; ++r) {
    int mt2, nt2; const bool has2 = xcd_tile(r + 1, tpb, 22, 5, mt2, nt2);
    const int b = mt / tpb, ti = mt - b * tpb;
    const int tokbase = b * TPB + (lat_only ? CTXL : 0);
    const int pos0 = ti * 254 - 1;
    const int vlo = (ti == 0) ? 1 : 0;
    int vhi = L - pos0; if (vhi > 256) vhi = 256;
    NextTile nx; nx.Ap = nullptr; nx.Bp = nullptr; nx.vlo = 0; nx.vhi = 0;
    if (has2) {
      const int b2 = mt2 / tpb, ti2 = mt2 - b2 * tpb;
      const int pos02 = ti2 * 254 - 1;
      nx.Ap = p.H + ((long)(b2 * TPB + (lat_only ? CTXL : 0)) + pos02) * DM; nx.Bp = p.Wup[layer] + (size_t)nt2 * 256 * DM;
      nx.vlo = (ti2 == 0) ? 1 : 0; nx.vhi = L - pos02; if (nx.vhi > 256) nx.vhi = 256;
    }
    ConvW cwv;
    gemm_tile<true>(p.H + ((long)tokbase + pos0) * DM, DM, vlo, vhi, p.Wup[layer] + (size_t)nt * 256 * DM, DM, DM, smem, nx, [&](const float* sC, int q) {
      epi_convgate(p, sC, bnd, q, tokbase, pos0, L, seam, nt, cwv);
    }, [&]() { conv_load(p, layer, nt, cwv); });
    mt = mt2; nt = nt2; has = has2;
  }
}

template <int RB> DI int kswz(int row, int ch) {
  if (RB == 256) return row * RB + ((ch ^ (row & 15)) << 4);
  return row * RB + ((((ch & 7) ^ ((row >> 1) & 7)) | (ch & ~7)) << 4);
}
DI bf16x8 pack8(float a0, float a1, float a2, float a3, float a4, float a5, float a6, float a7) {
  u32x4 w = {pack2(a0, a1), pack2(a2, a3), pack2(a4, a5), pack2(a6, a7)};
  return __builtin_bit_cast(bf16x8, w);
}

DI void qk_asm_a(f32x16 (&s)[2], const bf16x8 (&q)[4], const unsigned (&a)[4]) {
  u32x4 t0, t1, t2, t3, t4, t5;
  asm volatile(
      "ds_read_b128 %2, %12 offset:0\n\t"
      "ds_read_b128 %3, %12 offset:8192\n\t"
      "ds_read_b128 %4, %13 offset:0\n\t"
      "ds_read_b128 %5, %13 offset:8192\n\t"
      "ds_read_b128 %6, %14 offset:0\n\t"
      "ds_read_b128 %7, %14 offset:8192\n\t"
      "s_waitcnt lgkmcnt(5)\n\t"
      "v_mfma_f32_32x32x16_bf16 %0, %2, %8, %0\n\t"
      "ds_read_b128 %2, %15 offset:0\n\t"
      "s_waitcnt lgkmcnt(5)\n\t"
      "v_mfma_f32_32x32x16_bf16 %1, %3, %8, %1\n\t"
      "ds_read_b128 %3, %15 offset:8192\n\t"
      "s_waitcnt lgkmcnt(5)\n\t"
      "v_mfma_f32_32x32x16_bf16 %0, %4, %9, %0\n\t"
      "s_waitcnt lgkmcnt(4)\n\t"
      "v_mfma_f32_32x32x16_bf16 %1, %5, %9, %1\n\t"
      "s_waitcnt lgkmcnt(3)\n\t"
      "v_mfma_f32_32x32x16_bf16 %0, %6, %10, %0\n\t"
      "s_waitcnt lgkmcnt(2)\n\t"
      "v_mfma_f32_32x32x16_bf16 %1, %7, %10, %1\n\t"
      "s_waitcnt lgkmcnt(1)\n\t"
      "v_mfma_f32_32x32x16_bf16 %0, %2, %11, %0\n\t"
      "s_waitcnt lgkmcnt(0)\n\t"
      "v_mfma_f32_32x32x16_bf16 %1, %3, %11, %1\n\t"
      "s_nop 15\n\t"
      "s_nop 3\n\t"
      : "+v"(s[0]), "+v"(s[1]), "=&v"(t0), "=&v"(t1), "=&v"(t2), "=&v"(t3), "=&v"(t4), "=&v"(t5)
      : "v"(q[0]), "v"(q[1]), "v"(q[2]), "v"(q[3]), "v"(a[0]), "v"(a[1]), "v"(a[2]), "v"(a[3])
      : "memory");
}
DI void qk_asm_b(f32x16 (&s)[2], const bf16x8 (&q)[4], const unsigned (&a)[4]) {
  u32x4 t0, t1, t2, t3, t4, t5;
  asm volatile(
      "ds_read_b128 %2, %12 offset:0\n\t"
      "ds_read_b128 %3, %12 offset:4096\n\t"
      "ds_read_b128 %4, %13 offset:0\n\t"
      "ds_read_b128 %5, %13 offset:4096\n\t"
      "ds_read_b128 %6, %14 offset:0\n\t"
      "ds_read_b128 %7, %14 offset:4096\n\t"
      "s_waitcnt lgkmcnt(5)\n\t"
      "v_mfma_f32_32x32x16_bf16 %0, %2, %8, %0\n\t"
      "ds_read_b128 %2, %15 offset:0\n\t"
      "s_waitcnt lgkmcnt(5)\n\t"
      "v_mfma_f32_32x32x16_bf16 %1, %3, %8, %1\n\t"
      "ds_read_b128 %3, %15 offset:4096\n\t"
      "s_waitcnt lgkmcnt(5)\n\t"
      "v_mfma_f32_32x32x16_bf16 %0, %4, %9, %0\n\t"
      "s_waitcnt lgkmcnt(4)\n\t"
      "v_mfma_f32_32x32x16_bf16 %1, %5, %9, %1\n\t"
      "s_waitcnt lgkmcnt(3)\n\t"
      "v_mfma_f32_32x32x16_bf16 %0, %6, %10, %0\n\t"
      "s_waitcnt lgkmcnt(2)\n\t"
      "v_mfma_f32_32x32x16_bf16 %1, %7, %10, %1\n\t"
      "s_waitcnt lgkmcnt(1)\n\t"
      "v_mfma_f32_32x32x16_bf16 %0, %2, %11, %0\n\t"
      "s_waitcnt lgkmcnt(0)\n\t"
      "v_mfma_f32_32x32x16_bf16 %1, %3, %11, %1\n\t"
      "s_nop 15\n\t"
      "s_nop 3\n\t"
      : "+v"(s[0]), "+v"(s[1]), "=&v"(t0), "=&v"(t1), "=&v"(t2), "=&v"(t3), "=&v"(t4), "=&v"(t5)
      : "v"(q[0]), "v"(q[1]), "v"(q[2]), "v"(q[3]), "v"(a[0]), "v"(a[1]), "v"(a[2]), "v"(a[3])
      : "memory");
}
DI void qk_asm_c(f32x16 (&s)[1], const bf16x8 (&q)[12], const unsigned (&a)[4]) {
  u32x4 t0, t1, t2, t3, t4, t5;
  asm volatile(
      "ds_read_b128 %1, %19 offset:0\n\t"
      "ds_read_b128 %2, %20 offset:0\n\t"
      "ds_read_b128 %3, %21 offset:0\n\t"
      "ds_read_b128 %4, %22 offset:0\n\t"
      "ds_read_b128 %5, %19 offset:128\n\t"
      "ds_read_b128 %6, %20 offset:128\n\t"
      "s_waitcnt lgkmcnt(5)\n\t"
      "v_mfma_f32_32x32x16_bf16 %0, %1, %7, %0\n\t"
      "ds_read_b128 %1, %21 offset:128\n\t"
      "s_waitcnt lgkmcnt(5)\n\t"
      "v_mfma_f32_32x32x16_bf16 %0, %2, %8, %0\n\t"
      "ds_read_b128 %2, %22 offset:128\n\t"
      "s_waitcnt lgkmcnt(5)\n\t"
      "v_mfma_f32_32x32x16_bf16 %0, %3, %9, %0\n\t"
      "ds_read_b128 %3, %19 offset:256\n\t"
      "s_waitcnt lgkmcnt(5)\n\t"
      "v_mfma_f32_32x32x16_bf16 %0, %4, %10, %0\n\t"
      "ds_read_b128 %4, %20 offset:256\n\t"
      "s_waitcnt lgkmcnt(5)\n\t"
      "v_mfma_f32_32x32x16_bf16 %0, %5, %11, %0\n\t"
      "ds_read_b128 %5, %21 offset:256\n\t"
      "s_waitcnt lgkmcnt(5)\n\t"
      "v_mfma_f32_32x32x16_bf16 %0, %6, %12, %0\n\t"
      "ds_read_b128 %6, %22 offset:256\n\t"
      "s_waitcnt lgkmcnt(5)\n\t"
      "v_mfma_f32_32x32x16_bf16 %0, %1, %13, %0\n\t"
      "s_waitcnt lgkmcnt(4)\n\t"
      "v_mfma_f32_32x32x16_bf16 %0, %2, %14, %0\n\t"
      "s_waitcnt lgkmcnt(3)\n\t"
      "v_mfma_f32_32x32x16_bf16 %0, %3, %15, %0\n\t"
      "s_waitcnt lgkmcnt(2)\n\t"
      "v_mfma_f32_32x32x16_bf16 %0, %4, %16, %0\n\t"
      "s_waitcnt lgkmcnt(1)\n\t"
      "v_mfma_f32_32x32x16_bf16 %0, %5, %17, %0\n\t"
      "s_waitcnt lgkmcnt(0)\n\t"
      "v_mfma_f32_32x32x16_bf16 %0, %6, %18, %0\n\t"
      "s_nop 15\n\t"
      "s_nop 3\n\t"
      : "+v"(s[0]), "=&v"(t0), "=&v"(t1), "=&v"(t2), "=&v"(t3), "=&v"(t4), "=&v"(t5)
      : "v"(q[0]), "v"(q[1]), "v"(q[2]), "v"(q[3]), "v"(q[4]), "v"(q[5]), "v"(q[6]), "v"(q[7]), "v"(q[8]), "v"(q[9]), "v"(q[10]), "v"(q[11]), "v"(a[0]), "v"(a[1]), "v"(a[2]), "v"(a[3])
      : "memory");
}
DI void qk_asm_d(f32x16 (&s)[2], const bf16x8 (&q)[8], const unsigned (&a)[8]) {
  u32x4 t0, t1, t2, t3, t4, t5;
  asm volatile(
      "ds_read_b128 %2, %16 offset:0\n\t"
      "ds_read_b128 %3, %16 offset:8192\n\t"
      "ds_read_b128 %4, %17 offset:0\n\t"
      "ds_read_b128 %5, %17 offset:8192\n\t"
      "ds_read_b128 %6, %18 offset:0\n\t"
      "ds_read_b128 %7, %18 offset:8192\n\t"
      "s_waitcnt lgkmcnt(5)\n\t"
      "v_mfma_f32_32x32x16_bf16 %0, %2, %8, %0\n\t"
      "ds_read_b128 %2, %19 offset:0\n\t"
      "s_waitcnt lgkmcnt(5)\n\t"
      "v_mfma_f32_32x32x16_bf16 %1, %3, %8, %1\n\t"
      "ds_read_b128 %3, %19 offset:8192\n\t"
      "s_waitcnt lgkmcnt(5)\n\t"
      "v_mfma_f32_32x32x16_bf16 %0, %4, %9, %0\n\t"
      "ds_read_b128 %4, %20 offset:0\n\t"
      "s_waitcnt lgkmcnt(5)\n\t"
      "v_mfma_f32_32x32x16_bf16 %1, %5, %9, %1\n\t"
      "ds_read_b128 %5, %20 offset:8192\n\t"
      "s_waitcnt lgkmcnt(5)\n\t"
      "v_mfma_f32_32x32x16_bf16 %0, %6, %10, %0\n\t"
      "ds_read_b128 %6, %21 offset:0\n\t"
      "s_waitcnt lgkmcnt(5)\n\t"
      "v_mfma_f32_32x32x16_bf16 %1, %7, %10, %1\n\t"
      "ds_read_b128 %7, %21 offset:8192\n\t"
      "s_waitcnt lgkmcnt(5)\n\t"
      "v_mfma_f32_32x32x16_bf16 %0, %2, %11, %0\n\t"
      "ds_read_b128 %2, %22 offset:0\n\t"
      "s_waitcnt lgkmcnt(5)\n\t"
      "v_mfma_f32_32x32x16_bf16 %1, %3, %11, %1\n\t"
      "ds_read_b128 %3, %22 offset:8192\n\t"
      "s_waitcnt lgkmcnt(5)\n\t"
      "v_mfma_f32_32x32x16_bf16 %0, %4, %12, %0\n\t"
      "ds_read_b128 %4, %23 offset:0\n\t"
      "s_waitcnt lgkmcnt(5)\n\t"
      "v_mfma_f32_32x32x16_bf16 %1, %5, %12, %1\n\t"
      "ds_read_b128 %5, %23 offset:8192\n\t"
      "s_waitcnt lgkmcnt(5)\n\t"
      "v_mfma_f32_32x32x16_bf16 %0, %6, %13, %0\n\t"
      "s_waitcnt lgkmcnt(4)\n\t"
      "v_mfma_f32_32x32x16_bf16 %1, %7, %13, %1\n\t"
      "s_waitcnt lgkmcnt(3)\n\t"
      "v_mfma_f32_32x32x16_bf16 %0, %2, %14, %0\n\t"
      "s_waitcnt lgkmcnt(2)\n\t"
      "v_mfma_f32_32x32x16_bf16 %1, %3, %14, %1\n\t"
      "s_waitcnt lgkmcnt(1)\n\t"
      "v_mfma_f32_32x32x16_bf16 %0, %4, %15, %0\n\t"
      "s_waitcnt lgkmcnt(0)\n\t"
      "v_mfma_f32_32x32x16_bf16 %1, %5, %15, %1\n\t"
      "s_nop 15\n\t"
      "s_nop 3\n\t"
      : "+v"(s[0]), "+v"(s[1]), "=&v"(t0), "=&v"(t1), "=&v"(t2), "=&v"(t3), "=&v"(t4), "=&v"(t5)
      : "v"(q[0]), "v"(q[1]), "v"(q[2]), "v"(q[3]), "v"(q[4]), "v"(q[5]), "v"(q[6]), "v"(q[7]), "v"(a[0]), "v"(a[1]), "v"(a[2]), "v"(a[3]), "v"(a[4]), "v"(a[5]), "v"(a[6]), "v"(a[7])
      : "memory");
}
DI void pv_asm_42(f32x16 (&o)[4], const bf16x8 (&pb)[2][2], const unsigned (&a)[4]) {
  u32x4 t0, t1, t2, t3, t4, t5;
  asm volatile(
      "ds_read_b128 %4, %14 offset:0\n\t"
      "ds_read_b128 %5, %14 offset:4096\n\t"
      "ds_read_b128 %6, %14 offset:8192\n\t"
      "ds_read_b128 %7, %14 offset:12288\n\t"
      "ds_read_b128 %8, %15 offset:0\n\t"
      "ds_read_b128 %9, %15 offset:4096\n\t"
      "s_waitcnt lgkmcnt(5)\n\t"
      "v_mfma_f32_32x32x16_bf16 %0, %4, %10, %0\n\t"
      "ds_read_b128 %4, %15 offset:8192\n\t"
      "s_waitcnt lgkmcnt(5)\n\t"
      "v_mfma_f32_32x32x16_bf16 %1, %5, %10, %1\n\t"
      "ds_read_b128 %5, %15 offset:12288\n\t"
      "s_waitcnt lgkmcnt(5)\n\t"
      "v_mfma_f32_32x32x16_bf16 %2, %6, %10, %2\n\t"
      "ds_read_b128 %6, %16 offset:0\n\t"
      "s_waitcnt lgkmcnt(5)\n\t"
      "v_mfma_f32_32x32x16_bf16 %3, %7, %10, %3\n\t"
      "ds_read_b128 %7, %16 offset:4096\n\t"
      "s_waitcnt lgkmcnt(5)\n\t"
      "v_mfma_f32_32x32x16_bf16 %0, %8, %11, %0\n\t"
      "ds_read_b128 %8, %16 offset:8192\n\t"
      "s_waitcnt lgkmcnt(5)\n\t"
      "v_mfma_f32_32x32x16_bf16 %1, %9, %11, %1\n\t"
      "ds_read_b128 %9, %16 offset:12288\n\t"
      "s_waitcnt lgkmcnt(5)\n\t"
      "v_mfma_f32_32x32x16_bf16 %2, %4, %11, %2\n\t"
      "ds_read_b128 %4, %17 offset:0\n\t"
      "s_waitcnt lgkmcnt(5)\n\t"
      "v_mfma_f32_32x32x16_bf16 %3, %5, %11, %3\n\t"
      "ds_read_b128 %5, %17 offset:4096\n\t"
      "s_waitcnt lgkmcnt(5)\n\t"
      "v_mfma_f32_32x32x16_bf16 %0, %6, %12, %0\n\t"
      "ds_read_b128 %6, %17 offset:8192\n\t"
      "s_waitcnt lgkmcnt(5)\n\t"
      "v_mfma_f32_32x32x16_bf16 %1, %7, %12, %1\n\t"
      "ds_read_b128 %7, %17 offset:12288\n\t"
      "s_waitcnt lgkmcnt(5)\n\t"
      "v_mfma_f32_32x32x16_bf16 %2, %8, %12, %2\n\t"
      "s_waitcnt lgkmcnt(4)\n\t"
      "v_mfma_f32_32x32x16_bf16 %3, %9, %12, %3\n\t"
      "s_waitcnt lgkmcnt(3)\n\t"
      "v_mfma_f32_32x32x16_bf16 %0, %4, %13, %0\n\t"
      "s_waitcnt lgkmcnt(2)\n\t"
      "v_mfma_f32_32x32x16_bf16 %1, %5, %13, %1\n\t"
      "s_waitcnt lgkmcnt(1)\n\t"
      "v_mfma_f32_32x32x16_bf16 %2, %6, %13, %2\n\t"
      "s_waitcnt lgkmcnt(0)\n\t"
      "v_mfma_f32_32x32x16_bf16 %3, %7, %13, %3\n\t"
      "s_nop 15\n\t"
      "s_nop 3\n\t"
      : "+v"(o[0]), "+v"(o[1]), "+v"(o[2]), "+v"(o[3]), "=&v"(t0), "=&v"(t1), "=&v"(t2), "=&v"(t3), "=&v"(t4), "=&v"(t5)
      : "v"(pb[0][0]), "v"(pb[0][1]), "v"(pb[1][0]), "v"(pb[1][1]), "v"(a[0]), "v"(a[1]), "v"(a[2]), "v"(a[3])
      : "memory");
}
DI void pv_asm_22(f32x16 (&o)[2], const bf16x8 (&pb)[2][2], const unsigned (&a)[4]) {
  u32x4 t0, t1, t2, t3, t4, t5;
  asm volatile(
      "ds_read_b128 %2, %12 offset:0\n\t"
      "ds_read_b128 %3, %12 offset:4096\n\t"
      "ds_read_b128 %4, %13 offset:0\n\t"
      "ds_read_b128 %5, %13 offset:4096\n\t"
      "ds_read_b128 %6, %14 offset:0\n\t"
      "ds_read_b128 %7, %14 offset:4096\n\t"
      "s_waitcnt lgkmcnt(5)\n\t"
      "v_mfma_f32_32x32x16_bf16 %0, %2, %8, %0\n\t"
      "ds_read_b128 %2, %15 offset:0\n\t"
      "s_waitcnt lgkmcnt(5)\n\t"
      "v_mfma_f32_32x32x16_bf16 %1, %3, %8, %1\n\t"
      "ds_read_b128 %3, %15 offset:4096\n\t"
      "s_waitcnt lgkmcnt(5)\n\t"
      "v_mfma_f32_32x32x16_bf16 %0, %4, %9, %0\n\t"
      "s_waitcnt lgkmcnt(4)\n\t"
      "v_mfma_f32_32x32x16_bf16 %1, %5, %9, %1\n\t"
      "s_waitcnt lgkmcnt(3)\n\t"
      "v_mfma_f32_32x32x16_bf16 %0, %6, %10, %0\n\t"
      "s_waitcnt lgkmcnt(2)\n\t"
      "v_mfma_f32_32x32x16_bf16 %1, %7, %10, %1\n\t"
      "s_waitcnt lgkmcnt(1)\n\t"
      "v_mfma_f32_32x32x16_bf16 %0, %2, %11, %0\n\t"
      "s_waitcnt lgkmcnt(0)\n\t"
      "v_mfma_f32_32x32x16_bf16 %1, %3, %11, %1\n\t"
      "s_nop 15\n\t"
      "s_nop 3\n\t"
      : "+v"(o[0]), "+v"(o[1]), "=&v"(t0), "=&v"(t1), "=&v"(t2), "=&v"(t3), "=&v"(t4), "=&v"(t5)
      : "v"(pb[0][0]), "v"(pb[0][1]), "v"(pb[1][0]), "v"(pb[1][1]), "v"(a[0]), "v"(a[1]), "v"(a[2]), "v"(a[3])
      : "memory");
}
DI void pv_asm_41(f32x16 (&o)[4], const bf16x8 (&pb)[1][2], const unsigned (&a)[2]) {
  u32x4 t0, t1, t2, t3, t4, t5;
  asm volatile(
      "ds_read_b128 %4, %12 offset:0\n\t"
      "ds_read_b128 %5, %12 offset:4096\n\t"
      "ds_read_b128 %6, %12 offset:8192\n\t"
      "ds_read_b128 %7, %12 offset:12288\n\t"
      "ds_read_b128 %8, %13 offset:0\n\t"
      "ds_read_b128 %9, %13 offset:4096\n\t"
      "s_waitcnt lgkmcnt(5)\n\t"
      "v_mfma_f32_32x32x16_bf16 %0, %4, %10, %0\n\t"
      "ds_read_b128 %4, %13 offset:8192\n\t"
      "s_waitcnt lgkmcnt(5)\n\t"
      "v_mfma_f32_32x32x16_bf16 %1, %5, %10, %1\n\t"
      "ds_read_b128 %5, %13 offset:12288\n\t"
      "s_waitcnt lgkmcnt(5)\n\t"
      "v_mfma_f32_32x32x16_bf16 %2, %6, %10, %2\n\t"
      "s_waitcnt lgkmcnt(4)\n\t"
      "v_mfma_f32_32x32x16_bf16 %3, %7, %10, %3\n\t"
      "s_waitcnt lgkmcnt(3)\n\t"
      "v_mfma_f32_32x32x16_bf16 %0, %8, %11, %0\n\t"
      "s_waitcnt lgkmcnt(2)\n\t"
      "v_mfma_f32_32x32x16_bf16 %1, %9, %11, %1\n\t"
      "s_waitcnt lgkmcnt(1)\n\t"
      "v_mfma_f32_32x32x16_bf16 %2, %4, %11, %2\n\t"
      "s_waitcnt lgkmcnt(0)\n\t"
      "v_mfma_f32_32x32x16_bf16 %3, %5, %11, %3\n\t"
      "s_nop 15\n\t"
      "s_nop 3\n\t"
      : "+v"(o[0]), "+v"(o[1]), "+v"(o[2]), "+v"(o[3]), "=&v"(t0), "=&v"(t1), "=&v"(t2), "=&v"(t3), "=&v"(t4), "=&v"(t5)
      : "v"(pb[0][0]), "v"(pb[0][1]), "v"(a[0]), "v"(a[1])
      : "memory");
}

template <int KIND>
DI void attn_item(const Params& p, int b, int hh, int qt, char* smem, float lam) {
  constexpr int DQK = KIND == 2 ? 192 : KIND == 3 ? 128 : 64;
  constexpr int DV = KIND == 1 ? 64 : 128;
  constexpr int KRB = KIND == 0 ? 256 : KIND == 1 ? 128 : KIND == 2 ? 384 : 256;
  constexpr int NQ = KIND == 0 ? 128 : 256;
  constexpr int NMB = KIND == 2 ? 1 : 2;
  constexpr int KCH = KRB / 16, NKC = 64 * KCH / 512, NVC = DV * 8 / 512, NC = DV / 32;
  constexpr int LDQ = KIND == 0 ? 2048 : KIND == 1 ? 1280 : 1536;
  constexpr int LDK = KIND == 0 ? 2048 : KIND == 1 ? 1280 : KIND == 2 ? 1024 : 1536;
  const int tid = tidx(), lane = tid & 63, wave = tid >> 6, h = lane >> 5, ql = lane & 31;
  const int grp = KIND == 0 ? (wave >> 2) : 0;
  const int wq = KIND == 0 ? (wave & 3) : wave;
  const int tokb = b * TPB;
  const int q0 = qt * NQ;
  const bool isctx = q0 < CTXL;
  int lo = 0, hi = 0;
  if (!isctx) {
    if (KIND == 1) {
      int s = q0 - CTXL;
      int a = s - 128; if (a < 0) a = 0;
      int e = s + 383; if (e > SEQ - 1) e = SEQ - 1;
      lo = (CTXL + a) >> 6; hi = ((CTXL + e) >> 6) + 1;
    } else { lo = 4; hi = 36; }
  }
  const int ntiles = 4 + (hi - lo);
  const float sl2 = (KIND == 2 ? 0.07216878364870322f : KIND == 3 ? 0.08838834764831845f : 0.125f) * 1.4426950408889634f;

  const u16* Ksrc; const u16* Vth; int qoff, aoff;
  if (KIND == 0) { qoff = (2 * hh + grp) * 64; Ksrc = p.QK + 1024 + hh * 128; Vth = p.Vt + (size_t)(hh * 128) * T; aoff = hh * 128; }
  else if (KIND == 1) { qoff = hh * 64; Ksrc = p.QK + 1024 + (hh >> 2) * 64; Vth = p.Vt + (size_t)((hh >> 2) * 64) * T; aoff = hh * 64; }
  else if (KIND == 2) { qoff = hh * 192; Ksrc = p.QK + (size_t)T * 1536 + hh * 128; Vth = p.Vt + (size_t)(hh * 128) * T; aoff = hh * 128; }
  else { qoff = hh * 128; Ksrc = p.QK + 1024 + (hh >> 1) * 128; Vth = p.Vt + (size_t)((hh >> 1) * 128) * T; aoff = hh * 128; }
  const int qtok = tokb + q0 + wq * 32 + ql;

  bf16x8 qf[DQK / 16];
  {
    const u16* qrow = p.QK + (size_t)qtok * LDQ + qoff;
#pragma unroll
    for (int ks = 0; ks < DQK / 16; ++ks) qf[ks] = *(const bf16x8*)(qrow + 16 * ks + 8 * h);
  }
  u32x4 rk[NKC], rv[NVC];
  auto gload = [&](int kt) {
    const int key0 = tokb + kt * 64;
#pragma unroll
    for (int i = 0; i < NKC; ++i) {
      int id = tid + 512 * i; int row = id / KCH, ch = id - row * KCH;
      const u16* src = (KIND == 2 && ch >= 16) ? p.KR + (size_t)(key0 + row) * 64 + (ch - 16) * 8
                                               : Ksrc + (size_t)(key0 + row) * LDK + ch * 8;
      rk[i] = *(const u32x4*)src;
    }
#pragma unroll
    for (int i = 0; i < NVC; ++i) {
      int id = tid + 512 * i; int row = id >> 3, ch = id & 7;
      rv[i] = *(const u32x4*)(Vth + (size_t)row * T + key0 + ch * 8);
    }
  };
  auto sstore = [&](int buf) {
    char* sK = smem + buf * 40960; char* sV = sK + 24576;
#pragma unroll
    for (int i = 0; i < NKC; ++i) {
      int id = tid + 512 * i; int row = id / KCH, ch = id - row * KCH;
      *(u32x4*)(sK + kswz<KRB>(row, ch)) = rk[i];
    }
#pragma unroll
    for (int i = 0; i < NVC; ++i) {
      int id = tid + 512 * i; int row = id >> 3, ch = id & 7;
      *(u32x4*)(sV + swz128(row, ch)) = rv[i];
    }
  };
  f32x16 oacc[NC];
#pragma unroll
  for (int c = 0; c < NC; ++c)
#pragma unroll
    for (int r = 0; r < 16; ++r) oacc[c][r] = 0.f;
  float m = -1e30f, l = 0.f;
  const int prow = (ql & 3) | ((ql & 4) << 1) | ((ql & 8) >> 1) | (ql & 16);
  const unsigned lds0 = (unsigned)(size_t)smem;
  const int qpos = q0 - CTXL + wq * 32 + ql;

  gload(0); sstore(0); __syncthreads();
#pragma unroll 1
  for (int ti = 0; ti < ntiles; ++ti) {
    const int kt = ti < 4 ? ti : lo + ti - 4;
    if (ti + 1 < ntiles) gload(ti + 1 < 4 ? ti + 1 : lo + ti + 1 - 4);
    const char* sK = smem + (ti & 1) * 40960; const char* sV = sK + 24576;
    const bool domask = (KIND == 1) && !isctx && kt >= 4;
#pragma unroll
    for (int hb = 0; hb < 2; hb += NMB) {
      f32x16 sacc[NMB];
#pragma unroll
      for (int mb = 0; mb < NMB; ++mb)
#pragma unroll
        for (int r = 0; r < 16; ++r) sacc[mb][r] = 0.f;
      {
        const unsigned kbase = lds0 + (unsigned)((ti & 1) * 40960) + (unsigned)((prow + 32 * hb) * KRB);
        if (KIND == 0) {
          unsigned ka[4];
#pragma unroll
          for (int ks = 0; ks < 4; ++ks) ka[ks] = kbase + ((unsigned)((8 * grp + 2 * ks + h) ^ (prow & 15)) << 4);
          qk_asm_a(*(f32x16(*)[2])&sacc, *(const bf16x8(*)[4])&qf, ka);
        } else if (KIND == 1) {
          unsigned ka[4];
#pragma unroll
          for (int ks = 0; ks < 4; ++ks) ka[ks] = kbase + ((unsigned)((2 * ks + h) ^ ((prow >> 1) & 7)) << 4);
          qk_asm_b(*(f32x16(*)[2])&sacc, *(const bf16x8(*)[4])&qf, ka);
        } else if (KIND == 2) {
          unsigned ka[4];
#pragma unroll
          for (int b4 = 0; b4 < 4; ++b4) ka[b4] = kbase + ((unsigned)((2 * b4 + h) ^ ((prow >> 1) & 7)) << 4);
          qk_asm_c(*(f32x16(*)[1])&sacc, *(const bf16x8(*)[12])&qf, ka);
        } else {
          unsigned ka[8];
#pragma unroll
          for (int ks = 0; ks < 8; ++ks) ka[ks] = kbase + ((unsigned)((2 * ks + h) ^ (prow & 15)) << 4);
          qk_asm_d(*(f32x16(*)[2])&sacc, *(const bf16x8(*)[8])&qf, ka);
        }
      }
      float mx = -1e30f;
      if (domask) {
#pragma unroll
        for (int mb = 0; mb < NMB; ++mb)
#pragma unroll
          for (int r = 0; r < 16; ++r) {
            int kpos = kt * 64 + 32 * (hb + mb) + 16 * (r >> 3) + 8 * h + (r & 7) - CTXL;
            int d = qpos - kpos; if (d < 0) d = -d;
            if (d > 128) sacc[mb][r] = -1e30f;
          }
      }
#pragma unroll
      for (int mb = 0; mb < NMB; ++mb)
#pragma unroll
        for (int r = 0; r < 16; r += 2) mx = fmaxf(mx, fmaxf(sacc[mb][r], sacc[mb][r + 1]));
      mx = xmax32(mx);
      const float mn = fmaxf(m, mx);
      const float nms = -mn * sl2;
      const float alpha = __builtin_amdgcn_exp2f((m - mn) * sl2);
      float sum = 0.f;
#pragma unroll
      for (int mb = 0; mb < NMB; ++mb)
#pragma unroll
        for (int r = 0; r < 16; ++r) { float pv = __builtin_amdgcn_exp2f(fmaf(sacc[mb][r], sl2, nms)); sacc[mb][r] = pv; sum += pv; }
      sum = xsum32(sum);
      l = l * alpha + sum; m = mn;
      if (__any(alpha != 1.f)) {
#pragma unroll
        for (int c = 0; c < NC; ++c)
#pragma unroll
          for (int r = 0; r < 16; ++r) oacc[c][r] *= alpha;
      }
      bf16x8 pb[NMB][2];
#pragma unroll
      for (int mb = 0; mb < NMB; ++mb)
#pragma unroll
        for (int s = 0; s < 2; ++s)
          pb[mb][s] = pack8(sacc[mb][8 * s], sacc[mb][8 * s + 1], sacc[mb][8 * s + 2], sacc[mb][8 * s + 3],
                            sacc[mb][8 * s + 4], sacc[mb][8 * s + 5], sacc[mb][8 * s + 6], sacc[mb][8 * s + 7]);
      {
        const unsigned vbase = lds0 + (unsigned)((ti & 1) * 40960 + 24576) + (unsigned)(ql * 128);
        unsigned va[NMB * 2];
#pragma unroll
        for (int mb = 0; mb < NMB; ++mb)
#pragma unroll
          for (int s = 0; s < 2; ++s) va[mb * 2 + s] = vbase + ((unsigned)((4 * (hb + mb) + 2 * s + h) ^ ((ql >> 1) & 7)) << 4);
        if (KIND == 1) pv_asm_22(*(f32x16(*)[2])&oacc, *(const bf16x8(*)[2][2])&pb, *(const unsigned(*)[4])&va);
        else if (KIND == 2) pv_asm_41(*(f32x16(*)[4])&oacc, *(const bf16x8(*)[1][2])&pb, *(const unsigned(*)[2])&va);
        else pv_asm_42(*(f32x16(*)[4])&oacc, *(const bf16x8(*)[2][2])&pb, *(const unsigned(*)[4])&va);
      }
    }
    if (ti + 1 < ntiles) sstore((ti + 1) & 1);
    __syncthreads();
  }
  float den = l;
  if (KIND == 1) den += __builtin_amdgcn_exp2f(p.b_sink[hh] * 1.4426950408889634f - m * sl2);
  const float inv = 1.f / den;
  constexpr int ORS = DV * 2 + 16;
  char* sO = smem + (KIND == 0 ? 65536 : 40960) + (KIND == 0 ? wq : wave) * (32 * ORS);
  if (KIND != 0) {
#pragma unroll
    for (int c = 0; c < NC; ++c)
#pragma unroll
      for (int r4 = 0; r4 < 4; ++r4) {
        int d = 32 * c + 8 * r4 + 4 * h;
        *(u32x2*)(sO + ql * ORS + d * 2) = u32x2{pack2(oacc[c][4 * r4] * inv, oacc[c][4 * r4 + 1] * inv),
                                                 pack2(oacc[c][4 * r4 + 2] * inv, oacc[c][4 * r4 + 3] * inv)};
      }
  } else {
    float* sX = (float*)smem;
    if (grp == 1) {
#pragma unroll
      for (int c = 0; c < NC; ++c)
#pragma unroll
        for (int r = 0; r < 16; ++r) sX[((wq * 4 + c) * 16 + r) * 64 + lane] = oacc[c][r] * inv;
    }
    __syncthreads();
    if (grp == 0) {
      float ss = 0.f;
#pragma unroll
      for (int c = 0; c < NC; ++c)
#pragma unroll
        for (int r = 0; r < 16; ++r) {
          float dv = oacc[c][r] * inv - lam * sX[((wq * 4 + c) * 16 + r) * 64 + lane];
          oacc[c][r] = dv; ss += dv * dv;
        }
      ss += __shfl_xor(ss, 32);
      const float rstd = rsqrtf(ss * (1.f / 128.f) + EPS) * 0.8f;
#pragma unroll
      for (int c = 0; c < NC; ++c)
#pragma unroll
        for (int r4 = 0; r4 < 4; ++r4) {
          int d = 32 * c + 8 * r4 + 4 * h;
          float4 g = *(const float4*)(p.a_subln + d);
          *(u32x2*)(sO + ql * ORS + d * 2) = u32x2{pack2(oacc[c][4 * r4] * rstd * g.x, oacc[c][4 * r4 + 1] * rstd * g.y),
                                                   pack2(oacc[c][4 * r4 + 2] * rstd * g.z, oacc[c][4 * r4 + 3] * rstd * g.w)};
        }
    }
  }
  if (KIND != 0 || grp == 0) {
    __threadfence_block();
    u16* obase = p.AO + (size_t)(tokb + q0 + wq * 32) * DM + aoff;
    constexpr int CPR = DV / 8;
#pragma unroll
    for (int k = 0; k < 32 * CPR / 64; ++k) {
      const int idx = k * 64 + lane;
      const int row = idx / CPR, ch = idx - row * CPR;
      const u32x4 v = *(const u32x4*)(sO + row * ORS + ch * 16);
      *(u32x4*)(obase + (size_t)row * DM + ch * 8) = v;
    }
  }
  if (KIND == 0) __syncthreads();
}

template <int KIND>
DI void attn_phase_mfma(const Params& p, bool lat_only, char* smem) {
  constexpr int NH = KIND == 1 ? 16 : 8;
  constexpr int QTC = KIND == 0 ? 2 : 1, QTL = KIND == 0 ? 16 : 8;
  float lam = 0.f;
  if (KIND == 0) {
    const int lane = tidx() & 63;
    float s1 = wave_sum(p.a_lq1[lane] * p.a_lk1[lane]);
    float s2 = wave_sum(p.a_lq2[lane] * p.a_lk2[lane]);
    lam = __expf(s1) - __expf(s2) + 0.2f;
  }
  const int n_lat = NBATCH * NH * QTL, n_ctx = lat_only ? 0 : NBATCH * NH * QTC;
#pragma unroll 1
  for (int i = blockIdx.x; i < n_lat + n_ctx; i += gridDim.x) {
    int b, hh, qt;
    if (i < n_lat) { b = i & 7; int j = i >> 3; hh = j / QTL; qt = QTC + (j - hh * QTL); }
    else { int i2 = i - n_lat; b = i2 & 7; int j = i2 >> 3; hh = j / QTC; qt = j - hh * QTC; }
    attn_item<KIND>(p, b, hh, qt, smem, lam);
  }
}


#define XB_TMO      128
#define XB_XCNT(j)  (256  + 64 * (j))
#define XB_XSUB(j)  (1280 + 64 * (j))
#define XB_XGEN(j)  (2304 + 64 * (j))
#define XB_TOP      3328
#define XB_TOPGEN   3392
#define XCD_BAR_WORDS 3456
#define XB_SPIN_CAP (1u << 18)
#define LAS __attribute__((address_space(3)))
DI unsigned xb_ld(unsigned* p)              { return __hip_atomic_load(p, __ATOMIC_RELAXED, __HIP_MEMORY_SCOPE_AGENT); }
DI unsigned xb_add(unsigned* p, unsigned v) { return __hip_atomic_fetch_add(p, v, __ATOMIC_RELAXED, __HIP_MEMORY_SCOPE_AGENT); }
DI unsigned xb_xcc_id() { return (unsigned)__builtin_amdgcn_s_getreg((3 << 11) | 20) & 0xFu; }
#define XB_SPIN(cond, bar) do { unsigned _sp = 0; while (cond) { __builtin_amdgcn_s_sleep(1); \
    if ((++_sp & 255u) == 0u) { if (xb_ld(&(bar)[XB_TMO])) break; if (_sp > XB_SPIN_CAP) { atomicAdd(&(bar)[XB_TMO], 1u); break; } } } } while (0)
struct XcdBarrier { unsigned* bar; unsigned x; volatile LAS unsigned* st; };
DI XcdBarrier xcd_barrier_post(unsigned* bar, volatile LAS unsigned* st) {
    XcdBarrier b; b.bar = bar; b.x = xb_xcc_id(); b.st = st;
    if (threadIdx.x == 0) (void)xb_add(&bar[XB_XCNT(b.x)], 1u);
    return b;
}
DI void xcd_barrier_complete(unsigned* bar, unsigned x, unsigned& nloc, unsigned& nx) {
    const unsigned G = gridDim.x * gridDim.y * gridDim.z;
    unsigned sum, cnt, mine, sp = 0u;
    for (;;) {
        sum = 0u; cnt = 0u; mine = 0u;
#pragma unroll
        for (unsigned j = 0; j < 16; ++j) { const unsigned c = xb_ld(&bar[XB_XCNT(j)]); sum += c; cnt += (c > 0u) ? 1u : 0u; mine = (j == x) ? c : mine; }
        if (sum == G) break;
        __builtin_amdgcn_s_sleep(1);
        if ((++sp & 255u) == 0u) { if (xb_ld(&bar[XB_TMO])) break; if (sp > XB_SPIN_CAP) { atomicAdd(&bar[XB_TMO], 1u); break; } }
    }
    nloc = mine > 0u ? mine : 1u; nx = cnt > 0u ? cnt : 1u;
}
DI void xcd_barrier(const XcdBarrier& b) {
    asm volatile("s_waitcnt vmcnt(0)" ::: "memory");
    __syncthreads();
    if (threadIdx.x == 0) {
        unsigned* bar = b.bar;
        __builtin_amdgcn_s_waitcnt(0);
        unsigned nloc = b.st[0], nx = b.st[1];
        if (nloc == 0u) { xcd_barrier_complete(bar, b.x, nloc, nx); b.st[0] = nloc; b.st[1] = nx; }
        const unsigned old = xb_add(&bar[XB_XSUB(b.x)], 1u);
        const unsigned gen = old / nloc;
        if (old + 1u == (gen + 1u) * nloc) {
            __builtin_amdgcn_fence(__ATOMIC_RELEASE, "agent");
            asm volatile("s_waitcnt vmcnt(0)" ::: "memory");
            const unsigned og = xb_add(&bar[XB_TOP], 1u);
            const unsigned tg = og / nx;
            if (og + 1u == (tg + 1u) * nx) xb_add(&bar[XB_TOPGEN], 1u);
            else XB_SPIN(xb_ld(&bar[XB_TOPGEN]) == tg, bar);
            __builtin_amdgcn_fence(__ATOMIC_ACQUIRE, "agent");
            xb_add(&bar[XB_XGEN(b.x)], 1u);
            asm volatile("s_waitcnt vmcnt(0)" ::: "memory");
        } else {
            XB_SPIN(xb_ld(&bar[XB_XGEN(b.x)]) == gen, bar);
            __builtin_amdgcn_fence(__ATOMIC_ACQUIRE, "agent");
            asm volatile("s_waitcnt vmcnt(0)" ::: "memory");
        }
    }
    __syncthreads();
}

__global__ void __launch_bounds__(NTHR) mega(Params p) {
  __shared__ __attribute__((aligned(16))) char smem[SMEM_BYTES];
  cg::grid_group grid = cg::this_grid();
  __shared__ uint4 xb_words;
  if (threadIdx.x == 0) xb_words = make_uint4(0u, 0u, 0u, 0u);
  __syncthreads();
  const XcdBarrier xb = xcd_barrier_post(p.bar, (volatile LAS unsigned*)&xb_words);
  for (int ph = p.ph_lo; ph < p.ph_hi; ++ph) {
    if (ph > p.ph_lo) { if (p.ph_hi < 0) grid.sync(); else xcd_barrier(xb); }
    const int code = p.prog[ph];
    const int layer = (code >> 4) & 15, op = code & 15;
    const bool last = layer == 3;
    const float gs = (code & 256) ? 0.f : 1.f;
    switch (op) {
      case OP_PRO: prologue(p, smem); break;
      case OP_NORM1: norm_phase(p, layer, 0, false); break;
      case OP_QKV: qkv_phase(p, layer, smem); break;
      case OP_MLA_DOWN: mla_down_phase(p, smem); break;
      case OP_MLA_UP: mla_up_phase(p, smem); break;
      case OP_ATTN:
        if (layer == 0) attn_phase_mfma<0>(p, false, smem);
        else if (layer == 1) attn_phase_mfma<1>(p, false, smem);
        else if (layer == 2) attn_phase_mfma<2>(p, false, smem);
        else attn_phase_mfma<3>(p, true, smem);
        break;
      case OP_OPROJ: resid_gemm_phase(p, layer, p.AO, DM, DM, p.Wo[layer], 2, last, smem, gs); break;
      case OP_NORM2: norm_phase(p, layer, 1, last); break;
      case OP_FFN_UP: ffn_up_phase(p, layer, last, smem); break;
      case OP_FFN_DOWN: resid_gemm_phase(p, layer, p.G, DFF, DFF, p.Wdn[layer], 5, last, smem, gs); break;
      case OP_FINAL: final_phase(p); break;
      default: break;
    }
  }
}

static inline size_t al256(size_t x) { return (x + 255) & ~(size_t)255; }

extern "C" void kernel_launch(void* const* d_in, const int* in_sizes, int n_in, void* d_out, int out_size, void* d_ws,
                              size_t ws_size, hipStream_t stream) {
  Params p;
  memset(&p, 0, sizeof(p));
  auto F = [&](int i) { return (const float*)d_in[i]; };
  p.x = F(0); p.c = F(1); p.ctx = F(2); p.c_ctx = F(3); p.ada_w = F(4); p.ada_b = F(5); p.norm1_g = F(6); p.norm2_g = F(7);
  const float* ffn_up = F(8); p.conv_w = F(9); p.conv_b = F(10); const float* ffn_down = F(11);
  const float* a_w_qkv = F(12); const float* a_w_o = F(13);
  p.a_lq1 = F(14); p.a_lk1 = F(15); p.a_lq2 = F(16); p.a_lk2 = F(17); p.a_subln = F(18);
  const float* b_w_qkv = F(19); const float* b_w_o = F(20); p.b_sink = F(21);
  const float* c_w_down = F(22); const float* c_qg = F(23); const float* c_kvg = F(24);
  const float* c_w_uq = F(25); const float* c_w_ukv = F(26); const float* c_w_o = F(27);
  const float* d_w_qkv = F(28); p.d_qg = F(29); p.d_kg = F(30); const float* d_w_o = F(31);
  p.final_g = F(32);
  p.out = (float*)d_out;

  char* ws = (char*)d_ws; size_t off = 0;
  auto take = [&](size_t bytes) { char* r = ws + off; off = al256(off + bytes); return r; };
  p.bar = (unsigned*)take((size_t)XCD_BAR_WORDS * 4);
  p.Rctx = (float*)take((size_t)NBATCH * CTXL * DM * 4);
  p.MOD = (float*)take((size_t)4 * 9 * 6144 * 4);
  p.rope64 = (float*)take((size_t)131072 * 4);
  p.rope128 = (float*)take((size_t)262144 * 4);
  p.H = (u16*)take((size_t)T * DM * 2 + 4096);
  char* region = take((size_t)T * 2560 * 2 + (size_t)T * 1024 * 2 * 2 + (size_t)T * 768 * 2 + (size_t)T * 64 * 2);
  p.QK = (u16*)region;
  p.Vt = p.QK + (size_t)T * 2560;
  p.AO = p.Vt + (size_t)T * 1024;
  p.T1 = p.AO + (size_t)T * 1024;
  p.KR = p.T1 + (size_t)T * 768;
  p.G = (u16*)region;
  for (int l = 0; l < 4; ++l) {
    p.Wup[l] = (u16*)take((size_t)5632 * 1024 * 2);
    p.Wdn[l] = (u16*)take((size_t)1024 * 2816 * 2);
    p.Wo[l] = (u16*)take((size_t)1024 * 1024 * 2);
  }
  p.Wa_qkv = (u16*)take((size_t)3072 * 1024 * 2);
  p.Wb_qkv = (u16*)take((size_t)1536 * 1024 * 2);
  p.Wc_d = (u16*)take((size_t)768 * 1024 * 2);
  p.Wc_uq = (u16*)take((size_t)1536 * 384 * 2);
  p.Wc_uk = (u16*)take((size_t)1024 * 256 * 2);
  p.Wc_uv = (u16*)take((size_t)1024 * 256 * 2);
  p.Wd_qkv = (u16*)take((size_t)2048 * 1024 * 2);
  if (off > ws_size) { fprintf(stderr, "workspace too small: need %zu have %zu\n", off, ws_size); return; }

  int nj = 0, tiles = 0;
  auto job = [&](const float* src, u16* dst, const float* g, int K, int N, int ld, int grp, int gstride, int o, int mode) {
    Job& j = p.jobs[nj++];
    j.src = src; j.dst = dst; j.g = g; j.K = K; j.N = N; j.ld = ld; j.grp = grp; j.gstride = gstride; j.off = o; j.mode = mode; j.tile0 = tiles;
    tiles += (K / 64) * (N / 64);
  };
  const int BIG = 1 << 30;
  const float* wo_src[4] = {a_w_o, b_w_o, c_w_o, d_w_o};
  for (int l = 0; l < 4; ++l) {
    p.ltile[l] = tiles;
    if (l == 0) job(a_w_qkv, p.Wa_qkv, nullptr, 1024, 3072, 3072, BIG, 0, 0, 0);
    if (l == 1) job(b_w_qkv, p.Wb_qkv, nullptr, 1024, 1536, 1536, BIG, 0, 0, 0);
    if (l == 2) {
      job(c_w_down, p.Wc_d, nullptr, 1024, 768, 704, BIG, 0, 0, 2);
      job(c_w_uq, p.Wc_uq, c_qg, 384, 1536, 1536, BIG, 0, 0, 0);
      job(c_w_ukv, p.Wc_uk, c_kvg, 256, 1024, 2048, 128, 256, 0, 0);
      job(c_w_ukv, p.Wc_uv, c_kvg, 256, 1024, 2048, 128, 256, 128, 0);
    }
    if (l == 3) job(d_w_qkv, p.Wd_qkv, nullptr, 1024, 2048, 2048, BIG, 0, 0, 0);
    job(wo_src[l], p.Wo[l], nullptr, 1024, 1024, 1024, BIG, 0, 0, 0);
    job(ffn_up + (size_t)l * 1024 * 5632, p.Wup[l], nullptr, 1024, 5632, 5632, BIG, 0, 0, 1);
    job(ffn_down + (size_t)l * 2816 * 1024, p.Wdn[l], nullptr, 2816, 1024, 1024, BIG, 0, 0, 0);
  }
  p.ltile[4] = tiles; p.ltile[5] = 0;
  p.njobs = nj; p.conv_tiles = tiles;

  int np = 0;
  p.prog[np++] = OP_PRO;
  for (int l = 0; l < 4; ++l) {
    p.prog[np++] = l * 16 + OP_NORM1;
    if (l == 2) { p.prog[np++] = l * 16 + OP_MLA_DOWN; p.prog[np++] = l * 16 + OP_MLA_UP; }
    else p.prog[np++] = l * 16 + OP_QKV;
    p.prog[np++] = l * 16 + OP_ATTN;
    p.prog[np++] = l * 16 + OP_OPROJ;
    p.prog[np++] = l * 16 + OP_NORM2;
    p.prog[np++] = l * 16 + OP_FFN_UP;
    p.prog[np++] = l * 16 + OP_FFN_DOWN;
  }
  p.prog[np++] = 3 * 16 + OP_FINAL;
#ifdef PROBE_DUP_OP
  {
    int tmp[48]; int n2 = 0;
    for (int i = 0; i < np; ++i) { tmp[n2++] = p.prog[i]; if ((p.prog[i] & 15) == PROBE_DUP_OP) tmp[n2++] = p.prog[i] | 256; }
    for (int i = 0; i < n2; ++i) p.prog[i] = tmp[i];
    np = n2;
  }
#endif
  p.nprog = np;

  static int grid_blocks = 0;
  if (!grid_blocks) {
    int dev = 0, cus = 0, per_cu = 0;
    hipGetDevice(&dev);
    hipDeviceGetAttribute(&cus, hipDeviceAttributeMultiprocessorCount, dev);
    hipOccupancyMaxActiveBlocksPerMultiprocessor(&per_cu, mega, NTHR, 0);
    if (per_cu < 1) per_cu = 1;
    grid_blocks = cus * per_cu;
  }
#if MULTI_LAUNCH
  for (int ph = 0; ph < np; ++ph) {
    p.ph_lo = ph; p.ph_hi = ph + 1;
    hipLaunchKernelGGL(mega, dim3(grid_blocks), dim3(NTHR), 0, stream, p);
  }
#else
  p.ph_lo = 0; p.ph_hi = np;
  hipMemsetAsync(p.bar, 0, (size_t)XCD_BAR_WORDS * 4, stream);
  void* args[] = {&p};
  hipError_t e = hipLaunchCooperativeKernel((void*)mega, dim3(grid_blocks), dim3(NTHR), args, 0, stream);
  if (e != hipSuccess) fprintf(stderr, "cooperative launch failed: %s (grid %d)\n", hipGetErrorString(e), grid_blocks);
#endif
}
```

```cpp
#include <hip/hip_runtime.h>
#include <hip/hip_cooperative_groups.h>
#include <cstdio>
#include <cstring>
namespace cg = cooperative_groups;

#ifndef REF_ATTN
#define REF_ATTN 0
#endif
#ifndef MULTI_LAUNCH
#define MULTI_LAUNCH 0
#endif

typedef unsigned short u16;
using bf16x8 = __attribute__((ext_vector_type(8))) short;
using f32x16 = __attribute__((ext_vector_type(16))) float;
using u32x4 = __attribute__((ext_vector_type(4))) unsigned;
using u32x2 = __attribute__((ext_vector_type(2))) unsigned;
using f32x4 = __attribute__((ext_vector_type(4))) float;
using f32x2 = __attribute__((ext_vector_type(2))) float;
#define DI __device__ __forceinline__
DI int threadIdx_x_raw() { return (int)__builtin_amdgcn_workitem_id_x(); }

constexpr int DM = 1024, NBATCH = 8, SEQ = 2048, CTXL = 256, TPB = 2304, T = 18432, DFF = 2816;
constexpr int NTHR = 512;
constexpr int CLD = 260;
constexpr int STAGE_BYTES = 131072;
constexpr int BND_OFF = 128 * CLD * 4;
constexpr int RS_OFF = BND_OFF + 4 * 256 * 4;
constexpr int SMEM_BYTES = RS_OFF + 1024;
constexpr float EPS = 1e-6f;

enum { OP_PRO = 0, OP_NORM1, OP_QKV, OP_MLA_DOWN, OP_MLA_UP, OP_ATTN, OP_OPROJ, OP_NORM2, OP_FFN_UP, OP_FFN_DOWN, OP_FINAL };

struct Job { const float* src; u16* dst; const float* g; int K, N, ld, grp, gstride, off, mode, tile0; };

struct Params {
  const float *x, *c, *ctx, *c_ctx, *ada_w, *ada_b, *norm1_g, *norm2_g, *conv_w, *conv_b;
  const float *a_lq1, *a_lk1, *a_lq2, *a_lk2, *a_subln, *b_sink, *d_qg, *d_kg, *final_g;
  float *out, *Rctx, *MOD, *rope64, *rope128;
  u16 *H, *QK, *Vt, *AO, *T1, *KR, *G;
  unsigned* bar;
  u16 *Wup[4], *Wdn[4], *Wo[4];
  u16 *Wa_qkv, *Wb_qkv, *Wc_d, *Wc_uq, *Wc_uk, *Wc_uv, *Wd_qkv;
  Job jobs[20];
  int njobs, conv_tiles, nprog, ph_lo, ph_hi, pad0;
  int ltile[6];
  int prog[48];
};

DI int tidx() { int t = threadIdx_x_raw(); asm volatile("" : "+v"(t)); return t; }
DI u16 f2bf(float x) { unsigned u = __float_as_uint(x); u += 0x7fffu + ((u >> 16) & 1u); return (u16)(u >> 16); }
DI float bf2f(u16 h) { return __uint_as_float(((unsigned)h) << 16); }
DI float bflo(unsigned w) { return __uint_as_float(w << 16); }
DI float bfhi(unsigned w) { return __uint_as_float(w & 0xffff0000u); }
DI unsigned pack2(float a, float b) { unsigned r; asm("v_cvt_pk_bf16_f32 %0, %1, %2" : "=v"(r) : "v"(a), "v"(b)); return r; }
DI float wave_sum(float v) { for (int o = 32; o; o >>= 1) v += __shfl_xor(v, o); return v; }
DI float wave_max(float v) { for (int o = 32; o; o >>= 1) v = fmaxf(v, __shfl_xor(v, o)); return v; }
DI void swap32(float x, float& lo, float& hi) {
  auto r = __builtin_amdgcn_permlane32_swap(__float_as_uint(x), __float_as_uint(x), false, false);
  lo = __uint_as_float(r[0]); hi = __uint_as_float(r[1]);
}
DI float xmax32(float x) { float a, b; swap32(x, a, b); return fmaxf(a, b); }
DI float xsum32(float x) { float a, b; swap32(x, a, b); return a + b; }
DI float siluf(float v) { return v * __builtin_amdgcn_rcpf(1.f + __expf(-v)); }

DI float* rrow(const Params& p, int t) {
  int b = t / TPB, r = t - b * TPB;
  return r < CTXL ? p.Rctx + (size_t)(b * CTXL + r) * DM : p.out + (size_t)(b * SEQ + r - CTXL) * DM;
}
DI const float* xrow(const Params& p, int t) {
  int b = t / TPB, r = t - b * TPB;
  const float* px = p.x; const float* pc = p.ctx;
  asm volatile("" : "+s"(px), "+s"(pc));
  return r < CTXL ? pc + (size_t)(b * CTXL + r) * DM : px + (size_t)(b * SEQ + r - CTXL) * DM;
}
DI int modrow(int t) { int b = t / TPB, r = t - b * TPB; return r < CTXL ? 8 : b; }
DI int lat_token(int li) { int b = li >> 11; return b * TPB + CTXL + (li & 2047); }

struct CvT { const float* src; u16* dst; const float* g; int ld, K, k0, n0, col; bool ok, okcol; };
DI CvT cv_decode(const Params& p, int tile, bool ok, int t) {
  CvT c;
  int jb = 0;
  for (int q = 1; q < p.njobs; ++q) if (tile >= p.jobs[q].tile0) jb = q;
  const Job& j = p.jobs[jb];
  const int tl = tile - j.tile0;
  const int ntn = j.N >> 6;
  const int kt = tl / ntn, nt = tl - kt * ntn;
  c.k0 = kt * 64; c.n0 = nt * 64;
  const int n = c.n0 + (t & 63);
  c.okcol = true;
  if (j.mode == 1) c.col = (n >> 8) * 128 + (n & 127) + ((n >> 7) & 1) * DFF;
  else if (j.mode == 2) { c.col = n; c.okcol = n < 704; }
  else c.col = (n / j.grp) * j.gstride + (n % j.grp) + j.off;
  c.src = j.src; c.dst = j.dst; c.g = j.g; c.ld = j.ld; c.K = j.K; c.ok = ok;
  return c;
}
DI void convert_tiles(const Params& p, int tile0, int ntiles, char* smem) {
  const int tid = tidx();
  const int half = tid >> 8, t = tid & 255;
  const int nl = t & 63, kk = t >> 6;
  const int tA = tile0 + half * 2, tB = tA + 1;
  const CvT ca = cv_decode(p, tA < ntiles ? tA : 0, tA < ntiles, t), cb = cv_decode(p, tB < ntiles ? tB : 0, tB < ntiles, t);
  float* stA = (float*)smem + (half * 2) * (64 * 65); float* stB = stA + 64 * 65;
  float va[16], vb[16];
#pragma unroll
  for (int i = 0; i < 16; ++i) va[i] = (ca.ok && ca.okcol) ? ca.src[(size_t)(ca.k0 + kk + 4 * i) * ca.ld + ca.col] : 0.f;
#pragma unroll
  for (int i = 0; i < 16; ++i) vb[i] = (cb.ok && cb.okcol) ? cb.src[(size_t)(cb.k0 + kk + 4 * i) * cb.ld + cb.col] : 0.f;
#pragma unroll
  for (int i = 0; i < 16; ++i) {
    const int kl = kk + 4 * i;
    float x = va[i]; if (ca.g) x *= ca.g[ca.k0 + kl];
    stA[kl * 65 + nl] = x;
    float y = vb[i]; if (cb.g) y *= cb.g[cb.k0 + kl];
    stB[kl * 65 + nl] = y;
  }
  __syncthreads();
  {
    const int n2 = t >> 2, kc = t & 3;
    if (ca.ok) {
      unsigned w[8];
#pragma unroll
      for (int i = 0; i < 8; ++i) w[i] = pack2(stA[(kc * 16 + 2 * i) * 65 + n2], stA[(kc * 16 + 2 * i + 1) * 65 + n2]);
      u32x4* d = (u32x4*)(ca.dst + (size_t)(ca.n0 + n2) * ca.K + ca.k0 + kc * 16);
      d[0] = u32x4{w[0], w[1], w[2], w[3]}; d[1] = u32x4{w[4], w[5], w[6], w[7]};
    }
    if (cb.ok) {
      unsigned w[8];
#pragma unroll
      for (int i = 0; i < 8; ++i) w[i] = pack2(stB[(kc * 16 + 2 * i) * 65 + n2], stB[(kc * 16 + 2 * i + 1) * 65 + n2]);
      u32x4* d = (u32x4*)(cb.dst + (size_t)(cb.n0 + n2) * cb.K + cb.k0 + kc * 16);
      d[0] = u32x4{w[0], w[1], w[2], w[3]}; d[1] = u32x4{w[4], w[5], w[6], w[7]};
    }
  }
  __syncthreads();
}

DI void mod_item2(const Params& p, int item, bool ok_item, char* smem) {
  float* ss = (float*)smem;
  const int tid = tidx();
  const int half = tid >> 8, t = tid & 255;
  float* red = ss + 9 * 1024 + half * (4 * 576);
  const int layer = item / 96, n0 = (item % 96) * 64;
  for (int i = tid; i < 9 * 1024; i += NTHR) {
    int r = i >> 10, k = i & 1023;
    float v = r < 8 ? p.c[r * 1024 + k] : p.c_ctx[k];
    ss[i] = siluf(v);
  }
  __syncthreads();
  const int cq = t & 15, kg = t >> 4;
  f32x4 acc[9];
#pragma unroll
  for (int r = 0; r < 9; ++r) acc[r] = f32x4{0.f, 0.f, 0.f, 0.f};
  if (ok_item) {
    const float* w = p.ada_w + (size_t)layer * 1024 * 6144 + n0 + cq * 4 + (size_t)(kg * 64) * 6144;
#pragma unroll 1
    for (int kb = 0; kb < 64; kb += 8) {
      f32x4 wv[8];
#pragma unroll
      for (int u = 0; u < 8; ++u) wv[u] = *(const f32x4*)(w + (size_t)(kb + u) * 6144);
#pragma unroll
      for (int u = 0; u < 8; ++u) {
        const int k = kg * 64 + kb + u;
#pragma unroll
        for (int r = 0; r < 9; ++r) acc[r] += ss[r * 1024 + k] * wv[u];
      }
    }
  }
#pragma unroll
  for (int r = 0; r < 9; ++r)
#pragma unroll
    for (int e = 0; e < 4; ++e) {
      float x = acc[r][e];
      x += __shfl_xor(x, 16); x += __shfl_xor(x, 32);
      acc[r][e] = x;
    }
  const int wv4 = t >> 6, lane = t & 63;
  if (lane < 16) {
#pragma unroll
    for (int r = 0; r < 9; ++r) *(f32x4*)(red + (wv4 * 9 + r) * 64 + lane * 4) = acc[r];
  }
  __syncthreads();
  if (ok_item) {
    for (int i = t; i < 576; i += 256) {
      int c = i & 63;
      float v = red[i] + red[576 + i] + red[1152 + i] + red[1728 + i] + p.ada_b[layer * 6144 + n0 + c];
      p.MOD[((size_t)layer * 9 + (i >> 6)) * 6144 + n0 + c] = v;
    }
  }
  __syncthreads();
}

DI void sincos_acc(float ang, float& c, float& s) {
  float k = rintf(ang * 0.15915494309189535f);
  float x = fmaf(-k, 6.28318548202514648f, ang);
  x = fmaf(-k, -1.7484555e-7f, x);
  c = __cosf(x); s = __sinf(x);
}

DI void rope_item(const Params& p, int item) {
  int e = item * NTHR + tidx();
  if (e < 65536) {
    int pos = e >> 5, i = e & 31;
    int f = i & 15; float posv = (i < 16) ? (float)(pos >> 6) : (float)(pos & 63);
    float inv = exp2f(-(float)f / 16.f * 13.287712379549449f);
    float c, s; sincos_acc(posv * inv, c, s);
    p.rope64[e] = c; p.rope64[65536 + e] = s;
  } else {
    e -= 65536;
    int pos = e >> 6, i = e & 63;
    int f = i & 31; float posv = (i < 32) ? (float)(pos >> 6) : (float)(pos & 63);
    float inv = exp2f(-(float)f / 32.f * 13.287712379549449f);
    float c, s; sincos_acc(posv * inv, c, s);
    p.rope128[e] = c; p.rope128[131072 + e] = s;
  }
}

DI void prologue(const Params& p, char* smem) {
  const int n_mod2 = 48, n_rope = 384;
  const int G = gridDim.x;
#pragma unroll 1
  for (int i = blockIdx.x; i < n_mod2; i += G) mod_item2(p, 2 * i + (tidx() >> 8), true, smem);
  const int nconv0 = p.ltile[1];
  const int nct2 = (nconv0 + 3) >> 2;
  int start = (blockIdx.x + G - (n_mod2 % G)) % G;
#pragma unroll 1
  for (int i = start; i < nct2; i += G) convert_tiles(p, 4 * i, nconv0, smem);
#pragma unroll 1
  for (int i = blockIdx.x; i < n_rope; i += G) rope_item(p, i);
}

DI void norm_phase(const Params& p, int layer, int which  , bool lat_only) {
  const int lane = tidx() & 63, wave = tidx() >> 6;
  const int nrows = lat_only ? SEQ : TPB;
  const int grp8 = blockIdx.x & 7, slot = blockIdx.x >> 3, per = gridDim.x >> 3;
  const int tbase = grp8 * TPB + (lat_only ? CTXL : 0);
  const float* g = (which ? p.norm2_g : p.norm1_g) + layer * DM;
#pragma unroll 1
  for (int it = slot; it * 16 < nrows && slot < per; it += per) {
    f32x4 v[2][4];
    int tt[2];
#pragma unroll
    for (int u = 0; u < 2; ++u) {
      int ri = it * 16 + wave * 2 + u;
      tt[u] = tbase + ri;
      const float* xr = (layer == 0 && which == 0) ? xrow(p, tt[u]) : (const float*)rrow(p, tt[u]);
#pragma unroll
      for (int q = 0; q < 2; ++q) {
        v[u][2 * q] = *(const f32x4*)(xr + q * 512 + lane * 8);
        v[u][2 * q + 1] = *(const f32x4*)(xr + q * 512 + lane * 8 + 4);
      }
    }
#pragma unroll
    for (int u = 0; u < 2; ++u) {
      const int t = tt[u];
      const float* md = p.MOD + ((size_t)layer * 9 + modrow(t)) * 6144 + which * 3072;
      float ss = 0;
#pragma unroll
      for (int q = 0; q < 4; ++q) ss += v[u][q][0] * v[u][q][0] + v[u][q][1] * v[u][q][1] + v[u][q][2] * v[u][q][2] + v[u][q][3] * v[u][q][3];
      ss = wave_sum(ss);
      const float rstd = rsqrtf(ss * (1.f / DM) + EPS);
#pragma unroll
      for (int q = 0; q < 2; ++q) {
        const int cidx = q * 512 + lane * 8;
        unsigned w[4];
#pragma unroll
        for (int e = 0; e < 2; ++e) {
          const f32x4 gg = *(const f32x4*)(g + cidx + 4 * e);
          const f32x4 sh = *(const f32x4*)(md + cidx + 4 * e);
          const f32x4 sc = *(const f32x4*)(md + 1024 + cidx + 4 * e);
          const f32x4 y = v[u][2 * q + e] * rstd * gg * (sc + 1.f) + sh;
          w[2 * e] = pack2(y[0], y[1]); w[2 * e + 1] = pack2(y[2], y[3]);
        }
        *(u32x4*)(p.H + (size_t)t * DM + cidx) = u32x4{w[0], w[1], w[2], w[3]};
      }
    }
  }
}

DI void final_phase(const Params& p) {
  const int lane = tidx() & 63, wave = tidx() >> 6;
  const int grp8 = blockIdx.x & 7, slot = blockIdx.x >> 3, per = gridDim.x >> 3;
#pragma unroll 1
  for (int it = slot; it * 8 < SEQ && slot < per; it += per) {
    int ri = grp8 * SEQ + it * 8 + wave;
    float* xr = p.out + (size_t)ri * DM;
    float4 v[4]; float ss = 0;
#pragma unroll
    for (int q = 0; q < 4; ++q) {
      v[q] = *(const float4*)(xr + q * 256 + lane * 4);
      ss += v[q].x * v[q].x + v[q].y * v[q].y + v[q].z * v[q].z + v[q].w * v[q].w;
    }
    ss = wave_sum(ss);
    float rstd = rsqrtf(ss * (1.f / DM) + EPS);
#pragma unroll
    for (int q = 0; q < 4; ++q) {
      int cidx = q * 256 + lane * 4;
      float4 gg = *(const float4*)(p.final_g + cidx);
      float4 o = {v[q].x * rstd * gg.x, v[q].y * rstd * gg.y, v[q].z * rstd * gg.z, v[q].w * rstd * gg.w};
      *(float4*)(xr + cidx) = o;
    }
  }
}

DI int swz128(int row, int chunk) { return row * 128 + ((chunk ^ ((row >> 1) & 7)) << 4); }


DI void mma_ktile(f32x16 (&acc)[4][2], unsigned a0, unsigned a1, unsigned a2, unsigned a3, unsigned b0, unsigned b1, unsigned b2, unsigned b3) {
  u32x4 f0, f1, f2, f3, f4, f5, f6, f7, f8, f9;
  asm volatile(
      "ds_read_b128 %8, %18 offset:0\n\t"
      "ds_read_b128 %9, %18 offset:4096\n\t"
      "ds_read_b128 %10, %18 offset:8192\n\t"
      "ds_read_b128 %11, %18 offset:12288\n\t"
      "ds_read_b128 %16, %22 offset:0\n\t"
      "ds_read_b128 %17, %22 offset:4096\n\t"
      "ds_read_b128 %12, %19 offset:0\n\t"
      "ds_read_b128 %13, %19 offset:4096\n\t"
      "ds_read_b128 %14, %19 offset:8192\n\t"
      "ds_read_b128 %15, %19 offset:12288\n\t"
      "s_waitcnt lgkmcnt(4)\n\t"
      "v_mfma_f32_32x32x16_bf16 %0, %8, %16, %0\n\t"
      "v_mfma_f32_32x32x16_bf16 %2, %9, %16, %2\n\t"
      "v_mfma_f32_32x32x16_bf16 %4, %10, %16, %4\n\t"
      "v_mfma_f32_32x32x16_bf16 %6, %11, %16, %6\n\t"
      "ds_read_b128 %16, %23 offset:0\n\t"
      "v_mfma_f32_32x32x16_bf16 %1, %8, %17, %1\n\t"
      "v_mfma_f32_32x32x16_bf16 %3, %9, %17, %3\n\t"
      "v_mfma_f32_32x32x16_bf16 %5, %10, %17, %5\n\t"
      "v_mfma_f32_32x32x16_bf16 %7, %11, %17, %7\n\t"
      "ds_read_b128 %17, %23 offset:4096\n\t"
      "ds_read_b128 %8, %20 offset:0\n\t"
      "ds_read_b128 %9, %20 offset:4096\n\t"
      "ds_read_b128 %10, %20 offset:8192\n\t"
      "ds_read_b128 %11, %20 offset:12288\n\t"
      "s_waitcnt lgkmcnt(5)\n\t"
      "v_mfma_f32_32x32x16_bf16 %0, %12, %16, %0\n\t"
      "v_mfma_f32_32x32x16_bf16 %2, %13, %16, %2\n\t"
      "v_mfma_f32_32x32x16_bf16 %4, %14, %16, %4\n\t"
      "v_mfma_f32_32x32x16_bf16 %6, %15, %16, %6\n\t"
      "ds_read_b128 %16, %24 offset:0\n\t"
      "s_waitcnt lgkmcnt(5)\n\t"
      "v_mfma_f32_32x32x16_bf16 %1, %12, %17, %1\n\t"
      "v_mfma_f32_32x32x16_bf16 %3, %13, %17, %3\n\t"
      "v_mfma_f32_32x32x16_bf16 %5, %14, %17, %5\n\t"
      "v_mfma_f32_32x32x16_bf16 %7, %15, %17, %7\n\t"
      "ds_read_b128 %17, %24 offset:4096\n\t"
      "ds_read_b128 %12, %21 offset:0\n\t"
      "ds_read_b128 %13, %21 offset:4096\n\t"
      "ds_read_b128 %14, %21 offset:8192\n\t"
      "ds_read_b128 %15, %21 offset:12288\n\t"
      "s_waitcnt lgkmcnt(5)\n\t"
      "v_mfma_f32_32x32x16_bf16 %0, %8, %16, %0\n\t"
      "v_mfma_f32_32x32x16_bf16 %2, %9, %16, %2\n\t"
      "v_mfma_f32_32x32x16_bf16 %4, %10, %16, %4\n\t"
      "v_mfma_f32_32x32x16_bf16 %6, %11, %16, %6\n\t"
      "ds_read_b128 %16, %25 offset:0\n\t"
      "s_waitcnt lgkmcnt(5)\n\t"
      "v_mfma_f32_32x32x16_bf16 %1, %8, %17, %1\n\t"
      "v_mfma_f32_32x32x16_bf16 %3, %9, %17, %3\n\t"
      "v_mfma_f32_32x32x16_bf16 %5, %10, %17, %5\n\t"
      "v_mfma_f32_32x32x16_bf16 %7, %11, %17, %7\n\t"
      "ds_read_b128 %17, %25 offset:4096\n\t"
      "s_waitcnt lgkmcnt(1)\n\t"
      "v_mfma_f32_32x32x16_bf16 %0, %12, %16, %0\n\t"
      "v_mfma_f32_32x32x16_bf16 %2, %13, %16, %2\n\t"
      "v_mfma_f32_32x32x16_bf16 %4, %14, %16, %4\n\t"
      "v_mfma_f32_32x32x16_bf16 %6, %15, %16, %6\n\t"
      "s_waitcnt lgkmcnt(0)\n\t"
      "v_mfma_f32_32x32x16_bf16 %1, %12, %17, %1\n\t"
      "v_mfma_f32_32x32x16_bf16 %3, %13, %17, %3\n\t"
      "v_mfma_f32_32x32x16_bf16 %5, %14, %17, %5\n\t"
      "v_mfma_f32_32x32x16_bf16 %7, %15, %17, %7\n\t"
      "s_nop 15\n\t"
      "s_nop 7\n\t"
      : "+v"(acc[0][0]), "+v"(acc[0][1]), "+v"(acc[1][0]), "+v"(acc[1][1]), "+v"(acc[2][0]), "+v"(acc[2][1]), "+v"(acc[3][0]), "+v"(acc[3][1]),
        "=&v"(f0), "=&v"(f1), "=&v"(f2), "=&v"(f3), "=&v"(f4), "=&v"(f5), "=&v"(f6), "=&v"(f7), "=&v"(f8), "=&v"(f9)
      : "v"(a0), "v"(a1), "v"(a2), "v"(a3), "v"(b0), "v"(b1), "v"(b2), "v"(b3)
      : "memory");
}

struct NoPre { DI void operator()() const {} };
struct NextTile { const u16* Ap; const u16* Bp; int vlo, vhi; };
template <bool BND, class Epi, class Pre = NoPre>
DI void gemm_tile(const u16* __restrict__ Ap, int lda, int vlo, int vhi, const u16* __restrict__ Bp, int ldb, int K,
                  char* smem, NextTile nx, Epi&& epi, Pre&& pre = Pre()) {
  const int tid = tidx(), lane = tid & 63, wave = tid >> 6;
  const int wm = wave >> 2, wn = wave & 3;
  const int lr = tid >> 3, lc = tid & 7;
  f32x16 acc[4][2];
#pragma unroll
  for (int i = 0; i < 4; ++i)
#pragma unroll
    for (int j = 0; j < 2; ++j)
#pragma unroll
      for (int r = 0; r < 16; ++r) acc[i][j][r] = 0.f;
  u32x4 ra[4], rb[4];
  const unsigned offA = (unsigned)(lr * lda + lc * 8) * 2u, offB = (unsigned)(lr * ldb + lc * 8) * 2u;
  const unsigned strA = (unsigned)lda * 128u, strB = (unsigned)ldb * 128u;
  auto gload = [&](int k0) {
    const char* Ak = (const char*)Ap + (long)k0 * 2;
    const char* Bk = (const char*)Bp + (long)k0 * 2;
#pragma unroll
    for (int i = 0; i < 4; ++i) {
      int row = lr + 64 * i;
      u32x4 z = {0u, 0u, 0u, 0u};
      if (row >= vlo && row < vhi) z = *(const u32x4*)(Ak + (offA + (unsigned)i * strA));
      ra[i] = z;
      rb[i] = *(const u32x4*)(Bk + (offB + (unsigned)i * strB));
    }
  };
  auto sstore = [&](int buf) {
    char* sA = smem + buf * 65536; char* sB = sA + 32768;
#pragma unroll
    for (int i = 0; i < 4; ++i) {
      int row = lr + 64 * i;
      *(u32x4*)(sA + swz128(row, lc)) = ra[i];
      *(u32x4*)(sB + swz128(row, lc)) = rb[i];
    }
  };
  const int nk = K >> 6;
  const int half = wave >> 2;
  const unsigned lds0 = (unsigned)(size_t)smem;
  const unsigned offl = (unsigned)((lane & 31) * 128);
  const unsigned fx = (unsigned)((lane >> 1) & 7), hh = (unsigned)(lane >> 5);
  const unsigned aw = lds0 + (unsigned)(wm * 128 * 128) + offl, bw = lds0 + 32768u + (unsigned)(wn * 64 * 128) + offl;
  const unsigned o0 = ((0u + hh) ^ fx) << 4, o1 = ((2u + hh) ^ fx) << 4, o2 = ((4u + hh) ^ fx) << 4, o3 = ((6u + hh) ^ fx) << 4;
  auto compute = [&](int buf) {
    const unsigned bo = (unsigned)buf * 65536u;
    mma_ktile(acc, aw + bo + o0, aw + bo + o1, aw + bo + o2, aw + bo + o3, bw + bo + o0, bw + bo + o1, bw + bo + o2, bw + bo + o3);
  };
  gload(0); sstore(0);
  if (nk > 1) gload(64);
  __syncthreads();
#pragma unroll 1
  for (int it = 0; it < nk; ++it) {
    if (half == 0) compute(it & 1);
    else { if (it + 1 < nk) sstore((it + 1) & 1); if (it + 2 < nk) gload((it + 2) * 64); }
    __syncthreads();
    if (half == 1) compute(it & 1);
    else { if (it + 1 < nk) sstore((it + 1) & 1); if (it + 2 < nk) gload((it + 2) * 64); }
    __syncthreads();
  }
  float* sC = (float*)smem;
  const int h = lane >> 5;
  unsigned pf0 = 0u;
  if (nx.Ap != nullptr) {
    const int prow_ = tid & 255;
    const bool isb = tid >= 256;
    const char* pp = isb ? (const char*)(nx.Bp + (long)prow_ * ldb) : (const char*)(nx.Ap + (long)prow_ * lda);
    if (isb || (prow_ >= nx.vlo && prow_ < nx.vhi)) {
      asm volatile("global_load_dword %0, %1, off\n\tglobal_load_dword %0, %1, off offset:128" : "=&v"(pf0) : "v"(pp) : "memory");
    }
  }
  pre();
  if (BND) {
    float* bnd = (float*)(smem + BND_OFF);
#pragma unroll
    for (int j = 0; j < 2; ++j) {
      const int col = wn * 64 + j * 32 + (lane & 31);
      if (h == 0) bnd[(2 * wm) * 256 + col] = acc[0][j][0];
      else bnd[(2 * wm + 1) * 256 + col] = acc[3][j][15];
    }
  }
#pragma unroll
  for (int q = 0; q < 2; ++q) {
    if (wm == q) {
#pragma unroll
      for (int i = 0; i < 4; ++i)
#pragma unroll
        for (int j = 0; j < 2; ++j)
#pragma unroll
          for (int r = 0; r < 16; ++r) {
            int rl = i * 32 + (r & 3) + 8 * (r >> 2) + 4 * h;
            int col = wn * 64 + j * 32 + (lane & 31);
            sC[rl * CLD + col] = acc[i][j][r];
          }
    }
    __syncthreads();
    epi(sC, q);
    __syncthreads();
  }
  asm volatile("s_waitcnt vmcnt(0)" :: "v"(pf0) : "memory");
}

DI void epi_store(const float* sC, int q, u16* dst, long ldd, const float* rowscale  , f32x4 cs) {
  const int lane = tidx() & 63, wave = tidx() >> 6;
#pragma unroll
  for (int rr = 0; rr < 16; ++rr) {
    const int lr = wave * 16 + rr, R = q * 128 + lr;
    f32x4 v = *(const f32x4*)(sC + lr * CLD + lane * 4);
    const float rs = rowscale ? rowscale[R] : 1.f;
    v = v * rs * cs;
    *(u32x2*)(dst + R * ldd + lane * 4) = u32x2{pack2(v[0], v[1]), pack2(v[2], v[3])};
  }
}

DI void epi_rope64(const Params& p, const float* sC, int q, u16* dst, long ldd, int tok0, int ropemask, const float* rowscale) {
  const int lane = tidx() & 63, wave = tidx() >> 6;
  const int rsel = lane >> 5, g = (lane >> 3) & 3, j = lane & 7;
  const int c1 = g * 64 + 4 * j, c2 = c1 + 32;
  const int r0 = tok0 % TPB;
  const bool rot = (r0 >= CTXL) && ((ropemask >> g) & 1);
  f32x4 cs[8], sn[8];
  if (rot) {
#pragma unroll
    for (int rr = 0; rr < 8; ++rr) {
      const int pos = r0 - CTXL + q * 128 + wave * 16 + 2 * rr + rsel;
      cs[rr] = *(const f32x4*)(p.rope64 + pos * 32 + 4 * j);
      sn[rr] = *(const f32x4*)(p.rope64 + 65536 + pos * 32 + 4 * j);
    }
  }
#pragma unroll
  for (int rr = 0; rr < 8; ++rr) {
    const int lr = wave * 16 + 2 * rr + rsel, R = q * 128 + lr;
    const float rs = rowscale ? rowscale[R] : 1.f;
    f32x4 x1 = *(const f32x4*)(sC + lr * CLD + c1) * rs, x2 = *(const f32x4*)(sC + lr * CLD + c2) * rs;
    if (rot) {
      const f32x4 a = x1 * cs[rr] - x2 * sn[rr], b = x1 * sn[rr] + x2 * cs[rr];
      x1 = a; x2 = b;
    }
    *(u32x2*)(dst + R * ldd + c1) = u32x2{pack2(x1[0], x1[1]), pack2(x1[2], x1[3])};
    *(u32x2*)(dst + R * ldd + c2) = u32x2{pack2(x2[0], x2[1]), pack2(x2[2], x2[3])};
  }
}

DI void epi_qknorm128(const Params& p, const float* sC, int q, u16* dst, long ldd, int tok0, const float* gvec) {
  const int lane = tidx() & 63, wave = tidx() >> 6;
  const int rsel = lane >> 5, hd = (lane >> 4) & 1, j = lane & 15;
  const int c1 = hd * 128 + 4 * j, c2 = c1 + 64;
  const int r0 = tok0 % TPB;
  const bool lat = r0 >= CTXL;
  const f32x4 g1 = *(const f32x4*)(gvec + 4 * j), g2 = *(const f32x4*)(gvec + 64 + 4 * j);
  f32x4 cs[8], sn[8];
  if (lat) {
#pragma unroll
    for (int rr = 0; rr < 8; ++rr) {
      const int pos = r0 - CTXL + q * 128 + wave * 16 + 2 * rr + rsel;
      cs[rr] = *(const f32x4*)(p.rope128 + pos * 64 + 4 * j);
      sn[rr] = *(const f32x4*)(p.rope128 + 131072 + pos * 64 + 4 * j);
    }
  }
#pragma unroll
  for (int rr = 0; rr < 8; ++rr) {
    const int lr = wave * 16 + 2 * rr + rsel, R = q * 128 + lr;
    f32x4 x1 = *(const f32x4*)(sC + lr * CLD + c1), x2 = *(const f32x4*)(sC + lr * CLD + c2);
    float ss = x1[0] * x1[0] + x1[1] * x1[1] + x1[2] * x1[2] + x1[3] * x1[3] + x2[0] * x2[0] + x2[1] * x2[1] + x2[2] * x2[2] + x2[3] * x2[3];
    ss += __shfl_xor(ss, 1); ss += __shfl_xor(ss, 2); ss += __shfl_xor(ss, 4); ss += __shfl_xor(ss, 8);
    const float rstd = rsqrtf(ss * (1.f / 128.f) + EPS);
    x1 = x1 * rstd * g1; x2 = x2 * rstd * g2;
    if (lat) {
      const f32x4 a = x1 * cs[rr] - x2 * sn[rr], b = x1 * sn[rr] + x2 * cs[rr];
      x1 = a; x2 = b;
    }
    *(u32x2*)(dst + R * ldd + c1) = u32x2{pack2(x1[0], x1[1]), pack2(x1[2], x1[3])};
    *(u32x2*)(dst + R * ldd + c2) = u32x2{pack2(x2[0], x2[1]), pack2(x2[2], x2[3])};
  }
}

DI void resid_load(const float* Rsrc, int q, int col0, f32x4 (&rv)[16]) {
  const int lane = tidx() & 63, wave = tidx() >> 6;
  const float* R = Rsrc + col0 + lane * 4 + (size_t)(q * 128 + wave * 16) * DM;
#pragma unroll
  for (int rr = 0; rr < 16; ++rr) rv[rr] = *(const f32x4*)(R + (size_t)rr * DM);
}
DI void epi_resid(const Params& p, const float* Rsrc, const float* sC, int q, int tok0, int col0, f32x4 g, f32x4 (&rv)[16]) {
  const int lane = tidx() & 63, wave = tidx() >> 6;
  float* R = rrow(p, tok0) + col0 + lane * 4 + (size_t)(q * 128 + wave * 16) * DM;
#pragma unroll
  for (int rr = 0; rr < 16; ++rr) {
    const f32x4 c = *(const f32x4*)(sC + (wave * 16 + rr) * CLD + lane * 4);
    *(f32x4*)(R + (size_t)rr * DM) = rv[rr] + g * c;
  }
  if (q < 1) resid_load(Rsrc, q + 1, col0, rv);
}

struct ConvW { float2 wa0, wa1, wa2, ba, wg0, wg1, wg2, bg; };
DI void conv_load(const Params& p, int layer, int nt, ConvW& w) {
  const int lane = tidx() & 63;
  const int j0 = nt * 128;
  const float* cw = p.conv_w + (size_t)layer * 3 * 5632;
  const float* cb = p.conv_b + (size_t)layer * 5632;
  const int ca = j0 + 2 * lane, cg_ = DFF + j0 + 2 * lane;
  w.wa0 = *(const float2*)(cw + ca); w.wa1 = *(const float2*)(cw + 5632 + ca); w.wa2 = *(const float2*)(cw + 2 * 5632 + ca); w.ba = *(const float2*)(cb + ca);
  w.wg0 = *(const float2*)(cw + cg_); w.wg1 = *(const float2*)(cw + 5632 + cg_); w.wg2 = *(const float2*)(cw + 2 * 5632 + cg_); w.bg = *(const float2*)(cb + cg_);
}
DI void epi_convgate(const Params& p, const float* sC, const float* bnd, int q, int tokbase, int pos0, int L, int seam, int nt, const ConvW& w) {
  const int lane = tidx() & 63, wave = tidx() >> 6;
  const int j0 = nt * 128;
  const float2 wa0 = w.wa0, wa1 = w.wa1, wa2 = w.wa2, ba = w.ba, wg0 = w.wg0, wg1 = w.wg1, wg2 = w.wg2, bg = w.bg;
#pragma unroll 1
  for (int hb = 0; hb < 2; ++hb) {
    const int lr0 = wave * 16 + hb * 8;
    float2 va[10], vg[10];
#pragma unroll
    for (int k = 0; k < 10; ++k) {
      const int lrk = lr0 - 1 + k;
      const float* rowp = lrk < 0 ? bnd + (2 * q - 1) * 256 : (lrk > 127 ? bnd + (2 * q + 2) * 256 : sC + lrk * CLD);
      va[k] = *(const float2*)(rowp + 2 * lane); vg[k] = *(const float2*)(rowp + 128 + 2 * lane);
    }
#pragma unroll
    for (int k = 0; k < 8; ++k) {
      const int R = q * 128 + lr0 + k;
      const int pos = pos0 + R;
      if (R == 0 || R == 255 || pos >= L) continue;
      f32x2 pa = {va[k].x, va[k].y}, pg = {vg[k].x, vg[k].y}, na = {va[k + 2].x, va[k + 2].y}, ng = {vg[k + 2].x, vg[k + 2].y};
      const f32x2 ca2 = {va[k + 1].x, va[k + 1].y}, cg2 = {vg[k + 1].x, vg[k + 1].y};
      if (pos == seam) { pa = f32x2{0.f, 0.f}; pg = f32x2{0.f, 0.f}; }
      if (pos + 1 == seam) { na = f32x2{0.f, 0.f}; ng = f32x2{0.f, 0.f}; }
      const f32x2 ya = f32x2{ba.x, ba.y} + f32x2{wa0.x, wa0.y} * pa + f32x2{wa1.x, wa1.y} * ca2 + f32x2{wa2.x, wa2.y} * na;
      const f32x2 yg = f32x2{bg.x, bg.y} + f32x2{wg0.x, wg0.y} * pg + f32x2{wg1.x, wg1.y} * cg2 + f32x2{wg2.x, wg2.y} * ng;
      const float ya0 = ya[0], ya1 = ya[1], yg0 = yg[0], yg1 = yg[1];
      *(unsigned*)(p.G + (size_t)(tokbase + pos) * DFF + j0 + 2 * lane) = pack2(siluf(ya0) * yg0, siluf(ya1) * yg1);
    }
  }
}

DI void tile_rstd(const Params& p, int tok0, int c0, int len, float* rs) {
  const int tid = tidx();
  const int row = tid >> 1, part = tid & 1;
  const u16* tp = p.T1 + (size_t)(tok0 + row) * 768 + c0 + part * (len >> 1);
  float ss = 0;
#pragma unroll 8
  for (int c = 0; c < (len >> 4); ++c) {
    u32x4 v = *(const u32x4*)(tp + c * 8);
#pragma unroll
    for (int j = 0; j < 4; ++j) { float a = bflo(v[j]), b = bfhi(v[j]); ss += a * a + b * b; }
  }
  ss += __shfl_xor(ss, 1);
  if (!part) rs[row] = rsqrtf(ss / (float)len + EPS);
}

DI bool xcd_tile(int round, int Mx, int NT, int GM, int& mt, int& nt) {
  const int xcd = blockIdx.x & 7, slot = blockIdx.x >> 3;
  int per = gridDim.x >> 3;
  const int j = round * per + slot;
  if (slot >= per || j >= Mx * NT) return false;
  int gsz = __builtin_amdgcn_readfirstlane(GM * NT);
  asm volatile("" : "+s"(gsz));
  const int g = j / gsz, w = j - g * gsz;
  int gm = Mx - g * GM; if (gm > GM) gm = GM;
  gm = __builtin_amdgcn_readfirstlane(gm);
  asm volatile("" : "+s"(gm));
  const int q = w / gm;
  mt = xcd * Mx + g * GM + (w - q * gm); nt = q;
  return true;
}

DI bool xcd_tile_j(int j, int ntot, int Mx, int NT, int& mt, int& nt) {
  if (j >= ntot) return false;
  const int xcd = blockIdx.x & 7;
  int mx = __builtin_amdgcn_readfirstlane(Mx);
  asm volatile("" : "+s"(mx));
  const int q = j / mx;
  mt = xcd * Mx + (j - q * mx); nt = q;
  (void)NT;
  return true;
}

DI void qkv_phase(const Params& p, int kind, char* smem) {
  const u16* W = kind == 0 ? p.Wa_qkv : kind == 1 ? p.Wb_qkv : p.Wd_qkv;
  const int nqk = kind == 0 ? 2048 : kind == 1 ? 1280 : 1536;
  const int dvt = kind == 0 ? 1024 : kind == 1 ? 256 : 512;
  const int ntq = nqk >> 8, ntv = dvt >> 8;
  const int slot = blockIdx.x >> 3, per = gridDim.x >> 3;
  if (slot >= per) return;
  const int n1 = 9 * ntq, ntot = n1 + 9 * ntv;
  auto desc = [&](int j, const u16*& Ap, const u16*& Bp, int& tok0, int& c0, bool& isv) {
    int mt, nt;
    isv = j >= n1;
    xcd_tile_j(isv ? j - n1 : j, 1 << 30, 9, 0, mt, nt);
    tok0 = mt * 256; c0 = nt * 256;
    const u16* Hp = p.H + (size_t)tok0 * DM;
    const u16* Wp = W + (size_t)((isv ? nqk : 0) + c0) * DM;
    Ap = isv ? Wp : Hp; Bp = isv ? Hp : Wp;
  };
#pragma unroll 1
  for (int j = slot; j < ntot; j += per) {
    const u16 *Ap, *Bp; int tok0, c0; bool isv;
    desc(j, Ap, Bp, tok0, c0, isv);
    NextTile nx; nx.Ap = nullptr; nx.Bp = nullptr; nx.vlo = 0; nx.vhi = 256;
    if (j + per < ntot) { int t2, c2; bool v2; desc(j + per, nx.Ap, nx.Bp, t2, c2, v2); }
    gemm_tile<false>(Ap, DM, 0, 256, Bp, DM, DM, smem, nx, [&](const float* sC, int q) {
      if (isv) epi_store(sC, q, p.Vt + (size_t)c0 * T + tok0, T, nullptr, f32x4{1.f, 1.f, 1.f, 1.f});
      else if (kind == 3) epi_qknorm128(p, sC, q, p.QK + (size_t)tok0 * nqk + c0, nqk, tok0, c0 < 1024 ? p.d_qg : p.d_kg);
      else epi_rope64(p, sC, q, p.QK + (size_t)tok0 * nqk + c0, nqk, tok0, 15, nullptr);
    });
  }
}

DI void mla_down_phase(const Params& p, char* smem) {
  int mt, nt;
#pragma unroll 1
  for (int r = 0; xcd_tile(r, 9, 3, 9, mt, nt); ++r) {
    int tok0 = mt * 256, col0 = nt * 256;
    NextTile nx; nx.Ap = nullptr; nx.Bp = nullptr; nx.vlo = 0; nx.vhi = 0;
    gemm_tile<false>(p.H + (size_t)tok0 * DM, DM, 0, 256, p.Wc_d + (size_t)col0 * DM, DM, DM, smem, nx, [&](const float* sC, int q) {
      epi_store(sC, q, p.T1 + (size_t)tok0 * 768 + col0, 768, nullptr, f32x4{1.f, 1.f, 1.f, 1.f});
    });
  }
}

DI void mla_up_phase(const Params& p, char* smem) {
  float* rs = (float*)(smem + RS_OFF);
  u16* Qb = p.QK; u16* Kb = p.QK + (size_t)T * 1536;
  const int slot = blockIdx.x >> 3, per = gridDim.x >> 3;
#pragma unroll 1
  for (int j = slot; j < 126 && slot < per; j += per) {
    int mt, nt;
    const int ty = j < 54 ? 0 : j < 90 ? 1 : 2;
    xcd_tile_j(j - (ty == 0 ? 0 : ty == 1 ? 54 : 90), 1 << 30, 9, 0, mt, nt);
    const int tok0 = mt * 256, c0 = nt * 256;
    const int K = ty == 0 ? 384 : 256;
    const u16* Tp = p.T1 + (size_t)tok0 * 768 + (ty == 0 ? 0 : 384);
    const u16* Wp = (ty == 0 ? p.Wc_uq : ty == 1 ? p.Wc_uk : p.Wc_uv) + (size_t)c0 * K;
    NextTile nx; nx.Ap = nullptr; nx.Bp = nullptr; nx.vlo = 0; nx.vhi = 0;
    gemm_tile<false>(ty == 2 ? Wp : Tp, ty == 2 ? K : 768, 0, 256, ty == 2 ? Tp : Wp, ty == 2 ? 768 : K, K, smem, nx, [&](const float* sC, int q) {
      if (q == 0) { tile_rstd(p, tok0, ty == 0 ? 0 : 384, K, rs); __syncthreads(); }
      if (ty == 0) {
        int mask = 0;
#pragma unroll
        for (int g = 0; g < 4; ++g) if (((c0 + 64 * g) % 192) == 128) mask |= 1 << g;
        epi_rope64(p, sC, q, Qb + (size_t)tok0 * 1536 + c0, 1536, tok0, mask, rs);
      } else if (ty == 1) {
        epi_store(sC, q, Kb + (size_t)tok0 * 1024 + c0, 1024, rs, f32x4{1.f, 1.f, 1.f, 1.f});
      } else {
        const int lane = tidx() & 63;
        epi_store(sC, q, p.Vt + (size_t)c0 * T + tok0, T, nullptr, *(const f32x4*)(rs + lane * 4));
      }
    });
  }
#pragma unroll 1
  for (int mt2 = blockIdx.x; mt2 < 72; mt2 += gridDim.x) {
    int tok0 = mt2 * 256;
    const bool lat = (tok0 % TPB) >= CTXL;
    for (int e = tidx(); e < 8192; e += NTHR) {
      int row = e >> 5, i = e & 31;
      const u16* tp = p.T1 + (size_t)(tok0 + row) * 768 + 640;
      float x1 = bf2f(tp[i]), x2 = bf2f(tp[i + 32]);
      if (lat) {
        int pos = (tok0 % TPB) - CTXL + row;
        float cs = p.rope64[pos * 32 + i], sn = p.rope64[65536 + pos * 32 + i];
        float y1 = x1 * cs - x2 * sn, y2 = x1 * sn + x2 * cs;
        x1 = y1; x2 = y2;
      }
      p.KR[(size_t)(tok0 + row) * 64 + i] = f2bf(x1);
      p.KR[(size_t)(tok0 + row) * 64 + i + 32] = f2bf(x2);
    }
  }
}

DI int tile_token(int mt, bool lat_only) {
  if (!lat_only) return mt * 256;
  int b = mt >> 3; return b * TPB + CTXL + (mt & 7) * 256;
}

DI void resid_gemm_phase(const Params& p, int layer, const u16* A, int lda, int K, const u16* W, int chunk, bool lat_only, char* smem, float gs) {
  const int Mx = lat_only ? 8 : 9;
  int mt, nt; bool has = xcd_tile(0, Mx, 4, Mx, mt, nt);
#pragma unroll 1
  for (int r = 0; has; ++r) {
    int mt2, nt2; const bool has2 = xcd_tile(r + 1, Mx, 4, Mx, mt2, nt2);
    const int tok0 = tile_token(mt, lat_only), col0 = nt * 256;
    NextTile nx; nx.Ap = has2 ? A + (size_t)tile_token(mt2, lat_only) * lda : nullptr; nx.Bp = W + (size_t)nt2 * 256 * K; nx.vlo = 0; nx.vhi = 256;
    const float* gate = p.MOD + ((size_t)layer * 9 + modrow(tok0)) * 6144 + chunk * 1024;
    f32x4 rv[16]; f32x4 gv;
    const float* Rsrc = (layer == 0 && chunk == 2) ? xrow(p, tok0) : (const float*)rrow(p, tok0);
    gemm_tile<false>(A + (size_t)tok0 * lda, lda, 0, 256, W + (size_t)col0 * K, K, K, smem, nx, [&](const float* sC, int q) {
      epi_resid(p, Rsrc, sC, q, tok0, col0, gv, rv);
    }, [&]() { gv = *(const f32x4*)(gate + col0 + (tidx() & 63) * 4) * gs; resid_load(Rsrc, 0, col0, rv); });
    mt = mt2; nt = nt2; has = has2;
    if (!has2 && r == 0 && chunk == 2 && layer < 3) {
      const int per = gridDim.x >> 3, slot = blockIdx.x >> 3, xcd = blockIdx.x & 7;
      const int nbusy = Mx * 4 - per;
      const int me = (slot - nbusy) * 8 + xcd;
      const int nidle = (per - nbusy) * 8;
      if (nbusy >= 0 && nbusy < per && me >= 0) {
#pragma unroll 1
        for (int i = me; i < 48; i += nidle) mod_item2(p, (layer + 1) * 96 + 2 * i + (tidx() >> 8), true, smem);
      }
    }
    if (!has2 && r == 0 && chunk == 5 && layer < 3) {
      const int per = gridDim.x >> 3, slot = blockIdx.x >> 3, xcd = blockIdx.x & 7;
      const int nbusy = Mx * 4 - per;
      const int nidle = (per - nbusy) * 8;
      const int me = (slot - nbusy) * 8 + xcd;
      const int t0 = p.ltile[layer + 1], t1 = p.ltile[layer + 2];
      if (nbusy >= 0 && nbusy < per && me >= 0) {
#pragma unroll 1
        for (int i = me; t0 + 4 * i < t1; i += nidle) convert_tiles(p, t0 + 4 * i, t1, smem);
      }
    }
  }
}

DI void ffn_up_phase(const Params& p, int layer, bool lat_only, char* smem) {
  const int tpb = lat_only ? 9 : 10;
  const int L = lat_only ? SEQ : TPB;
  const int seam = lat_only ? -1 : CTXL;
  const float* bnd = (const float*)(smem + BND_OFF);
  int mt, nt; bool has = xcd_tile(0, tpb, 22, 5, mt, nt);
#pragma unroll 1
  for (int r = 0; has; ++r) {
    int mt2, nt2; const bool has2 = xcd_tile(r + 1, tpb, 22, 5, mt2, nt2);
    const int b = mt / tpb, ti = mt - b * tpb;
    const int tokbase = b * TPB + (lat_only ? CTXL : 0);
    const int pos0 = ti * 254 - 1;
    const int vlo = (ti == 0) ? 1 : 0;
    int vhi = L - pos0; if (vhi > 256) vhi = 256;
    NextTile nx; nx.Ap = nullptr; nx.Bp = nullptr; nx.vlo = 0; nx.vhi = 0;
    if (has2) {
      const int b2 = mt2 / tpb, ti2 = mt2 - b2 * tpb;
      const int pos02 = ti2 * 254 - 1;
      nx.Ap = p.H + ((long)(b2 * TPB + (lat_only ? CTXL : 0)) + pos02) * DM; nx.Bp = p.Wup[layer] + (size_t)nt2 * 256 * DM;
      nx.vlo = (ti2 == 0) ? 1 : 0; nx.vhi = L - pos02; if (nx.vhi > 256) nx.vhi = 256;
    }
    ConvW cwv;
    gemm_tile<true>(p.H + ((long)tokbase + pos0) * DM, DM, vlo, vhi, p.Wup[layer] + (size_t)nt * 256 * DM, DM, DM, smem, nx, [&](const float* sC, int q) {
      epi_convgate(p, sC, bnd, q, tokbase, pos0, L, seam, nt, cwv);
    }, [&]() { conv_load(p, layer, nt, cwv); });
    mt = mt2; nt = nt2; has = has2;
  }
}

template <int RB> DI int kswz(int row, int ch) {
  if (RB == 256) return row * RB + ((ch ^ (row & 15)) << 4);
  return row * RB + ((((ch & 7) ^ ((row >> 1) & 7)) | (ch & ~7)) << 4);
}
DI bf16x8 pack8(float a0, float a1, float a2, float a3, float a4, float a5, float a6, float a7) {
  u32x4 w = {pack2(a0, a1), pack2(a2, a3), pack2(a4, a5), pack2(a6, a7)};
  return __builtin_bit_cast(bf16x8, w);
}

DI void qk_asm_a(f32x16 (&s)[2], const bf16x8 (&q)[4], const unsigned (&a)[4]) {
  u32x4 t0, t1, t2, t3, t4, t5;
  asm volatile(
      "ds_read_b128 %2, %12 offset:0\n\t"
      "ds_read_b128 %3, %12 offset:8192\n\t"
      "ds_read_b128 %4, %13 offset:0\n\t"
      "ds_read_b128 %5, %13 offset:8192\n\t"
      "ds_read_b128 %6, %14 offset:0\n\t"
      "ds_read_b128 %7, %14 offset:8192\n\t"
      "s_waitcnt lgkmcnt(5)\n\t"
      "v_mfma_f32_32x32x16_bf16 %0, %2, %8, %0\n\t"
      "ds_read_b128 %2, %15 offset:0\n\t"
      "s_waitcnt lgkmcnt(5)\n\t"
      "v_mfma_f32_32x32x16_bf16 %1, %3, %8, %1\n\t"
      "ds_read_b128 %3, %15 offset:8192\n\t"
      "s_waitcnt lgkmcnt(5)\n\t"
      "v_mfma_f32_32x32x16_bf16 %0, %4, %9, %0\n\t"
      "s_waitcnt lgkmcnt(4)\n\t"
      "v_mfma_f32_32x32x16_bf16 %1, %5, %9, %1\n\t"
      "s_waitcnt lgkmcnt(3)\n\t"
      "v_mfma_f32_32x32x16_bf16 %0, %6, %10, %0\n\t"
      "s_waitcnt lgkmcnt(2)\n\t"
      "v_mfma_f32_32x32x16_bf16 %1, %7, %10, %1\n\t"
      "s_waitcnt lgkmcnt(1)\n\t"
      "v_mfma_f32_32x32x16_bf16 %0, %2, %11, %0\n\t"
      "s_waitcnt lgkmcnt(0)\n\t"
      "v_mfma_f32_32x32x16_bf16 %1, %3, %11, %1\n\t"
      "s_nop 15\n\t"
      "s_nop 3\n\t"
      : "+v"(s[0]), "+v"(s[1]), "=&v"(t0), "=&v"(t1), "=&v"(t2), "=&v"(t3), "=&v"(t4), "=&v"(t5)
      : "v"(q[0]), "v"(q[1]), "v"(q[2]), "v"(q[3]), "v"(a[0]), "v"(a[1]), "v"(a[2]), "v"(a[3])
      : "memory");
}
DI void qk_asm_b(f32x16 (&s)[2], const bf16x8 (&q)[4], const unsigned (&a)[4]) {
  u32x4 t0, t1, t2, t3, t4, t5;
  asm volatile(
      "ds_read_b128 %2, %12 offset:0\n\t"
      "ds_read_b128 %3, %12 offset:4096\n\t"
      "ds_read_b128 %4, %13 offset:0\n\t"
      "ds_read_b128 %5, %13 offset:4096\n\t"
      "ds_read_b128 %6, %14 offset:0\n\t"
      "ds_read_b128 %7, %14 offset:4096\n\t"
      "s_waitcnt lgkmcnt(5)\n\t"
      "v_mfma_f32_32x32x16_bf16 %0, %2, %8, %0\n\t"
      "ds_read_b128 %2, %15 offset:0\n\t"
      "s_waitcnt lgkmcnt(5)\n\t"
      "v_mfma_f32_32x32x16_bf16 %1, %3, %8, %1\n\t"
      "ds_read_b128 %3, %15 offset:4096\n\t"
      "s_waitcnt lgkmcnt(5)\n\t"
      "v_mfma_f32_32x32x16_bf16 %0, %4, %9, %0\n\t"
      "s_waitcnt lgkmcnt(4)\n\t"
      "v_mfma_f32_32x32x16_bf16 %1, %5, %9, %1\n\t"
      "s_waitcnt lgkmcnt(3)\n\t"
      "v_mfma_f32_32x32x16_bf16 %0, %6, %10, %0\n\t"
      "s_waitcnt lgkmcnt(2)\n\t"
      "v_mfma_f32_32x32x16_bf16 %1, %7, %10, %1\n\t"
      "s_waitcnt lgkmcnt(1)\n\t"
      "v_mfma_f32_32x32x16_bf16 %0, %2, %11, %0\n\t"
      "s_waitcnt lgkmcnt(0)\n\t"
      "v_mfma_f32_32x32x16_bf16 %1, %3, %11, %1\n\t"
      "s_nop 15\n\t"
      "s_nop 3\n\t"
      : "+v"(s[0]), "+v"(s[1]), "=&v"(t0), "=&v"(t1), "=&v"(t2), "=&v"(t3), "=&v"(t4), "=&v"(t5)
      : "v"(q[0]), "v"(q[1]), "v"(q[2]), "v"(q[3]), "v"(a[0]), "v"(a[1]), "v"(a[2]), "v"(a[3])
      : "memory");
}
DI void qk_asm_c(f32x16 (&s)[1], const bf16x8 (&q)[12], const unsigned (&a)[4]) {
  u32x4 t0, t1, t2, t3, t4, t5;
  asm volatile(
      "ds_read_b128 %1, %19 offset:0\n\t"
      "ds_read_b128 %2, %20 offset:0\n\t"
      "ds_read_b128 %3, %21 offset:0\n\t"
      "ds_read_b128 %4, %22 offset:0\n\t"
      "ds_read_b128 %5, %19 offset:128\n\t"
      "ds_read_b128 %6, %20 offset:128\n\t"
      "s_waitcnt lgkmcnt(5)\n\t"
      "v_mfma_f32_32x32x16_bf16 %0, %1, %7, %0\n\t"
      "ds_read_b128 %1, %21 offset:128\n\t"
      "s_waitcnt lgkmcnt(5)\n\t"
      "v_mfma_f32_32x32x16_bf16 %0, %2, %8, %0\n\t"
      "ds_read_b128 %2, %22 offset:128\n\t"
      "s_waitcnt lgkmcnt(5)\n\t"
      "v_mfma_f32_32x32x16_bf16 %0, %3, %9, %0\n\t"
      "ds_read_b128 %3, %19 offset:256\n\t"
      "s_waitcnt lgkmcnt(5)\n\t"
      "v_mfma_f32_32x32x16_bf16 %0, %4, %10, %0\n\t"
      "ds_read_b128 %4, %20 offset:256\n\t"
      "s_waitcnt lgkmcnt(5)\n\t"
      "v_mfma_f32_32x32x16_bf16 %0, %5, %11, %0\n\t"
      "ds_read_b128 %5, %21 offset:256\n\t"
      "s_waitcnt lgkmcnt(5)\n\t"
      "v_mfma_f32_32x32x16_bf16 %0, %6, %12, %0\n\t"
      "ds_read_b128 %6, %22 offset:256\n\t"
      "s_waitcnt lgkmcnt(5)\n\t"
      "v_mfma_f32_32x32x16_bf16 %0, %1, %13, %0\n\t"
      "s_waitcnt lgkmcnt(4)\n\t"
      "v_mfma_f32_32x32x16_bf16 %0, %2, %14, %0\n\t"
      "s_waitcnt lgkmcnt(3)\n\t"
      "v_mfma_f32_32x32x16_bf16 %0, %3, %15, %0\n\t"
      "s_waitcnt lgkmcnt(2)\n\t"
      "v_mfma_f32_32x32x16_bf16 %0, %4, %16, %0\n\t"
      "s_waitcnt lgkmcnt(1)\n\t"
      "v_mfma_f32_32x32x16_bf16 %0, %5, %17, %0\n\t"
      "s_waitcnt lgkmcnt(0)\n\t"
      "v_mfma_f32_32x32x16_bf16 %0, %6, %18, %0\n\t"
      "s_nop 15\n\t"
      "s_nop 3\n\t"
      : "+v"(s[0]), "=&v"(t0), "=&v"(t1), "=&v"(t2), "=&v"(t3), "=&v"(t4), "=&v"(t5)
      : "v"(q[0]), "v"(q[1]), "v"(q[2]), "v"(q[3]), "v"(q[4]), "v"(q[5]), "v"(q[6]), "v"(q[7]), "v"(q[8]), "v"(q[9]), "v"(q[10]), "v"(q[11]), "v"(a[0]), "v"(a[1]), "v"(a[2]), "v"(a[3])
      : "memory");
}
DI void qk_asm_d(f32x16 (&s)[2], const bf16x8 (&q)[8], const unsigned (&a)[8]) {
  u32x4 t0, t1, t2, t3, t4, t5;
  asm volatile(
      "ds_read_b128 %2, %16 offset:0\n\t"
      "ds_read_b128 %3, %16 offset:8192\n\t"
      "ds_read_b128 %4, %17 offset:0\n\t"
      "ds_read_b128 %5, %17 offset:8192\n\t"
      "ds_read_b128 %6, %18 offset:0\n\t"
      "ds_read_b128 %7, %18 offset:8192\n\t"
      "s_waitcnt lgkmcnt(5)\n\t"
      "v_mfma_f32_32x32x16_bf16 %0, %2, %8, %0\n\t"
      "ds_read_b128 %2, %19 offset:0\n\t"
      "s_waitcnt lgkmcnt(5)\n\t"
      "v_mfma_f32_32x32x16_bf16 %1, %3, %8, %1\n\t"
      "ds_read_b128 %3, %19 offset:8192\n\t"
      "s_waitcnt lgkmcnt(5)\n\t"
      "v_mfma_f32_32x32x16_bf16 %0, %4, %9, %0\n\t"
      "ds_read_b128 %4, %20 offset:0\n\t"
      "s_waitcnt lgkmcnt(5)\n\t"
      "v_mfma_f32_32x32x16_bf16 %1, %5, %9, %1\n\t"
      "ds_read_b128 %5, %20 offset:8192\n\t"
      "s_waitcnt lgkmcnt(5)\n\t"
      "v_mfma_f32_32x32x16_bf16 %0, %6, %10, %0\n\t"
      "ds_read_b128 %6, %21 offset:0\n\t"
      "s_waitcnt lgkmcnt(5)\n\t"
      "v_mfma_f32_32x32x16_bf16 %1, %7, %10, %1\n\t"
      "ds_read_b128 %7, %21 offset:8192\n\t"
      "s_waitcnt lgkmcnt(5)\n\t"
      "v_mfma_f32_32x32x16_bf16 %0, %2, %11, %0\n\t"
      "ds_read_b128 %2, %22 offset:0\n\t"
      "s_waitcnt lgkmcnt(5)\n\t"
      "v_mfma_f32_32x32x16_bf16 %1, %3, %11, %1\n\t"
      "ds_read_b128 %3, %22 offset:8192\n\t"
      "s_waitcnt lgkmcnt(5)\n\t"
      "v_mfma_f32_32x32x16_bf16 %0, %4, %12, %0\n\t"
      "ds_read_b128 %4, %23 offset:0\n\t"
      "s_waitcnt lgkmcnt(5)\n\t"
      "v_mfma_f32_32x32x16_bf16 %1, %5, %12, %1\n\t"
      "ds_read_b128 %5, %23 offset:8192\n\t"
      "s_waitcnt lgkmcnt(5)\n\t"
      "v_mfma_f32_32x32x16_bf16 %0, %6, %13, %0\n\t"
      "s_waitcnt lgkmcnt(4)\n\t"
      "v_mfma_f32_32x32x16_bf16 %1, %7, %13, %1\n\t"
      "s_waitcnt lgkmcnt(3)\n\t"
      "v_mfma_f32_32x32x16_bf16 %0, %2, %14, %0\n\t"
      "s_waitcnt lgkmcnt(2)\n\t"
      "v_mfma_f32_32x32x16_bf16 %1, %3, %14, %1\n\t"
      "s_waitcnt lgkmcnt(1)\n\t"
      "v_mfma_f32_32x32x16_bf16 %0, %4, %15, %0\n\t"
      "s_waitcnt lgkmcnt(0)\n\t"
      "v_mfma_f32_32x32x16_bf16 %1, %5, %15, %1\n\t"
      "s_nop 15\n\t"
      "s_nop 3\n\t"
      : "+v"(s[0]), "+v"(s[1]), "=&v"(t0), "=&v"(t1), "=&v"(t2), "=&v"(t3), "=&v"(t4), "=&v"(t5)
      : "v"(q[0]), "v"(q[1]), "v"(q[2]), "v"(q[3]), "v"(q[4]), "v"(q[5]), "v"(q[6]), "v"(q[7]), "v"(a[0]), "v"(a[1]), "v"(a[2]), "v"(a[3]), "v"(a[4]), "v"(a[5]), "v"(a[6]), "v"(a[7])
      : "memory");
}
DI void pv_asm_42(f32x16 (&o)[4], const bf16x8 (&pb)[2][2], const unsigned (&a)[4]) {
  u32x4 t0, t1, t2, t3, t4, t5;
  asm volatile(
      "ds_read_b128 %4, %14 offset:0\n\t"
      "ds_read_b128 %5, %14 offset:4096\n\t"
      "ds_read_b128 %6, %14 offset:8192\n\t"
      "ds_read_b128 %7, %14 offset:12288\n\t"
      "ds_read_b128 %8, %15 offset:0\n\t"
      "ds_read_b128 %9, %15 offset:4096\n\t"
      "s_waitcnt lgkmcnt(5)\n\t"
      "v_mfma_f32_32x32x16_bf16 %0, %4, %10, %0\n\t"
      "ds_read_b128 %4, %15 offset:8192\n\t"
      "s_waitcnt lgkmcnt(5)\n\t"
      "v_mfma_f32_32x32x16_bf16 %1, %5, %10, %1\n\t"
      "ds_read_b128 %5, %15 offset:12288\n\t"
      "s_waitcnt lgkmcnt(5)\n\t"
      "v_mfma_f32_32x32x16_bf16 %2, %6, %10, %2\n\t"
      "ds_read_b128 %6, %16 offset:0\n\t"
      "s_waitcnt lgkmcnt(5)\n\t"
      "v_mfma_f32_32x32x16_bf16 %3, %7, %10, %3\n\t"
      "ds_read_b128 %7, %16 offset:4096\n\t"
      "s_waitcnt lgkmcnt(5)\n\t"
      "v_mfma_f32_32x32x16_bf16 %0, %8, %11, %0\n\t"
      "ds_read_b128 %8, %16 offset:8192\n\t"
      "s_waitcnt lgkmcnt(5)\n\t"
      "v_mfma_f32_32x32x16_bf16 %1, %9, %11, %1\n\t"
      "ds_read_b128 %9, %16 offset:12288\n\t"
      "s_waitcnt lgkmcnt(5)\n\t"
      "v_mfma_f32_32x32x16_bf16 %2, %4, %11, %2\n\t"
      "ds_read_b128 %4, %17 offset:0\n\t"
      "s_waitcnt lgkmcnt(5)\n\t"
      "v_mfma_f32_32x32x16_bf16 %3, %5, %11, %3\n\t"
      "ds_read_b128 %5, %17 offset:4096\n\t"
      "s_waitcnt lgkmcnt(5)\n\t"
      "v_mfma_f32_32x32x16_bf16 %0, %6, %12, %0\n\t"
      "ds_read_b128 %6, %17 offset:8192\n\t"
      "s_waitcnt lgkmcnt(5)\n\t"
      "v_mfma_f32_32x32x16_bf16 %1, %7, %12, %1\n\t"
      "ds_read_b128 %7, %17 offset:12288\n\t"
      "s_waitcnt lgkmcnt(5)\n\t"
      "v_mfma_f32_32x32x16_bf16 %2, %8, %12, %2\n\t"
      "s_waitcnt lgkmcnt(4)\n\t"
      "v_mfma_f32_32x32x16_bf16 %3, %9, %12, %3\n\t"
      "s_waitcnt lgkmcnt(3)\n\t"
      "v_mfma_f32_32x32x16_bf16 %0, %4, %13, %0\n\t"
      "s_waitcnt lgkmcnt(2)\n\t"
      "v_mfma_f32_32x32x16_bf16 %1, %5, %13, %1\n\t"
      "s_waitcnt lgkmcnt(1)\n\t"
      "v_mfma_f32_32x32x16_bf16 %2, %6, %13, %2\n\t"
      "s_waitcnt lgkmcnt(0)\n\t"
      "v_mfma_f32_32x32x16_bf16 %3, %7, %13, %3\n\t"
      "s_nop 15\n\t"
      "s_nop 3\n\t"
      : "+v"(o[0]), "+v"(o[1]), "+v"(o[2]), "+v"(o[3]), "=&v"(t0), "=&v"(t1), "=&v"(t2), "=&v"(t3), "=&v"(t4), "=&v"(t5)
      : "v"(pb[0][0]), "v"(pb[0][1]), "v"(pb[1][0]), "v"(pb[1][1]), "v"(a[0]), "v"(a[1]), "v"(a[2]), "v"(a[3])
      : "memory");
}
DI void pv_asm_22(f32x16 (&o)[2], const bf16x8 (&pb)[2][2], const unsigned (&a)[4]) {
  u32x4 t0, t1, t2, t3, t4, t5;
  asm volatile(
      "ds_read_b128 %2, %12 offset:0\n\t"
      "ds_read_b128 %3, %12 offset:4096\n\t"
      "ds_read_b128 %4, %13 offset:0\n\t"
      "ds_read_b128 %5, %13 offset:4096\n\t"
      "ds_read_b128 %6, %14 offset:0\n\t"
      "ds_read_b128 %7, %14 offset:4096\n\t"
      "s_waitcnt lgkmcnt(5)\n\t"
      "v_mfma_f32_32x32x16_bf16 %0, %2, %8, %0\n\t"
      "ds_read_b128 %2, %15 offset:0\n\t"
      "s_waitcnt lgkmcnt(5)\n\t"
      "v_mfma_f32_32x32x16_bf16 %1, %3, %8, %1\n\t"
      "ds_read_b128 %3, %15 offset:4096\n\t"
      "s_waitcnt lgkmcnt(5)\n\t"
      "v_mfma_f32_32x32x16_bf16 %0, %4, %9, %0\n\t"
      "s_waitcnt lgkmcnt(4)\n\t"
      "v_mfma_f32_32x32x16_bf16 %1, %5, %9, %1\n\t"
      "s_waitcnt lgkmcnt(3)\n\t"
      "v_mfma_f32_32x32x16_bf16 %0, %6, %10, %0\n\t"
      "s_waitcnt lgkmcnt(2)\n\t"
      "v_mfma_f32_32x32x16_bf16 %1, %7, %10, %1\n\t"
      "s_waitcnt lgkmcnt(1)\n\t"
      "v_mfma_f32_32x32x16_bf16 %0, %2, %11, %0\n\t"
      "s_waitcnt lgkmcnt(0)\n\t"
      "v_mfma_f32_32x32x16_bf16 %1, %3, %11, %1\n\t"
      "s_nop 15\n\t"
      "s_nop 3\n\t"
      : "+v"(o[0]), "+v"(o[1]), "=&v"(t0), "=&v"(t1), "=&v"(t2), "=&v"(t3), "=&v"(t4), "=&v"(t5)
      : "v"(pb[0][0]), "v"(pb[0][1]), "v"(pb[1][0]), "v"(pb[1][1]), "v"(a[0]), "v"(a[1]), "v"(a[2]), "v"(a[3])
      : "memory");
}
DI void pv_asm_41(f32x16 (&o)[4], const bf16x8 (&pb)[1][2], const unsigned (&a)[2]) {
  u32x4 t0, t1, t2, t3, t4, t5;
  asm volatile(
      "ds_read_b128 %4, %12 offset:0\n\t"
      "ds_read_b128 %5, %12 offset:4096\n\t"
      "ds_read_b128 %6, %12 offset:8192\n\t"
      "ds_read_b128 %7, %12 offset:12288\n\t"
      "ds_read_b128 %8, %13 offset:0\n\t"
      "ds_read_b128 %9, %13 offset:4096\n\t"
      "s_waitcnt lgkmcnt(5)\n\t"
      "v_mfma_f32_32x32x16_bf16 %0, %4, %10, %0\n\t"
      "ds_read_b128 %4, %13 offset:8192\n\t"
      "s_waitcnt lgkmcnt(5)\n\t"
      "v_mfma_f32_32x32x16_bf16 %1, %5, %10, %1\n\t"
      "ds_read_b128 %5, %13 offset:12288\n\t"
      "s_waitcnt lgkmcnt(5)\n\t"
      "v_mfma_f32_32x32x16_bf16 %2, %6, %10, %2\n\t"
      "s_waitcnt lgkmcnt(4)\n\t"
      "v_mfma_f32_32x32x16_bf16 %3, %7, %10, %3\n\t"
      "s_waitcnt lgkmcnt(3)\n\t"
      "v_mfma_f32_32x32x16_bf16 %0, %8, %11, %0\n\t"
      "s_waitcnt lgkmcnt(2)\n\t"
      "v_mfma_f32_32x32x16_bf16 %1, %9, %11, %1\n\t"
      "s_waitcnt lgkmcnt(1)\n\t"
      "v_mfma_f32_32x32x16_bf16 %2, %4, %11, %2\n\t"
      "s_waitcnt lgkmcnt(0)\n\t"
      "v_mfma_f32_32x32x16_bf16 %3, %5, %11, %3\n\t"
      "s_nop 15\n\t"
      "s_nop 3\n\t"
      : "+v"(o[0]), "+v"(o[1]), "+v"(o[2]), "+v"(o[3]), "=&v"(t0), "=&v"(t1), "=&v"(t2), "=&v"(t3), "=&v"(t4), "=&v"(t5)
      : "v"(pb[0][0]), "v"(pb[0][1]), "v"(a[0]), "v"(a[1])
      : "memory");
}

template <int KIND>
DI void attn_item(const Params& p, int b, int hh, int qt, char* smem, float lam, int nb, int nhh) {
  constexpr int DQK = KIND == 2 ? 192 : KIND == 3 ? 128 : 64;
  constexpr int DV = KIND == 1 ? 64 : 128;
  constexpr int KRB = KIND == 0 ? 256 : KIND == 1 ? 128 : KIND == 2 ? 384 : 256;
  constexpr int NQ = KIND == 0 ? 128 : 256;
  constexpr int NMB = KIND == 2 ? 1 : 2;
  constexpr int KCH = KRB / 16, NKC = 64 * KCH / 512, NVC = DV * 8 / 512, NC = DV / 32;
  constexpr int LDQ = KIND == 0 ? 2048 : KIND == 1 ? 1280 : 1536;
  constexpr int LDK = KIND == 0 ? 2048 : KIND == 1 ? 1280 : KIND == 2 ? 1024 : 1536;
  const int tid = tidx(), lane = tid & 63, wave = tid >> 6, h = lane >> 5, ql = lane & 31;
  const int grp = KIND == 0 ? (wave >> 2) : 0;
  const int wq = KIND == 0 ? (wave & 3) : wave;
  const int tokb = b * TPB;
  const int q0 = qt * NQ;
  const bool isctx = q0 < CTXL;
  int lo = 0, hi = 0;
  if (!isctx) {
    if (KIND == 1) {
      int s = q0 - CTXL;
      int a = s - 128; if (a < 0) a = 0;
      int e = s + 383; if (e > SEQ - 1) e = SEQ - 1;
      lo = (CTXL + a) >> 6; hi = ((CTXL + e) >> 6) + 1;
    } else { lo = 4; hi = 36; }
  }
  const int ntiles = 4 + (hi - lo);
  const float sl2 = (KIND == 2 ? 0.07216878364870322f : KIND == 3 ? 0.08838834764831845f : 0.125f) * 1.4426950408889634f;

  const u16* Ksrc; const u16* Vth; int qoff, aoff;
  if (KIND == 0) { qoff = (2 * hh + grp) * 64; Ksrc = p.QK + 1024 + hh * 128; Vth = p.Vt + (size_t)(hh * 128) * T; aoff = hh * 128; }
  else if (KIND == 1) { qoff = hh * 64; Ksrc = p.QK + 1024 + (hh >> 2) * 64; Vth = p.Vt + (size_t)((hh >> 2) * 64) * T; aoff = hh * 64; }
  else if (KIND == 2) { qoff = hh * 192; Ksrc = p.QK + (size_t)T * 1536 + hh * 128; Vth = p.Vt + (size_t)(hh * 128) * T; aoff = hh * 128; }
  else { qoff = hh * 128; Ksrc = p.QK + 1024 + (hh >> 1) * 128; Vth = p.Vt + (size_t)((hh >> 1) * 128) * T; aoff = hh * 128; }
  const int qtok = tokb + q0 + wq * 32 + ql;

  bf16x8 qf[DQK / 16];
  {
    const u16* qrow = p.QK + (size_t)qtok * LDQ + qoff;
#pragma unroll
    for (int ks = 0; ks < DQK / 16; ++ks) qf[ks] = *(const bf16x8*)(qrow + 16 * ks + 8 * h);
  }
  u32x4 rk[NKC], rv[NVC];
  auto gload = [&](int kt) {
    const int key0 = tokb + kt * 64;
#pragma unroll
    for (int i = 0; i < NKC; ++i) {
      int id = tid + 512 * i; int row = id / KCH, ch = id - row * KCH;
      const u16* src = (KIND == 2 && ch >= 16) ? p.KR + (size_t)(key0 + row) * 64 + (ch - 16) * 8
                                               : Ksrc + (size_t)(key0 + row) * LDK + ch * 8;
      rk[i] = *(const u32x4*)src;
    }
#pragma unroll
    for (int i = 0; i < NVC; ++i) {
      int id = tid + 512 * i; int row = id >> 3, ch = id & 7;
      rv[i] = *(const u32x4*)(Vth + (size_t)row * T + key0 + ch * 8);
    }
  };
  auto sstore = [&](int buf) {
    char* sK = smem + buf * 40960; char* sV = sK + 24576;
#pragma unroll
    for (int i = 0; i < NKC; ++i) {
      int id = tid + 512 * i; int row = id / KCH, ch = id - row * KCH;
      *(u32x4*)(sK + kswz<KRB>(row, ch)) = rk[i];
    }
#pragma unroll
    for (int i = 0; i < NVC; ++i) {
      int id = tid + 512 * i; int row = id >> 3, ch = id & 7;
      *(u32x4*)(sV + swz128(row, ch)) = rv[i];
    }
  };
  f32x16 oacc[NC];
#pragma unroll
  for (int c = 0; c < NC; ++c)
#pragma unroll
    for (int r = 0; r < 16; ++r) oacc[c][r] = 0.f;
  float m = -1e30f, l = 0.f;
  const int prow = (ql & 3) | ((ql & 4) << 1) | ((ql & 8) >> 1) | (ql & 16);
  const unsigned lds0 = (unsigned)(size_t)smem;
  const int qpos = q0 - CTXL + wq * 32 + ql;

  gload(0); sstore(0); __syncthreads();
#pragma unroll 1
  for (int ti = 0; ti < ntiles; ++ti) {
    const int kt = ti < 4 ? ti : lo + ti - 4;
    if (ti + 1 < ntiles) gload(ti + 1 < 4 ? ti + 1 : lo + ti + 1 - 4);
    const char* sK = smem + (ti & 1) * 40960; const char* sV = sK + 24576;
    const bool domask = (KIND == 1) && !isctx && kt >= 4;
#pragma unroll
    for (int hb = 0; hb < 2; hb += NMB) {
      f32x16 sacc[NMB];
#pragma unroll
      for (int mb = 0; mb < NMB; ++mb)
#pragma unroll
        for (int r = 0; r < 16; ++r) sacc[mb][r] = 0.f;
      {
        const unsigned kbase = lds0 + (unsigned)((ti & 1) * 40960) + (unsigned)((prow + 32 * hb) * KRB);
        if (KIND == 0) {
          unsigned ka[4];
#pragma unroll
          for (int ks = 0; ks < 4; ++ks) ka[ks] = kbase + ((unsigned)((8 * grp + 2 * ks + h) ^ (prow & 15)) << 4);
          qk_asm_a(*(f32x16(*)[2])&sacc, *(const bf16x8(*)[4])&qf, ka);
        } else if (KIND == 1) {
          unsigned ka[4];
#pragma unroll
          for (int ks = 0; ks < 4; ++ks) ka[ks] = kbase + ((unsigned)((2 * ks + h) ^ ((prow >> 1) & 7)) << 4);
          qk_asm_b(*(f32x16(*)[2])&sacc, *(const bf16x8(*)[4])&qf, ka);
        } else if (KIND == 2) {
          unsigned ka[4];
#pragma unroll
          for (int b4 = 0; b4 < 4; ++b4) ka[b4] = kbase + ((unsigned)((2 * b4 + h) ^ ((prow >> 1) & 7)) << 4);
          qk_asm_c(*(f32x16(*)[1])&sacc, *(const bf16x8(*)[12])&qf, ka);
        } else {
          unsigned ka[8];
#pragma unroll
          for (int ks = 0; ks < 8; ++ks) ka[ks] = kbase + ((unsigned)((2 * ks + h) ^ (prow & 15)) << 4);
          qk_asm_d(*(f32x16(*)[2])&sacc, *(const bf16x8(*)[8])&qf, ka);
        }
      }
      float mx = -1e30f;
      if (domask) {
#pragma unroll
        for (int mb = 0; mb < NMB; ++mb)
#pragma unroll
          for (int r = 0; r < 16; ++r) {
            int kpos = kt * 64 + 32 * (hb + mb) + 16 * (r >> 3) + 8 * h + (r & 7) - CTXL;
            int d = qpos - kpos; if (d < 0) d = -d;
            if (d > 128) sacc[mb][r] = -1e30f;
          }
      }
#pragma unroll
      for (int mb = 0; mb < NMB; ++mb)
#pragma unroll
        for (int r = 0; r < 16; r += 2) mx = fmaxf(mx, fmaxf(sacc[mb][r], sacc[mb][r + 1]));
      mx = xmax32(mx);
      const float mn = fmaxf(m, mx);
      const float nms = -mn * sl2;
      const float alpha = __builtin_amdgcn_exp2f((m - mn) * sl2);
      float sum = 0.f;
#pragma unroll
      for (int mb = 0; mb < NMB; ++mb)
#pragma unroll
        for (int r = 0; r < 16; ++r) { float pv = __builtin_amdgcn_exp2f(fmaf(sacc[mb][r], sl2, nms)); sacc[mb][r] = pv; sum += pv; }
      sum = xsum32(sum);
      l = l * alpha + sum; m = mn;
      if (__any(alpha != 1.f)) {
#pragma unroll
        for (int c = 0; c < NC; ++c)
#pragma unroll
          for (int r = 0; r < 16; ++r) oacc[c][r] *= alpha;
      }
      bf16x8 pb[NMB][2];
#pragma unroll
      for (int mb = 0; mb < NMB; ++mb)
#pragma unroll
        for (int s = 0; s < 2; ++s)
          pb[mb][s] = pack8(sacc[mb][8 * s], sacc[mb][8 * s + 1], sacc[mb][8 * s + 2], sacc[mb][8 * s + 3],
                            sacc[mb][8 * s + 4], sacc[mb][8 * s + 5], sacc[mb][8 * s + 6], sacc[mb][8 * s + 7]);
      {
        const unsigned vbase = lds0 + (unsigned)((ti & 1) * 40960 + 24576) + (unsigned)(ql * 128);
        unsigned va[NMB * 2];
#pragma unroll
        for (int mb = 0; mb < NMB; ++mb)
#pragma unroll
          for (int s = 0; s < 2; ++s) va[mb * 2 + s] = vbase + ((unsigned)((4 * (hb + mb) + 2 * s + h) ^ ((ql >> 1) & 7)) << 4);
        if (KIND == 1) pv_asm_22(*(f32x16(*)[2])&oacc, *(const bf16x8(*)[2][2])&pb, *(const unsigned(*)[4])&va);
        else if (KIND == 2) pv_asm_41(*(f32x16(*)[4])&oacc, *(const bf16x8(*)[1][2])&pb, *(const unsigned(*)[2])&va);
        else pv_asm_42(*(f32x16(*)[4])&oacc, *(const bf16x8(*)[2][2])&pb, *(const unsigned(*)[4])&va);
      }
    }
    if (ti + 1 < ntiles) sstore((ti + 1) & 1);
    __syncthreads();
  }
  unsigned pfa = 0u;
  if (nb >= 0) {
    const u16* K2; const u16* V2;
    if (KIND == 0) { K2 = p.QK + 1024 + nhh * 128; V2 = p.Vt + (size_t)(nhh * 128) * T; }
    else if (KIND == 1) { K2 = p.QK + 1024 + (nhh >> 2) * 64; V2 = p.Vt + (size_t)((nhh >> 2) * 64) * T; }
    else if (KIND == 2) { K2 = p.QK + (size_t)T * 1536 + nhh * 128; V2 = p.Vt + (size_t)(nhh * 128) * T; }
    else { K2 = p.QK + 1024 + (nhh >> 1) * 128; V2 = p.Vt + (size_t)((nhh >> 1) * 128) * T; }
    constexpr int LK = KRB / 128;
    const int tokb2 = nb * TPB;
    const char* pp = nullptr;
    if (tid < 64 * LK) {
      const int row = tid / LK, ln = tid - row * LK;
      if (KIND == 2 && ln == 2) pp = (const char*)(p.KR + (size_t)(tokb2 + row) * 64);
      else pp = (const char*)(K2 + (size_t)(tokb2 + row) * LDK + ln * 64);
    } else if (tid - 64 * LK < DV) {
      pp = (const char*)(V2 + (size_t)(tid - 64 * LK) * T + tokb2);
    }
    if (pp) asm volatile("global_load_dword %0, %1, off" : "=v"(pfa) : "v"(pp) : "memory");
  }
  float den = l;
  if (KIND == 1) den += __builtin_amdgcn_exp2f(p.b_sink[hh] * 1.4426950408889634f - m * sl2);
  const float inv = 1.f / den;
  constexpr int ORS = DV * 2 + 16;
  char* sO = smem + (KIND == 0 ? 65536 : 40960) + (KIND == 0 ? wq : wave) * (32 * ORS);
  if (KIND != 0) {
#pragma unroll
    for (int c = 0; c < NC; ++c)
#pragma unroll
      for (int r4 = 0; r4 < 4; ++r4) {
        int d = 32 * c + 8 * r4 + 4 * h;
        *(u32x2*)(sO + ql * ORS + d * 2) = u32x2{pack2(oacc[c][4 * r4] * inv, oacc[c][4 * r4 + 1] * inv),
                                                 pack2(oacc[c][4 * r4 + 2] * inv, oacc[c][4 * r4 + 3] * inv)};
      }
  } else {
    float* sX = (float*)smem;
    if (grp == 1) {
#pragma unroll
      for (int c = 0; c < NC; ++c)
#pragma unroll
        for (int r = 0; r < 16; ++r) sX[((wq * 4 + c) * 16 + r) * 64 + lane] = oacc[c][r] * inv;
    }
    __syncthreads();
    if (grp == 0) {
      float ss = 0.f;
#pragma unroll
      for (int c = 0; c < NC; ++c)
#pragma unroll
        for (int r = 0; r < 16; ++r) {
          float dv = oacc[c][r] * inv - lam * sX[((wq * 4 + c) * 16 + r) * 64 + lane];
          oacc[c][r] = dv; ss += dv * dv;
        }
      ss += __shfl_xor(ss, 32);
      const float rstd = rsqrtf(ss * (1.f / 128.f) + EPS) * 0.8f;
#pragma unroll
      for (int c = 0; c < NC; ++c)
#pragma unroll
        for (int r4 = 0; r4 < 4; ++r4) {
          int d = 32 * c + 8 * r4 + 4 * h;
          float4 g = *(const float4*)(p.a_subln + d);
          *(u32x2*)(sO + ql * ORS + d * 2) = u32x2{pack2(oacc[c][4 * r4] * rstd * g.x, oacc[c][4 * r4 + 1] * rstd * g.y),
                                                   pack2(oacc[c][4 * r4 + 2] * rstd * g.z, oacc[c][4 * r4 + 3] * rstd * g.w)};
        }
    }
  }
  if (KIND != 0 || grp == 0) {
    __threadfence_block();
    u16* obase = p.AO + (size_t)(tokb + q0 + wq * 32) * DM + aoff;
    constexpr int CPR = DV / 8;
#pragma unroll
    for (int k = 0; k < 32 * CPR / 64; ++k) {
      const int idx = k * 64 + lane;
      const int row = idx / CPR, ch = idx - row * CPR;
      const u32x4 v = *(const u32x4*)(sO + row * ORS + ch * 16);
      *(u32x4*)(obase + (size_t)row * DM + ch * 8) = v;
    }
  }
  asm volatile("s_waitcnt vmcnt(0)" :: "v"(pfa) : "memory");
  if (KIND == 0) __syncthreads();
}

template <int KIND>
DI void attn_phase_mfma(const Params& p, bool lat_only, char* smem) {
  constexpr int NH = KIND == 1 ? 16 : 8;
  constexpr int QTC = KIND == 0 ? 2 : 1, QTL = KIND == 0 ? 16 : 8;
  float lam = 0.f;
  if (KIND == 0) {
    const int lane = tidx() & 63;
    float s1 = wave_sum(p.a_lq1[lane] * p.a_lk1[lane]);
    float s2 = wave_sum(p.a_lq2[lane] * p.a_lk2[lane]);
    lam = __expf(s1) - __expf(s2) + 0.2f;
  }
  const int n_lat = NBATCH * NH * QTL, n_ctx = lat_only ? 0 : NBATCH * NH * QTC;
#pragma unroll 1
  for (int i = blockIdx.x; i < n_lat + n_ctx; i += gridDim.x) {
    int b, hh, qt;
    if (i < n_lat) { b = i & 7; int j = i >> 3; hh = j / QTL; qt = QTC + (j - hh * QTL); }
    else { int i2 = i - n_lat; b = i2 & 7; int j = i2 >> 3; hh = j / QTC; qt = j - hh * QTC; }
    int nb = -1, nhh = 0;
    {
      const int i3 = i + gridDim.x;
      if (i3 < n_lat + n_ctx) {
        if (i3 < n_lat) { nb = i3 & 7; nhh = (i3 >> 3) / QTL; }
        else { const int i4 = i3 - n_lat; nb = i4 & 7; nhh = (i4 >> 3) / QTC; }
      }
    }
    attn_item<KIND>(p, b, hh, qt, smem, lam, nb, nhh);
  }
}


#define XB_TMO      128
#define XB_XCNT(j)  (256  + 64 * (j))
#define XB_XSUB(j)  (1280 + 64 * (j))
#define XB_XGEN(j)  (2304 + 64 * (j))
#define XB_TOP      3328
#define XB_TOPGEN   3392
#define XCD_BAR_WORDS 3456
#define XB_SPIN_CAP (1u << 18)
#define LAS __attribute__((address_space(3)))
DI unsigned xb_ld(unsigned* p)              { return __hip_atomic_load(p, __ATOMIC_RELAXED, __HIP_MEMORY_SCOPE_AGENT); }
DI unsigned xb_add(unsigned* p, unsigned v) { return __hip_atomic_fetch_add(p, v, __ATOMIC_RELAXED, __HIP_MEMORY_SCOPE_AGENT); }
DI unsigned xb_xcc_id() { return (unsigned)__builtin_amdgcn_s_getreg((3 << 11) | 20) & 0xFu; }
#define XB_SPIN(cond, bar) do { unsigned _sp = 0; while (cond) { __builtin_amdgcn_s_sleep(1); \
    if ((++_sp & 255u) == 0u) { if (xb_ld(&(bar)[XB_TMO])) break; if (_sp > XB_SPIN_CAP) { atomicAdd(&(bar)[XB_TMO], 1u); break; } } } } while (0)
struct XcdBarrier { unsigned* bar; unsigned x; volatile LAS unsigned* st; };
DI XcdBarrier xcd_barrier_post(unsigned* bar, volatile LAS unsigned* st) {
    XcdBarrier b; b.bar = bar; b.x = xb_xcc_id(); b.st = st;
    if (threadIdx.x == 0) (void)xb_add(&bar[XB_XCNT(b.x)], 1u);
    return b;
}
DI void xcd_barrier_complete(unsigned* bar, unsigned x, unsigned& nloc, unsigned& nx) {
    const unsigned G = gridDim.x * gridDim.y * gridDim.z;
    unsigned sum, cnt, mine, sp = 0u;
    for (;;) {
        sum = 0u; cnt = 0u; mine = 0u;
#pragma unroll
        for (unsigned j = 0; j < 16; ++j) { const unsigned c = xb_ld(&bar[XB_XCNT(j)]); sum += c; cnt += (c > 0u) ? 1u : 0u; mine = (j == x) ? c : mine; }
        if (sum == G) break;
        __builtin_amdgcn_s_sleep(1);
        if ((++sp & 255u) == 0u) { if (xb_ld(&bar[XB_TMO])) break; if (sp > XB_SPIN_CAP) { atomicAdd(&bar[XB_TMO], 1u); break; } }
    }
    nloc = mine > 0u ? mine : 1u; nx = cnt > 0u ? cnt : 1u;
}
DI void xcd_barrier(const XcdBarrier& b) {
    asm volatile("s_waitcnt vmcnt(0)" ::: "memory");
    __syncthreads();
    if (threadIdx.x == 0) {
        unsigned* bar = b.bar;
        __builtin_amdgcn_s_waitcnt(0);
        unsigned nloc = b.st[0], nx = b.st[1];
        if (nloc == 0u) { xcd_barrier_complete(bar, b.x, nloc, nx); b.st[0] = nloc; b.st[1] = nx; }
        const unsigned old = xb_add(&bar[XB_XSUB(b.x)], 1u);
        const unsigned gen = old / nloc;
        if (old + 1u == (gen + 1u) * nloc) {
            __builtin_amdgcn_fence(__ATOMIC_RELEASE, "agent");
            asm volatile("s_waitcnt vmcnt(0)" ::: "memory");
            const unsigned og = xb_add(&bar[XB_TOP], 1u);
            const unsigned tg = og / nx;
            if (og + 1u == (tg + 1u) * nx) xb_add(&bar[XB_TOPGEN], 1u);
            else XB_SPIN(xb_ld(&bar[XB_TOPGEN]) == tg, bar);
            __builtin_amdgcn_fence(__ATOMIC_ACQUIRE, "agent");
            xb_add(&bar[XB_XGEN(b.x)], 1u);
            asm volatile("s_waitcnt vmcnt(0)" ::: "memory");
        } else {
            XB_SPIN(xb_ld(&bar[XB_XGEN(b.x)]) == gen, bar);
            __builtin_amdgcn_fence(__ATOMIC_ACQUIRE, "agent");
            asm volatile("s_waitcnt vmcnt(0)" ::: "memory");
        }
    }
    __syncthreads();
}

__global__ void __launch_bounds__(NTHR) mega(Params p) {
  __shared__ __attribute__((aligned(16))) char smem[SMEM_BYTES];
  cg::grid_group grid = cg::this_grid();
  __shared__ uint4 xb_words;
  if (threadIdx.x == 0) xb_words = make_uint4(0u, 0u, 0u, 0u);
  __syncthreads();
  const XcdBarrier xb = xcd_barrier_post(p.bar, (volatile LAS unsigned*)&xb_words);
  for (int ph = p.ph_lo; ph < p.ph_hi; ++ph) {
    if (ph > p.ph_lo) { if (p.ph_hi < 0) grid.sync(); else xcd_barrier(xb); }
    const int code = p.prog[ph];
    const int layer = (code >> 4) & 15, op = code & 15;
    const bool last = layer == 3;
    const float gs = (code & 256) ? 0.f : 1.f;
    switch (op) {
      case OP_PRO: prologue(p, smem); break;
      case OP_NORM1: norm_phase(p, layer, 0, false); break;
      case OP_QKV: qkv_phase(p, layer, smem); break;
      case OP_MLA_DOWN: mla_down_phase(p, smem); break;
      case OP_MLA_UP: mla_up_phase(p, smem); break;
      case OP_ATTN:
        if (layer == 0) attn_phase_mfma<0>(p, false, smem);
        else if (layer == 1) attn_phase_mfma<1>(p, false, smem);
        else if (layer == 2) attn_phase_mfma<2>(p, false, smem);
        else attn_phase_mfma<3>(p, true, smem);
        break;
      case OP_OPROJ: resid_gemm_phase(p, layer, p.AO, DM, DM, p.Wo[layer], 2, last, smem, gs); break;
      case OP_NORM2: norm_phase(p, layer, 1, last); break;
      case OP_FFN_UP: ffn_up_phase(p, layer, last, smem); break;
      case OP_FFN_DOWN: resid_gemm_phase(p, layer, p.G, DFF, DFF, p.Wdn[layer], 5, last, smem, gs); break;
      case OP_FINAL: final_phase(p); break;
      default: break;
    }
  }
}

static inline size_t al256(size_t x) { return (x + 255) & ~(size_t)255; }

extern "C" void kernel_launch(void* const* d_in, const int* in_sizes, int n_in, void* d_out, int out_size, void* d_ws,
                              size_t ws_size, hipStream_t stream) {
  Params p;
  memset(&p, 0, sizeof(p));
  auto F = [&](int i) { return (const float*)d_in[i]; };
  p.x = F(0); p.c = F(1); p.ctx = F(2); p.c_ctx = F(3); p.ada_w = F(4); p.ada_b = F(5); p.norm1_g = F(6); p.norm2_g = F(7);
  const float* ffn_up = F(8); p.conv_w = F(9); p.conv_b = F(10); const float* ffn_down = F(11);
  const float* a_w_qkv = F(12); const float* a_w_o = F(13);
  p.a_lq1 = F(14); p.a_lk1 = F(15); p.a_lq2 = F(16); p.a_lk2 = F(17); p.a_subln = F(18);
  const float* b_w_qkv = F(19); const float* b_w_o = F(20); p.b_sink = F(21);
  const float* c_w_down = F(22); const float* c_qg = F(23); const float* c_kvg = F(24);
  const float* c_w_uq = F(25); const float* c_w_ukv = F(26); const float* c_w_o = F(27);
  const float* d_w_qkv = F(28); p.d_qg = F(29); p.d_kg = F(30); const float* d_w_o = F(31);
  p.final_g = F(32);
  p.out = (float*)d_out;

  char* ws = (char*)d_ws; size_t off = 0;
  auto take = [&](size_t bytes) { char* r = ws + off; off = al256(off + bytes); return r; };
  p.bar = (unsigned*)take((size_t)XCD_BAR_WORDS * 4);
  p.Rctx = (float*)take((size_t)NBATCH * CTXL * DM * 4);
  p.MOD = (float*)take((size_t)4 * 9 * 6144 * 4);
  p.rope64 = (float*)take((size_t)131072 * 4);
  p.rope128 = (float*)take((size_t)262144 * 4);
  p.H = (u16*)take((size_t)T * DM * 2 + 4096);
  char* region = take((size_t)T * 2560 * 2 + (size_t)T * 1024 * 2 * 2 + (size_t)T * 768 * 2 + (size_t)T * 64 * 2);
  p.QK = (u16*)region;
  p.Vt = p.QK + (size_t)T * 2560;
  p.AO = p.Vt + (size_t)T * 1024;
  p.T1 = p.AO + (size_t)T * 1024;
  p.KR = p.T1 + (size_t)T * 768;
  p.G = (u16*)region;
  for (int l = 0; l < 4; ++l) {
    p.Wup[l] = (u16*)take((size_t)5632 * 1024 * 2);
    p.Wdn[l] = (u16*)take((size_t)1024 * 2816 * 2);
    p.Wo[l] = (u16*)take((size_t)1024 * 1024 * 2);
  }
  p.Wa_qkv = (u16*)take((size_t)3072 * 1024 * 2);
  p.Wb_qkv = (u16*)take((size_t)1536 * 1024 * 2);
  p.Wc_d = (u16*)take((size_t)768 * 1024 * 2);
  p.Wc_uq = (u16*)take((size_t)1536 * 384 * 2);
  p.Wc_uk = (u16*)take((size_t)1024 * 256 * 2);
  p.Wc_uv = (u16*)take((size_t)1024 * 256 * 2);
  p.Wd_qkv = (u16*)take((size_t)2048 * 1024 * 2);
  if (off > ws_size) { fprintf(stderr, "workspace too small: need %zu have %zu\n", off, ws_size); return; }

  int nj = 0, tiles = 0;
  auto job = [&](const float* src, u16* dst, const float* g, int K, int N, int ld, int grp, int gstride, int o, int mode) {
    Job& j = p.jobs[nj++];
    j.src = src; j.dst = dst; j.g = g; j.K = K; j.N = N; j.ld = ld; j.grp = grp; j.gstride = gstride; j.off = o; j.mode = mode; j.tile0 = tiles;
    tiles += (K / 64) * (N / 64);
  };
  const int BIG = 1 << 30;
  const float* wo_src[4] = {a_w_o, b_w_o, c_w_o, d_w_o};
  for (int l = 0; l < 4; ++l) {
    p.ltile[l] = tiles;
    if (l == 0) job(a_w_qkv, p.Wa_qkv, nullptr, 1024, 3072, 3072, BIG, 0, 0, 0);
    if (l == 1) job(b_w_qkv, p.Wb_qkv, nullptr, 1024, 1536, 1536, BIG, 0, 0, 0);
    if (l == 2) {
      job(c_w_down, p.Wc_d, nullptr, 1024, 768, 704, BIG, 0, 0, 2);
      job(c_w_uq, p.Wc_uq, c_qg, 384, 1536, 1536, BIG, 0, 0, 0);
      job(c_w_ukv, p.Wc_uk, c_kvg, 256, 1024, 2048, 128, 256, 0, 0);
      job(c_w_ukv, p.Wc_uv, c_kvg, 256, 1024, 2048, 128, 256, 128, 0);
    }
    if (l == 3) job(d_w_qkv, p.Wd_qkv, nullptr, 1024, 2048, 2048, BIG, 0, 0, 0);
    job(wo_src[l], p.Wo[l], nullptr, 1024, 1024, 1024, BIG, 0, 0, 0);
    job(ffn_up + (size_t)l * 1024 * 5632, p.Wup[l], nullptr, 1024, 5632, 5632, BIG, 0, 0, 1);
    job(ffn_down + (size_t)l * 2816 * 1024, p.Wdn[l], nullptr, 2816, 1024, 1024, BIG, 0, 0, 0);
  }
  p.ltile[4] = tiles; p.ltile[5] = 0;
  p.njobs = nj; p.conv_tiles = tiles;

  int np = 0;
  p.prog[np++] = OP_PRO;
  for (int l = 0; l < 4; ++l) {
    p.prog[np++] = l * 16 + OP_NORM1;
    if (l == 2) { p.prog[np++] = l * 16 + OP_MLA_DOWN; p.prog[np++] = l * 16 + OP_MLA_UP; }
    else p.prog[np++] = l * 16 + OP_QKV;
    p.prog[np++] = l * 16 + OP_ATTN;
    p.prog[np++] = l * 16 + OP_OPROJ;
    p.prog[np++] = l * 16 + OP_NORM2;
    p.prog[np++] = l * 16 + OP_FFN_UP;
    p.prog[np++] = l * 16 + OP_FFN_DOWN;
  }
  p.prog[np++] = 3 * 16 + OP_FINAL;
#ifdef PROBE_DUP_OP
  {
    int tmp[48]; int n2 = 0;
    for (int i = 0; i < np; ++i) { tmp[n2++] = p.prog[i]; if ((p.prog[i] & 15) == PROBE_DUP_OP) tmp[n2++] = p.prog[i] | 256; }
    for (int i = 0; i < n2; ++i) p.prog[i] = tmp[i];
    np = n2;
  }
#endif
  p.nprog = np;

  static int grid_blocks = 0;
  if (!grid_blocks) {
    int dev = 0, cus = 0, per_cu = 0;
    hipGetDevice(&dev);
    hipDeviceGetAttribute(&cus, hipDeviceAttributeMultiprocessorCount, dev);
    hipOccupancyMaxActiveBlocksPerMultiprocessor(&per_cu, mega, NTHR, 0);
    if (per_cu < 1) per_cu = 1;
    grid_blocks = cus * per_cu;
  }
#if MULTI_LAUNCH
  for (int ph = 0; ph < np; ++ph) {
    p.ph_lo = ph; p.ph_hi = ph + 1;
    hipLaunchKernelGGL(mega, dim3(grid_blocks), dim3(NTHR), 0, stream, p);
  }
#else
  p.ph_lo = 0; p.ph_hi = np;
  hipMemsetAsync(p.bar, 0, (size_t)XCD_BAR_WORDS * 4, stream);
  void* args[] = {&p};
  hipError_t e = hipLaunchCooperativeKernel((void*)mega, dim3(grid_blocks), dim3(NTHR), args, 0, stream);
  if (e != hipSuccess) fprintf(stderr, "cooperative launch failed: %s (grid %d)\n", hipGetErrorString(e), grid_blocks);
#endif
}
```

```cpp
#include <hip/hip_runtime.h>
#include <hip/hip_cooperative_groups.h>
#include <cstdio>
#include <cstring>
namespace cg = cooperative_groups;

#ifndef REF_ATTN
#define REF_ATTN 0
#endif
#ifndef MULTI_LAUNCH
#define MULTI_LAUNCH 0
#endif

typedef unsigned short u16;
using bf16x8 = __attribute__((ext_vector_type(8))) short;
using f32x16 = __attribute__((ext_vector_type(16))) float;
using u32x4 = __attribute__((ext_vector_type(4))) unsigned;
using u32x2 = __attribute__((ext_vector_type(2))) unsigned;
using f32x4 = __attribute__((ext_vector_type(4))) float;
using f32x2 = __attribute__((ext_vector_type(2))) float;
#define DI __device__ __forceinline__
DI int threadIdx_x_raw() { return (int)__builtin_amdgcn_workitem_id_x(); }

constexpr int DM = 1024, NBATCH = 8, SEQ = 2048, CTXL = 256, TPB = 2304, T = 18432, DFF = 2816;
constexpr int NTHR = 512;
constexpr int CLD = 260;
constexpr int STAGE_BYTES = 131072;
constexpr int BND_OFF = 128 * CLD * 4;
constexpr int RS_OFF = BND_OFF + 4 * 256 * 4;
constexpr int SMEM_BYTES = RS_OFF + 1024;
constexpr float EPS = 1e-6f;

enum { OP_PRO = 0, OP_NORM1, OP_QKV, OP_MLA_DOWN, OP_MLA_UP, OP_ATTN, OP_OPROJ, OP_NORM2, OP_FFN_UP, OP_FFN_DOWN, OP_FINAL };

struct Job { const float* src; u16* dst; const float* g; int K, N, ld, grp, gstride, off, mode, tile0; };

struct Params {
  const float *x, *c, *ctx, *c_ctx, *ada_w, *ada_b, *norm1_g, *norm2_g, *conv_w, *conv_b;
  const float *a_lq1, *a_lk1, *a_lq2, *a_lk2, *a_subln, *b_sink, *d_qg, *d_kg, *final_g;
  float *out, *Rctx, *MOD, *rope64, *rope128;
  u16 *H, *QK, *Vt, *AO, *T1, *KR, *G;
  unsigned* bar;
  u16 *Wup[4], *Wdn[4], *Wo[4];
  u16 *Wa_qkv, *Wb_qkv, *Wc_d, *Wc_uq, *Wc_uk, *Wc_uv, *Wd_qkv;
  Job jobs[20];
  int njobs, conv_tiles, nprog, ph_lo, ph_hi, pad0;
  int ltile[6];
  int prog[48];
};

DI int tidx() { int t = threadIdx_x_raw(); asm volatile("" : "+v"(t)); return t; }
DI u16 f2bf(float x) { unsigned u = __float_as_uint(x); u += 0x7fffu + ((u >> 16) & 1u); return (u16)(u >> 16); }
DI float bf2f(u16 h) { return __uint_as_float(((unsigned)h) << 16); }
DI float bflo(unsigned w) { return __uint_as_float(w << 16); }
DI float bfhi(unsigned w) { return __uint_as_float(w & 0xffff0000u); }
DI unsigned pack2(float a, float b) { unsigned r; asm("v_cvt_pk_bf16_f32 %0, %1, %2" : "=v"(r) : "v"(a), "v"(b)); return r; }
DI float wave_sum(float v) { for (int o = 32; o; o >>= 1) v += __shfl_xor(v, o); return v; }
DI float wave_max(float v) { for (int o = 32; o; o >>= 1) v = fmaxf(v, __shfl_xor(v, o)); return v; }
DI void swap32(float x, float& lo, float& hi) {
  auto r = __builtin_amdgcn_permlane32_swap(__float_as_uint(x), __float_as_uint(x), false, false);
  lo = __uint_as_float(r[0]); hi = __uint_as_float(r[1]);
}
DI float xmax32(float x) { float a, b; swap32(x, a, b); return fmaxf(a, b); }
DI float xsum32(float x) { float a, b; swap32(x, a, b); return a + b; }
DI float siluf(float v) { return v * __builtin_amdgcn_rcpf(1.f + __expf(-v)); }

DI float* rrow(const Params& p, int t) {
  int b = t / TPB, r = t - b * TPB;
  return r < CTXL ? p.Rctx + (size_t)(b * CTXL + r) * DM : p.out + (size_t)(b * SEQ + r - CTXL) * DM;
}
DI const float* xrow(const Params& p, int t) {
  int b = t / TPB, r = t - b * TPB;
  const float* px = p.x; const float* pc = p.ctx;
  asm volatile("" : "+s"(px), "+s"(pc));
  return r < CTXL ? pc + (size_t)(b * CTXL + r) * DM : px + (size_t)(b * SEQ + r - CTXL) * DM;
}
DI int modrow(int t) { int b = t / TPB, r = t - b * TPB; return r < CTXL ? 8 : b; }
DI int lat_token(int li) { int b = li >> 11; return b * TPB + CTXL + (li & 2047); }

struct CvT { const float* src; u16* dst; const float* g; int ld, K, k0, n0, col; bool ok, okcol; };
DI CvT cv_decode(const Params& p, int tile, bool ok, int t) {
  CvT c;
  int jb = 0;
  for (int q = 1; q < p.njobs; ++q) if (tile >= p.jobs[q].tile0) jb = q;
  const Job& j = p.jobs[jb];
  const int tl = tile - j.tile0;
  const int ntn = j.N >> 6;
  const int kt = tl / ntn, nt = tl - kt * ntn;
  c.k0 = kt * 64; c.n0 = nt * 64;
  const int n = c.n0 + (t & 63);
  c.okcol = true;
  if (j.mode == 1) c.col = (n >> 8) * 128 + (n & 127) + ((n >> 7) & 1) * DFF;
  else if (j.mode == 2) { c.col = n; c.okcol = n < 704; }
  else c.col = (n / j.grp) * j.gstride + (n % j.grp) + j.off;
  c.src = j.src; c.dst = j.dst; c.g = j.g; c.ld = j.ld; c.K = j.K; c.ok = ok;
  return c;
}
DI void convert_tiles(const Params& p, int tile0, int ntiles, char* smem) {
  const int tid = tidx();
  const int half = tid >> 8, t = tid & 255;
  const int nl = t & 63, kk = t >> 6;
  const int tA = tile0 + half * 2, tB = tA + 1;
  const CvT ca = cv_decode(p, tA < ntiles ? tA : 0, tA < ntiles, t), cb = cv_decode(p, tB < ntiles ? tB : 0, tB < ntiles, t);
  float* stA = (float*)smem + (half * 2) * (64 * 65); float* stB = stA + 64 * 65;
  float va[16], vb[16];
#pragma unroll
  for (int i = 0; i < 16; ++i) va[i] = (ca.ok && ca.okcol) ? ca.src[(size_t)(ca.k0 + kk + 4 * i) * ca.ld + ca.col] : 0.f;
#pragma unroll
  for (int i = 0; i < 16; ++i) vb[i] = (cb.ok && cb.okcol) ? cb.src[(size_t)(cb.k0 + kk + 4 * i) * cb.ld + cb.col] : 0.f;
#pragma unroll
  for (int i = 0; i < 16; ++i) {
    const int kl = kk + 4 * i;
    float x = va[i]; if (ca.g) x *= ca.g[ca.k0 + kl];
    stA[kl * 65 + nl] = x;
    float y = vb[i]; if (cb.g) y *= cb.g[cb.k0 + kl];
    stB[kl * 65 + nl] = y;
  }
  __syncthreads();
  {
    const int n2 = t >> 2, kc = t & 3;
    if (ca.ok) {
      unsigned w[8];
#pragma unroll
      for (int i = 0; i < 8; ++i) w[i] = pack2(stA[(kc * 16 + 2 * i) * 65 + n2], stA[(kc * 16 + 2 * i + 1) * 65 + n2]);
      u32x4* d = (u32x4*)(ca.dst + (size_t)(ca.n0 + n2) * ca.K + ca.k0 + kc * 16);
      d[0] = u32x4{w[0], w[1], w[2], w[3]}; d[1] = u32x4{w[4], w[5], w[6], w[7]};
    }
    if (cb.ok) {
      unsigned w[8];
#pragma unroll
      for (int i = 0; i < 8; ++i) w[i] = pack2(stB[(kc * 16 + 2 * i) * 65 + n2], stB[(kc * 16 + 2 * i + 1) * 65 + n2]);
      u32x4* d = (u32x4*)(cb.dst + (size_t)(cb.n0 + n2) * cb.K + cb.k0 + kc * 16);
      d[0] = u32x4{w[0], w[1], w[2], w[3]}; d[1] = u32x4{w[4], w[5], w[6], w[7]};
    }
  }
  __syncthreads();
}

DI void mod_item2(const Params& p, int item, bool ok_item, char* smem) {
  float* ss = (float*)smem;
  const int tid = tidx();
  const int half = tid >> 8, t = tid & 255;
  float* red = ss + 9 * 1024 + half * (4 * 576);
  const int layer = item / 96, n0 = (item % 96) * 64;
  for (int i = tid; i < 9 * 1024; i += NTHR) {
    int r = i >> 10, k = i & 1023;
    float v = r < 8 ? p.c[r * 1024 + k] : p.c_ctx[k];
    ss[i] = siluf(v);
  }
  __syncthreads();
  const int cq = t & 15, kg = t >> 4;
  f32x4 acc[9];
#pragma unroll
  for (int r = 0; r < 9; ++r) acc[r] = f32x4{0.f, 0.f, 0.f, 0.f};
  if (ok_item) {
    const float* w = p.ada_w + (size_t)layer * 1024 * 6144 + n0 + cq * 4 + (size_t)(kg * 64) * 6144;
#pragma unroll 1
    for (int kb = 0; kb < 64; kb += 8) {
      f32x4 wv[8];
#pragma unroll
      for (int u = 0; u < 8; ++u) wv[u] = *(const f32x4*)(w + (size_t)(kb + u) * 6144);
#pragma unroll
      for (int u = 0; u < 8; ++u) {
        const int k = kg * 64 + kb + u;
#pragma unroll
        for (int r = 0; r < 9; ++r) acc[r] += ss[r * 1024 + k] * wv[u];
      }
    }
  }
#pragma unroll
  for (int r = 0; r < 9; ++r)
#pragma unroll
    for (int e = 0; e < 4; ++e) {
      float x = acc[r][e];
      x += __shfl_xor(x, 16); x += __shfl_xor(x, 32);
      acc[r][e] = x;
    }
  const int wv4 = t >> 6, lane = t & 63;
  if (lane < 16) {
#pragma unroll
    for (int r = 0; r < 9; ++r) *(f32x4*)(red + (wv4 * 9 + r) * 64 + lane * 4) = acc[r];
  }
  __syncthreads();
  if (ok_item) {
    for (int i = t; i < 576; i += 256) {
      int c = i & 63;
      float v = red[i] + red[576 + i] + red[1152 + i] + red[1728 + i] + p.ada_b[layer * 6144 + n0 + c];
      p.MOD[((size_t)layer * 9 + (i >> 6)) * 6144 + n0 + c] = v;
    }
  }
  __syncthreads();
}

DI void sincos_acc(float ang, float& c, float& s) {
  float k = rintf(ang * 0.15915494309189535f);
  float x = fmaf(-k, 6.28318548202514648f, ang);
  x = fmaf(-k, -1.7484555e-7f, x);
  c = __cosf(x); s = __sinf(x);
}

DI void rope_item(const Params& p, int item) {
  int e = item * NTHR + tidx();
  if (e < 65536) {
    int pos = e >> 5, i = e & 31;
    int f = i & 15; float posv = (i < 16) ? (float)(pos >> 6) : (float)(pos & 63);
    float inv = exp2f(-(float)f / 16.f * 13.287712379549449f);
    float c, s; sincos_acc(posv * inv, c, s);
    p.rope64[e] = c; p.rope64[65536 + e] = s;
  } else {
    e -= 65536;
    int pos = e >> 6, i = e & 63;
    int f = i & 31; float posv = (i < 32) ? (float)(pos >> 6) : (float)(pos & 63);
    float inv = exp2f(-(float)f / 32.f * 13.287712379549449f);
    float c, s; sincos_acc(posv * inv, c, s);
    p.rope128[e] = c; p.rope128[131072 + e] = s;
  }
}

DI void prologue(const Params& p, char* smem) {
  const int n_mod2 = 48, n_rope = 384;
  const int G = gridDim.x;
#pragma unroll 1
  for (int i = blockIdx.x; i < n_mod2; i += G) mod_item2(p, 2 * i + (tidx() >> 8), true, smem);
  const int nconv0 = p.ltile[1];
  const int nct2 = (nconv0 + 3) >> 2;
  int start = (blockIdx.x + G - (n_mod2 % G)) % G;
#pragma unroll 1
  for (int i = start; i < nct2; i += G) convert_tiles(p, 4 * i, nconv0, smem);
#pragma unroll 1
  for (int i = blockIdx.x; i < n_rope; i += G) rope_item(p, i);
}

DI void norm_phase(const Params& p, int layer, int which  , bool lat_only) {
  const int lane = tidx() & 63, wave = tidx() >> 6;
  const int nrows = lat_only ? SEQ : TPB;
  const int grp8 = blockIdx.x & 7, slot = blockIdx.x >> 3, per = gridDim.x >> 3;
  const int tbase = grp8 * TPB + (lat_only ? CTXL : 0);
  const float* g = (which ? p.norm2_g : p.norm1_g) + layer * DM;
#pragma unroll 1
  for (int it = slot; it * 16 < nrows && slot < per; it += per) {
    f32x4 v[2][4];
    int tt[2];
#pragma unroll
    for (int u = 0; u < 2; ++u) {
      int ri = it * 16 + wave * 2 + u;
      tt[u] = tbase + ri;
      const float* xr = (layer == 0 && which == 0) ? xrow(p, tt[u]) : (const float*)rrow(p, tt[u]);
#pragma unroll
      for (int q = 0; q < 2; ++q) {
        v[u][2 * q] = *(const f32x4*)(xr + q * 512 + lane * 8);
        v[u][2 * q + 1] = *(const f32x4*)(xr + q * 512 + lane * 8 + 4);
      }
    }
#pragma unroll
    for (int u = 0; u < 2; ++u) {
      const int t = tt[u];
      const float* md = p.MOD + ((size_t)layer * 9 + modrow(t)) * 6144 + which * 3072;
      float ss = 0;
#pragma unroll
      for (int q = 0; q < 4; ++q) ss += v[u][q][0] * v[u][q][0] + v[u][q][1] * v[u][q][1] + v[u][q][2] * v[u][q][2] + v[u][q][3] * v[u][q][3];
      ss = wave_sum(ss);
      const float rstd = rsqrtf(ss * (1.f / DM) + EPS);
#pragma unroll
      for (int q = 0; q < 2; ++q) {
        const int cidx = q * 512 + lane * 8;
        unsigned w[4];
#pragma unroll
        for (int e = 0; e < 2; ++e) {
          const f32x4 gg = *(const f32x4*)(g + cidx + 4 * e);
          const f32x4 sh = *(const f32x4*)(md + cidx + 4 * e);
          const f32x4 sc = *(const f32x4*)(md + 1024 + cidx + 4 * e);
          const f32x4 y = v[u][2 * q + e] * rstd * gg * (sc + 1.f) + sh;
          w[2 * e] = pack2(y[0], y[1]); w[2 * e + 1] = pack2(y[2], y[3]);
        }
        *(u32x4*)(p.H + (size_t)t * DM + cidx) = u32x4{w[0], w[1], w[2], w[3]};
      }
    }
  }
}

DI void final_phase(const Params& p) {
  const int lane = tidx() & 63, wave = tidx() >> 6;
  const int grp8 = blockIdx.x & 7, slot = blockIdx.x >> 3, per = gridDim.x >> 3;
#pragma unroll 1
  for (int it = slot; it * 8 < SEQ && slot < per; it += per) {
    int ri = grp8 * SEQ + it * 8 + wave;
    float* xr = p.out + (size_t)ri * DM;
    float4 v[4]; float ss = 0;
#pragma unroll
    for (int q = 0; q < 4; ++q) {
      v[q] = *(const float4*)(xr + q * 256 + lane * 4);
      ss += v[q].x * v[q].x + v[q].y * v[q].y + v[q].z * v[q].z + v[q].w * v[q].w;
    }
    ss = wave_sum(ss);
    float rstd = rsqrtf(ss * (1.f / DM) + EPS);
#pragma unroll
    for (int q = 0; q < 4; ++q) {
      int cidx = q * 256 + lane * 4;
      float4 gg = *(const float4*)(p.final_g + cidx);
      float4 o = {v[q].x * rstd * gg.x, v[q].y * rstd * gg.y, v[q].z * rstd * gg.z, v[q].w * rstd * gg.w};
      *(float4*)(xr + cidx) = o;
    }
  }
}

DI int swz128(int row, int chunk) { return row * 128 + ((chunk ^ ((row >> 1) & 7)) << 4); }


DI void mma_ktile(f32x16 (&acc)[4][2], unsigned a0, unsigned a1, unsigned a2, unsigned a3, unsigned b0, unsigned b1, unsigned b2, unsigned b3) {
  u32x4 f0, f1, f2, f3, f4, f5, f6, f7, f8, f9;
  asm volatile(
      "ds_read_b128 %8, %18 offset:0\n\t"
      "ds_read_b128 %9, %18 offset:4096\n\t"
      "ds_read_b128 %10, %18 offset:8192\n\t"
      "ds_read_b128 %11, %18 offset:12288\n\t"
      "ds_read_b128 %16, %22 offset:0\n\t"
      "ds_read_b128 %17, %22 offset:4096\n\t"
      "ds_read_b128 %12, %19 offset:0\n\t"
      "ds_read_b128 %13, %19 offset:4096\n\t"
      "ds_read_b128 %14, %19 offset:8192\n\t"
      "ds_read_b128 %15, %19 offset:12288\n\t"
      "s_waitcnt lgkmcnt(4)\n\t"
      "v_mfma_f32_32x32x16_bf16 %0, %8, %16, %0\n\t"
      "v_mfma_f32_32x32x16_bf16 %2, %9, %16, %2\n\t"
      "v_mfma_f32_32x32x16_bf16 %4, %10, %16, %4\n\t"
      "v_mfma_f32_32x32x16_bf16 %6, %11, %16, %6\n\t"
      "ds_read_b128 %16, %23 offset:0\n\t"
      "v_mfma_f32_32x32x16_bf16 %1, %8, %17, %1\n\t"
      "v_mfma_f32_32x32x16_bf16 %3, %9, %17, %3\n\t"
      "v_mfma_f32_32x32x16_bf16 %5, %10, %17, %5\n\t"
      "v_mfma_f32_32x32x16_bf16 %7, %11, %17, %7\n\t"
      "ds_read_b128 %17, %23 offset:4096\n\t"
      "ds_read_b128 %8, %20 offset:0\n\t"
      "ds_read_b128 %9, %20 offset:4096\n\t"
      "ds_read_b128 %10, %20 offset:8192\n\t"
      "ds_read_b128 %11, %20 offset:12288\n\t"
      "s_waitcnt lgkmcnt(5)\n\t"
      "v_mfma_f32_32x32x16_bf16 %0, %12, %16, %0\n\t"
      "v_mfma_f32_32x32x16_bf16 %2, %13, %16, %2\n\t"
      "v_mfma_f32_32x32x16_bf16 %4, %14, %16, %4\n\t"
      "v_mfma_f32_32x32x16_bf16 %6, %15, %16, %6\n\t"
      "ds_read_b128 %16, %24 offset:0\n\t"
      "s_waitcnt lgkmcnt(5)\n\t"
      "v_mfma_f32_32x32x16_bf16 %1, %12, %17, %1\n\t"
      "v_mfma_f32_32x32x16_bf16 %3, %13, %17, %3\n\t"
      "v_mfma_f32_32x32x16_bf16 %5, %14, %17, %5\n\t"
      "v_mfma_f32_32x32x16_bf16 %7, %15, %17, %7\n\t"
      "ds_read_b128 %17, %24 offset:4096\n\t"
      "ds_read_b128 %12, %21 offset:0\n\t"
      "ds_read_b128 %13, %21 offset:4096\n\t"
      "ds_read_b128 %14, %21 offset:8192\n\t"
      "ds_read_b128 %15, %21 offset:12288\n\t"
      "s_waitcnt lgkmcnt(5)\n\t"
      "v_mfma_f32_32x32x16_bf16 %0, %8, %16, %0\n\t"
      "v_mfma_f32_32x32x16_bf16 %2, %9, %16, %2\n\t"
      "v_mfma_f32_32x32x16_bf16 %4, %10, %16, %4\n\t"
      "v_mfma_f32_32x32x16_bf16 %6, %11, %16, %6\n\t"
      "ds_read_b128 %16, %25 offset:0\n\t"
      "s_waitcnt lgkmcnt(5)\n\t"
      "v_mfma_f32_32x32x16_bf16 %1, %8, %17, %1\n\t"
      "v_mfma_f32_32x32x16_bf16 %3, %9, %17, %3\n\t"
      "v_mfma_f32_32x32x16_bf16 %5, %10, %17, %5\n\t"
      "v_mfma_f32_32x32x16_bf16 %7, %11, %17, %7\n\t"
      "ds_read_b128 %17, %25 offset:4096\n\t"
      "s_waitcnt lgkmcnt(1)\n\t"
      "v_mfma_f32_32x32x16_bf16 %0, %12, %16, %0\n\t"
      "v_mfma_f32_32x32x16_bf16 %2, %13, %16, %2\n\t"
      "v_mfma_f32_32x32x16_bf16 %4, %14, %16, %4\n\t"
      "v_mfma_f32_32x32x16_bf16 %6, %15, %16, %6\n\t"
      "s_waitcnt lgkmcnt(0)\n\t"
      "v_mfma_f32_32x32x16_bf16 %1, %12, %17, %1\n\t"
      "v_mfma_f32_32x32x16_bf16 %3, %13, %17, %3\n\t"
      "v_mfma_f32_32x32x16_bf16 %5, %14, %17, %5\n\t"
      "v_mfma_f32_32x32x16_bf16 %7, %15, %17, %7\n\t"
      "s_nop 15\n\t"
      "s_nop 7\n\t"
      : "+v"(acc[0][0]), "+v"(acc[0][1]), "+v"(acc[1][0]), "+v"(acc[1][1]), "+v"(acc[2][0]), "+v"(acc[2][1]), "+v"(acc[3][0]), "+v"(acc[3][1]),
        "=&v"(f0), "=&v"(f1), "=&v"(f2), "=&v"(f3), "=&v"(f4), "=&v"(f5), "=&v"(f6), "=&v"(f7), "=&v"(f8), "=&v"(f9)
      : "v"(a0), "v"(a1), "v"(a2), "v"(a3), "v"(b0), "v"(b1), "v"(b2), "v"(b3)
      : "memory");
}

struct NoPre { DI void operator()() const {} };
struct NextTile { const u16* Ap; const u16* Bp; int vlo, vhi; };
template <bool BND, class Epi, class Pre = NoPre>
DI void gemm_tile(const u16* __restrict__ Ap, int lda, int vlo, int vhi, const u16* __restrict__ Bp, int ldb, int K,
                  char* smem, NextTile nx, Epi&& epi, Pre&& pre = Pre()) {
  const int tid = tidx(), lane = tid & 63, wave = tid >> 6;
  const int wm = wave >> 2, wn = wave & 3;
  const int lr = tid >> 3, lc = tid & 7;
  f32x16 acc[4][2];
#pragma unroll
  for (int i = 0; i < 4; ++i)
#pragma unroll
    for (int j = 0; j < 2; ++j)
#pragma unroll
      for (int r = 0; r < 16; ++r) acc[i][j][r] = 0.f;
  u32x4 ra[4], rb[4];
  const unsigned offA = (unsigned)(lr * lda + lc * 8) * 2u, offB = (unsigned)(lr * ldb + lc * 8) * 2u;
  const unsigned strA = (unsigned)lda * 128u, strB = (unsigned)ldb * 128u;
  auto gload = [&](int k0) {
    const char* Ak = (const char*)Ap + (long)k0 * 2;
    const char* Bk = (const char*)Bp + (long)k0 * 2;
#pragma unroll
    for (int i = 0; i < 4; ++i) {
      int row = lr + 64 * i;
      u32x4 z = {0u, 0u, 0u, 0u};
      if (row >= vlo && row < vhi) z = *(const u32x4*)(Ak + (offA + (unsigned)i * strA));
      ra[i] = z;
      rb[i] = *(const u32x4*)(Bk + (offB + (unsigned)i * strB));
    }
  };
  auto sstore = [&](int buf) {
    char* sA = smem + buf * 65536; char* sB = sA + 32768;
#pragma unroll
    for (int i = 0; i < 4; ++i) {
      int row = lr + 64 * i;
      *(u32x4*)(sA + swz128(row, lc)) = ra[i];
      *(u32x4*)(sB + swz128(row, lc)) = rb[i];
    }
  };
  const int nk = K >> 6;
  const int half = wave >> 2;
  const unsigned lds0 = (unsigned)(size_t)smem;
  const unsigned offl = (unsigned)((lane & 31) * 128);
  const unsigned fx = (unsigned)((lane >> 1) & 7), hh = (unsigned)(lane >> 5);
  const unsigned aw = lds0 + (unsigned)(wm * 128 * 128) + offl, bw = lds0 + 32768u + (unsigned)(wn * 64 * 128) + offl;
  const unsigned o0 = ((0u + hh) ^ fx) << 4, o1 = ((2u + hh) ^ fx) << 4, o2 = ((4u + hh) ^ fx) << 4, o3 = ((6u + hh) ^ fx) << 4;
  auto compute = [&](int buf) {
    const unsigned bo = (unsigned)buf * 65536u;
    mma_ktile(acc, aw + bo + o0, aw + bo + o1, aw + bo + o2, aw + bo + o3, bw + bo + o0, bw + bo + o1, bw + bo + o2, bw + bo + o3);
  };
  gload(0); sstore(0);
  if (nk > 1) gload(64);
  __syncthreads();
#pragma unroll 1
  for (int it = 0; it < nk; ++it) {
    if (half == 0) compute(it & 1);
    else { if (it + 1 < nk) sstore((it + 1) & 1); if (it + 2 < nk) gload((it + 2) * 64); }
    __syncthreads();
    if (half == 1) compute(it & 1);
    else { if (it + 1 < nk) sstore((it + 1) & 1); if (it + 2 < nk) gload((it + 2) * 64); }
    __syncthreads();
  }
  float* sC = (float*)smem;
  const int h = lane >> 5;
  unsigned pf0 = 0u;
  if (nx.Ap != nullptr) {
    const int prow_ = tid & 255;
    const bool isb = tid >= 256;
    const char* pp = isb ? (const char*)(nx.Bp + (long)prow_ * ldb) : (const char*)(nx.Ap + (long)prow_ * lda);
    if (isb || (prow_ >= nx.vlo && prow_ < nx.vhi)) {
      asm volatile("global_load_dword %0, %1, off\n\tglobal_load_dword %0, %1, off offset:128" : "=&v"(pf0) : "v"(pp) : "memory");
    }
  }
  pre();
  if (BND) {
    float* bnd = (float*)(smem + BND_OFF);
#pragma unroll
    for (int j = 0; j < 2; ++j) {
      const int col = wn * 64 + j * 32 + (lane & 31);
      if (h == 0) bnd[(2 * wm) * 256 + col] = acc[0][j][0];
      else bnd[(2 * wm + 1) * 256 + col] = acc[3][j][15];
    }
  }
#pragma unroll
  for (int q = 0; q < 2; ++q) {
    if (wm == q) {
#pragma unroll
      for (int i = 0; i < 4; ++i)
#pragma unroll
        for (int j = 0; j < 2; ++j)
#pragma unroll
          for (int r = 0; r < 16; ++r) {
            int rl = i * 32 + (r & 3) + 8 * (r >> 2) + 4 * h;
            int col = wn * 64 + j * 32 + (lane & 31);
            sC[rl * CLD + col] = acc[i][j][r];
          }
    }
    __syncthreads();
    epi(sC, q);
    __syncthreads();
  }
  asm volatile("s_waitcnt vmcnt(0)" :: "v"(pf0) : "memory");
}

DI void epi_store(const float* sC, int q, u16* dst, long ldd, const float* rowscale  , f32x4 cs) {
  const int lane = tidx() & 63, wave = tidx() >> 6;
#pragma unroll
  for (int rr = 0; rr < 16; ++rr) {
    const int lr = wave * 16 + rr, R = q * 128 + lr;
    f32x4 v = *(const f32x4*)(sC + lr * CLD + lane * 4);
    const float rs = rowscale ? rowscale[R] : 1.f;
    v = v * rs * cs;
    *(u32x2*)(dst + R * ldd + lane * 4) = u32x2{pack2(v[0], v[1]), pack2(v[2], v[3])};
  }
}

DI void epi_rope64(const Params& p, const float* sC, int q, u16* dst, long ldd, int tok0, int ropemask, const float* rowscale) {
  const int lane = tidx() & 63, wave = tidx() >> 6;
  const int rsel = lane >> 5, g = (lane >> 3) & 3, j = lane & 7;
  const int c1 = g * 64 + 4 * j, c2 = c1 + 32;
  const int r0 = tok0 % TPB;
  const bool rot = (r0 >= CTXL) && ((ropemask >> g) & 1);
  f32x4 cs[8], sn[8];
  if (rot) {
#pragma unroll
    for (int rr = 0; rr < 8; ++rr) {
      const int pos = r0 - CTXL + q * 128 + wave * 16 + 2 * rr + rsel;
      cs[rr] = *(const f32x4*)(p.rope64 + pos * 32 + 4 * j);
      sn[rr] = *(const f32x4*)(p.rope64 + 65536 + pos * 32 + 4 * j);
    }
  }
#pragma unroll
  for (int rr = 0; rr < 8; ++rr) {
    const int lr = wave * 16 + 2 * rr + rsel, R = q * 128 + lr;
    const float rs = rowscale ? rowscale[R] : 1.f;
    f32x4 x1 = *(const f32x4*)(sC + lr * CLD + c1) * rs, x2 = *(const f32x4*)(sC + lr * CLD + c2) * rs;
    if (rot) {
      const f32x4 a = x1 * cs[rr] - x2 * sn[rr], b = x1 * sn[rr] + x2 * cs[rr];
      x1 = a; x2 = b;
    }
    *(u32x2*)(dst + R * ldd + c1) = u32x2{pack2(x1[0], x1[1]), pack2(x1[2], x1[3])};
    *(u32x2*)(dst + R * ldd + c2) = u32x2{pack2(x2[0], x2[1]), pack2(x2[2], x2[3])};
  }
}

DI void epi_qknorm128(const Params& p, const float* sC, int q, u16* dst, long ldd, int tok0, const float* gvec) {
  const int lane = tidx() & 63, wave = tidx() >> 6;
  const int rsel = lane >> 5, hd = (lane >> 4) & 1, j = lane & 15;
  const int c1 = hd * 128 + 4 * j, c2 = c1 + 64;
  const int r0 = tok0 % TPB;
  const bool lat = r0 >= CTXL;
  const f32x4 g1 = *(const f32x4*)(gvec + 4 * j), g2 = *(const f32x4*)(gvec + 64 + 4 * j);
  f32x4 cs[8], sn[8];
  if (lat) {
#pragma unroll
    for (int rr = 0; rr < 8; ++rr) {
      const int pos = r0 - CTXL + q * 128 + wave * 16 + 2 * rr + rsel;
      cs[rr] = *(const f32x4*)(p.rope128 + pos * 64 + 4 * j);
      sn[rr] = *(const f32x4*)(p.rope128 + 131072 + pos * 64 + 4 * j);
    }
  }
#pragma unroll
  for (int rr = 0; rr < 8; ++rr) {
    const int lr = wave * 16 + 2 * rr + rsel, R = q * 128 + lr;
    f32x4 x1 = *(const f32x4*)(sC + lr * CLD + c1), x2 = *(const f32x4*)(sC + lr * CLD + c2);
    float ss = x1[0] * x1[0] + x1[1] * x1[1] + x1[2] * x1[2] + x1[3] * x1[3] + x2[0] * x2[0] + x2[1] * x2[1] + x2[2] * x2[2] + x2[3] * x2[3];
    ss += __shfl_xor(ss, 1); ss += __shfl_xor(ss, 2); ss += __shfl_xor(ss, 4); ss += __shfl_xor(ss, 8);
    const float rstd = rsqrtf(ss * (1.f / 128.f) + EPS);
    x1 = x1 * rstd * g1; x2 = x2 * rstd * g2;
    if (lat) {
      const f32x4 a = x1 * cs[rr] - x2 * sn[rr], b = x1 * sn[rr] + x2 * cs[rr];
      x1 = a; x2 = b;
    }
    *(u32x2*)(dst + R * ldd + c1) = u32x2{pack2(x1[0], x1[1]), pack2(x1[2], x1[3])};
    *(u32x2*)(dst + R * ldd + c2) = u32x2{pack2(x2[0], x2[1]), pack2(x2[2], x2[3])};
  }
}

DI void resid_load(const float* Rsrc, int q, int col0, f32x4 (&rv)[16]) {
  const int lane = tidx() & 63, wave = tidx() >> 6;
  const float* R = Rsrc + col0 + lane * 4 + (size_t)(q * 128 + wave * 16) * DM;
#pragma unroll
  for (int rr = 0; rr < 16; ++rr) rv[rr] = *(const f32x4*)(R + (size_t)rr * DM);
}
DI void epi_resid(const Params& p, const float* Rsrc, const float* sC, int q, int tok0, int col0, f32x4 g, f32x4 (&rv)[16]) {
  const int lane = tidx() & 63, wave = tidx() >> 6;
  float* R = rrow(p, tok0) + col0 + lane * 4 + (size_t)(q * 128 + wave * 16) * DM;
#pragma unroll
  for (int rr = 0; rr < 16; ++rr) {
    const f32x4 c = *(const f32x4*)(sC + (wave * 16 + rr) * CLD + lane * 4);
    *(f32x4*)(R + (size_t)rr * DM) = rv[rr] + g * c;
  }
  if (q < 1) resid_load(Rsrc, q + 1, col0, rv);
}

struct ConvW { float2 wa0, wa1, wa2, ba, wg0, wg1, wg2, bg; };
DI void conv_load(const Params& p, int layer, int nt, ConvW& w) {
  const int lane = tidx() & 63;
  const int j0 = nt * 128;
  const float* cw = p.conv_w + (size_t)layer * 3 * 5632;
  const float* cb = p.conv_b + (size_t)layer * 5632;
  const int ca = j0 + 2 * lane, cg_ = DFF + j0 + 2 * lane;
  w.wa0 = *(const float2*)(cw + ca); w.wa1 = *(const float2*)(cw + 5632 + ca); w.wa2 = *(const float2*)(cw + 2 * 5632 + ca); w.ba = *(const float2*)(cb + ca);
  w.wg0 = *(const float2*)(cw + cg_); w.wg1 = *(const float2*)(cw + 5632 + cg_); w.wg2 = *(const float2*)(cw + 2 * 5632 + cg_); w.bg = *(const float2*)(cb + cg_);
}
DI void epi_convgate(const Params& p, const float* sC, const float* bnd, int q, int tokbase, int pos0, int L, int seam, int nt, const ConvW& w) {
  const int lane = tidx() & 63, wave = tidx() >> 6;
  const int j0 = nt * 128;
  const float2 wa0 = w.wa0, wa1 = w.wa1, wa2 = w.wa2, ba = w.ba, wg0 = w.wg0, wg1 = w.wg1, wg2 = w.wg2, bg = w.bg;
#pragma unroll 1
  for (int hb = 0; hb < 2; ++hb) {
    const int lr0 = wave * 16 + hb * 8;
    float2 va[10], vg[10];
#pragma unroll
    for (int k = 0; k < 10; ++k) {
      const int lrk = lr0 - 1 + k;
      const float* rowp = lrk < 0 ? bnd + (2 * q - 1) * 256 : (lrk > 127 ? bnd + (2 * q + 2) * 256 : sC + lrk * CLD);
      va[k] = *(const float2*)(rowp + 2 * lane); vg[k] = *(const float2*)(rowp + 128 + 2 * lane);
    }
#pragma unroll
    for (int k = 0; k < 8; ++k) {
      const int R = q * 128 + lr0 + k;
      const int pos = pos0 + R;
      if (R == 0 || R == 255 || pos >= L) continue;
      f32x2 pa = {va[k].x, va[k].y}, pg = {vg[k].x, vg[k].y}, na = {va[k + 2].x, va[k + 2].y}, ng = {vg[k + 2].x, vg[k + 2].y};
      const f32x2 ca2 = {va[k + 1].x, va[k + 1].y}, cg2 = {vg[k + 1].x, vg[k + 1].y};
      if (pos == seam) { pa = f32x2{0.f, 0.f}; pg = f32x2{0.f, 0.f}; }
      if (pos + 1 == seam) { na = f32x2{0.f, 0.f}; ng = f32x2{0.f, 0.f}; }
      const f32x2 ya = f32x2{ba.x, ba.y} + f32x2{wa0.x, wa0.y} * pa + f32x2{wa1.x, wa1.y} * ca2 + f32x2{wa2.x, wa2.y} * na;
      const f32x2 yg = f32x2{bg.x, bg.y} + f32x2{wg0.x, wg0.y} * pg + f32x2{wg1.x, wg1.y} * cg2 + f32x2{wg2.x, wg2.y} * ng;
      const float ya0 = ya[0], ya1 = ya[1], yg0 = yg[0], yg1 = yg[1];
      *(unsigned*)(p.G + (size_t)(tokbase + pos) * DFF + j0 + 2 * lane) = pack2(siluf(ya0) * yg0, siluf(ya1) * yg1);
    }
  }
}

DI void tile_rstd(const Params& p, int tok0, int c0, int len, float* rs) {
  const int tid = tidx();
  const int row = tid >> 1, part = tid & 1;
  const u16* tp = p.T1 + (size_t)(tok0 + row) * 768 + c0 + part * (len >> 1);
  float ss = 0;
#pragma unroll 8
  for (int c = 0; c < (len >> 4); ++c) {
    u32x4 v = *(const u32x4*)(tp + c * 8);
#pragma unroll
    for (int j = 0; j < 4; ++j) { float a = bflo(v[j]), b = bfhi(v[j]); ss += a * a + b * b; }
  }
  ss += __shfl_xor(ss, 1);
  if (!part) rs[row] = rsqrtf(ss / (float)len + EPS);
}

DI bool xcd_tile(int round, int Mx, int NT, int GM, int& mt, int& nt) {
  const int xcd = blockIdx.x & 7, slot = blockIdx.x >> 3;
  int per = gridDim.x >> 3;
  const int j = round * per + slot;
  if (slot >= per || j >= Mx * NT) return false;
  int gsz = __builtin_amdgcn_readfirstlane(GM * NT);
  asm volatile("" : "+s"(gsz));
  const int g = j / gsz, w = j - g * gsz;
  int gm = Mx - g * GM; if (gm > GM) gm = GM;
  gm = __builtin_amdgcn_readfirstlane(gm);
  asm volatile("" : "+s"(gm));
  const int q = w / gm;
  mt = xcd * Mx + g * GM + (w - q * gm); nt = q;
  return true;
}

DI bool xcd_tile_j(int j, int ntot, int Mx, int NT, int& mt, int& nt) {
  if (j >= ntot) return false;
  const int xcd = blockIdx.x & 7;
  int mx = __builtin_amdgcn_readfirstlane(Mx);
  asm volatile("" : "+s"(mx));
  const int q = j / mx;
  mt = xcd * Mx + (j - q * mx); nt = q;
  (void)NT;
  return true;
}

DI void qkv_phase(const Params& p, int kind, char* smem) {
  const u16* W = kind == 0 ? p.Wa_qkv : kind == 1 ? p.Wb_qkv : p.Wd_qkv;
  const int nqk = kind == 0 ? 2048 : kind == 1 ? 1280 : 1536;
  const int dvt = kind == 0 ? 1024 : kind == 1 ? 256 : 512;
  const int ntq = nqk >> 8, ntv = dvt >> 8;
  const int slot = blockIdx.x >> 3, per = gridDim.x >> 3;
  if (slot >= per) return;
  const int n1 = 9 * ntq, ntot = n1 + 9 * ntv;
  auto desc = [&](int j, const u16*& Ap, const u16*& Bp, int& tok0, int& c0, bool& isv) {
    int mt, nt;
    isv = j >= n1;
    xcd_tile_j(isv ? j - n1 : j, 1 << 30, 9, 0, mt, nt);
    tok0 = mt * 256; c0 = nt * 256;
    const u16* Hp = p.H + (size_t)tok0 * DM;
    const u16* Wp = W + (size_t)((isv ? nqk : 0) + c0) * DM;
    Ap = isv ? Wp : Hp; Bp = isv ? Hp : Wp;
  };
#pragma unroll 1
  for (int j = slot; j < ntot; j += per) {
    const u16 *Ap, *Bp; int tok0, c0; bool isv;
    desc(j, Ap, Bp, tok0, c0, isv);
    NextTile nx; nx.Ap = nullptr; nx.Bp = nullptr; nx.vlo = 0; nx.vhi = 256;
    if (j + per < ntot) { int t2, c2; bool v2; desc(j + per, nx.Ap, nx.Bp, t2, c2, v2); }
    gemm_tile<false>(Ap, DM, 0, 256, Bp, DM, DM, smem, nx, [&](const float* sC, int q) {
      if (isv) epi_store(sC, q, p.Vt + (size_t)c0 * T + tok0, T, nullptr, f32x4{1.f, 1.f, 1.f, 1.f});
      else if (kind == 3) epi_qknorm128(p, sC, q, p.QK + (size_t)tok0 * nqk + c0, nqk, tok0, c0 < 1024 ? p.d_qg : p.d_kg);
      else epi_rope64(p, sC, q, p.QK + (size_t)tok0 * nqk + c0, nqk, tok0, 15, nullptr);
    });
  }
}

DI void mla_down_phase(const Params& p, char* smem) {
  int mt, nt;
#pragma unroll 1
  for (int r = 0; xcd_tile(r, 9, 3, 9, mt, nt); ++r) {
    int tok0 = mt * 256, col0 = nt * 256;
    NextTile nx; nx.Ap = nullptr; nx.Bp = nullptr; nx.vlo = 0; nx.vhi = 0;
    gemm_tile<false>(p.H + (size_t)tok0 * DM, DM, 0, 256, p.Wc_d + (size_t)col0 * DM, DM, DM, smem, nx, [&](const float* sC, int q) {
      epi_store(sC, q, p.T1 + (size_t)tok0 * 768 + col0, 768, nullptr, f32x4{1.f, 1.f, 1.f, 1.f});
    });
  }
}

DI void mla_up_phase(const Params& p, char* smem) {
  float* rs = (float*)(smem + RS_OFF);
  u16* Qb = p.QK; u16* Kb = p.QK + (size_t)T * 1536;
  const int slot = blockIdx.x >> 3, per = gridDim.x >> 3;
#pragma unroll 1
  for (int j = slot; j < 126 && slot < per; j += per) {
    int mt, nt;
    const int ty = j < 54 ? 0 : j < 90 ? 1 : 2;
    xcd_tile_j(j - (ty == 0 ? 0 : ty == 1 ? 54 : 90), 1 << 30, 9, 0, mt, nt);
    const int tok0 = mt * 256, c0 = nt * 256;
    const int K = ty == 0 ? 384 : 256;
    const u16* Tp = p.T1 + (size_t)tok0 * 768 + (ty == 0 ? 0 : 384);
    const u16* Wp = (ty == 0 ? p.Wc_uq : ty == 1 ? p.Wc_uk : p.Wc_uv) + (size_t)c0 * K;
    NextTile nx; nx.Ap = nullptr; nx.Bp = nullptr; nx.vlo = 0; nx.vhi = 0;
    gemm_tile<false>(ty == 2 ? Wp : Tp, ty == 2 ? K : 768, 0, 256, ty == 2 ? Tp : Wp, ty == 2 ? 768 : K, K, smem, nx, [&](const float* sC, int q) {
      if (q == 0) { tile_rstd(p, tok0, ty == 0 ? 0 : 384, K, rs); __syncthreads(); }
      if (ty == 0) {
        int mask = 0;
#pragma unroll
        for (int g = 0; g < 4; ++g) if (((c0 + 64 * g) % 192) == 128) mask |= 1 << g;
        epi_rope64(p, sC, q, Qb + (size_t)tok0 * 1536 + c0, 1536, tok0, mask, rs);
      } else if (ty == 1) {
        epi_store(sC, q, Kb + (size_t)tok0 * 1024 + c0, 1024, rs, f32x4{1.f, 1.f, 1.f, 1.f});
      } else {
        const int lane = tidx() & 63;
        epi_store(sC, q, p.Vt + (size_t)c0 * T + tok0, T, nullptr, *(const f32x4*)(rs + lane * 4));
      }
    });
  }
#pragma unroll 1
  for (int mt2 = blockIdx.x; mt2 < 72; mt2 += gridDim.x) {
    int tok0 = mt2 * 256;
    const bool lat = (tok0 % TPB) >= CTXL;
    for (int e = tidx(); e < 8192; e += NTHR) {
      int row = e >> 5, i = e & 31;
      const u16* tp = p.T1 + (size_t)(tok0 + row) * 768 + 640;
      float x1 = bf2f(tp[i]), x2 = bf2f(tp[i + 32]);
      if (lat) {
        int pos = (tok0 % TPB) - CTXL + row;
        float cs = p.rope64[pos * 32 + i], sn = p.rope64[65536 + pos * 32 + i];
        float y1 = x1 * cs - x2 * sn, y2 = x1 * sn + x2 * cs;
        x1 = y1; x2 = y2;
      }
      p.KR[(size_t)(tok0 + row) * 64 + i] = f2bf(x1);
      p.KR[(size_t)(tok0 + row) * 64 + i + 32] = f2bf(x2);
    }
  }
}

DI int tile_token(int mt, bool lat_only) {
  if (!lat_only) return mt * 256;
  int b = mt >> 3; return b * TPB + CTXL + (mt & 7) * 256;
}

DI void resid_gemm_phase(const Params& p, int layer, const u16* A, int lda, int K, const u16* W, int chunk, bool lat_only, char* smem, float gs) {
  const int Mx = lat_only ? 8 : 9;
  int mt, nt; bool has = xcd_tile(0, Mx, 4, 3, mt, nt);
#pragma unroll 1
  for (int r = 0; has; ++r) {
    int mt2, nt2; const bool has2 = xcd_tile(r + 1, Mx, 4, 3, mt2, nt2);
    const int tok0 = tile_token(mt, lat_only), col0 = nt * 256;
    NextTile nx; nx.Ap = has2 ? A + (size_t)tile_token(mt2, lat_only) * lda : nullptr; nx.Bp = W + (size_t)nt2 * 256 * K; nx.vlo = 0; nx.vhi = 256;
    const float* gate = p.MOD + ((size_t)layer * 9 + modrow(tok0)) * 6144 + chunk * 1024;
    f32x4 rv[16]; f32x4 gv;
    const float* Rsrc = (layer == 0 && chunk == 2) ? xrow(p, tok0) : (const float*)rrow(p, tok0);
    gemm_tile<false>(A + (size_t)tok0 * lda, lda, 0, 256, W + (size_t)col0 * K, K, K, smem, nx, [&](const float* sC, int q) {
      epi_resid(p, Rsrc, sC, q, tok0, col0, gv, rv);
    }, [&]() { gv = *(const f32x4*)(gate + col0 + (tidx() & 63) * 4) * gs; resid_load(Rsrc, 0, col0, rv); });
    mt = mt2; nt = nt2; has = has2;
    if (!has2 && r == 0 && chunk == 2 && layer < 3) {
      const int per = gridDim.x >> 3, slot = blockIdx.x >> 3, xcd = blockIdx.x & 7;
      const int nbusy = Mx * 4 - per;
      const int me = (slot - nbusy) * 8 + xcd;
      const int nidle = (per - nbusy) * 8;
      if (nbusy >= 0 && nbusy < per && me >= 0) {
#pragma unroll 1
        for (int i = me; i < 48; i += nidle) mod_item2(p, (layer + 1) * 96 + 2 * i + (tidx() >> 8), true, smem);
      }
    }
    if (!has2 && r == 0 && chunk == 5 && layer < 3) {
      const int per = gridDim.x >> 3, slot = blockIdx.x >> 3, xcd = blockIdx.x & 7;
      const int nbusy = Mx * 4 - per;
      const int nidle = (per - nbusy) * 8;
      const int me = (slot - nbusy) * 8 + xcd;
      const int t0 = p.ltile[layer + 1], t1 = p.ltile[layer + 2];
      if (nbusy >= 0 && nbusy < per && me >= 0) {
#pragma unroll 1
        for (int i = me; t0 + 4 * i < t1; i += nidle) convert_tiles(p, t0 + 4 * i, t1, smem);
      }
    }
  }
}

DI void ffn_up_phase(const Params& p, int layer, bool lat_only, char* smem) {
  const int tpb = lat_only ? 9 : 10;
  const int L = lat_only ? SEQ : TPB;
  const int seam = lat_only ? -1 : CTXL;
  const float* bnd = (const float*)(smem + BND_OFF);
  int mt, nt; bool has = xcd_tile(0, tpb, 22, 5, mt, nt);
#pragma unroll 1
  for (int r = 0; has; ++r) {
    int mt2, nt2; const bool has2 = xcd_tile(r + 1, tpb, 22, 5, mt2, nt2);
    const int b = mt / tpb, ti = mt - b * tpb;
    const int tokbase = b * TPB + (lat_only ? CTXL : 0);
    const int pos0 = ti * 254 - 1;
    const int vlo = (ti == 0) ? 1 : 0;
    int vhi = L - pos0; if (vhi > 256) vhi = 256;
    NextTile nx; nx.Ap = nullptr; nx.Bp = nullptr; nx.vlo = 0; nx.vhi = 0;
    if (has2) {
      const int b2 = mt2 / tpb, ti2 = mt2 - b2 * tpb;
      const int pos02 = ti2 * 254 - 1;
      nx.Ap = p.H + ((long)(b2 * TPB + (lat_only ? CTXL : 0)) + pos02) * DM; nx.Bp = p.Wup[layer] + (size_t)nt2 * 256 * DM;
      nx.vlo = (ti2 == 0) ? 1 : 0; nx.vhi = L - pos02; if (nx.vhi > 256) nx.vhi = 256;
    }
    ConvW cwv;
    gemm_tile<true>(p.H + ((long)tokbase + pos0) * DM, DM, vlo, vhi, p.Wup[layer] + (size_t)nt * 256 * DM, DM, DM, smem, nx, [&](const float* sC, int q) {
      epi_convgate(p, sC, bnd, q, tokbase, pos0, L, seam, nt, cwv);
    }, [&]() { conv_load(p, layer, nt, cwv); });
    mt = mt2; nt = nt2; has = has2;
  }
}

template <int RB> DI int kswz(int row, int ch) {
  if (RB == 256) return row * RB + ((ch ^ (row & 15)) << 4);
  return row * RB + ((((ch & 7) ^ ((row >> 1) & 7)) | (ch & ~7)) << 4);
}
DI bf16x8 pack8(float a0, float a1, float a2, float a3, float a4, float a5, float a6, float a7) {
  u32x4 w = {pack2(a0, a1), pack2(a2, a3), pack2(a4, a5), pack2(a6, a7)};
  return __builtin_bit_cast(bf16x8, w);
}

DI void qk_asm_a(f32x16 (&s)[2], const bf16x8 (&q)[4], const unsigned (&a)[4]) {
  u32x4 t0, t1, t2, t3, t4, t5;
  asm volatile(
      "ds_read_b128 %2, %12 offset:0\n\t"
      "ds_read_b128 %3, %12 offset:8192\n\t"
      "ds_read_b128 %4, %13 offset:0\n\t"
      "ds_read_b128 %5, %13 offset:8192\n\t"
      "ds_read_b128 %6, %14 offset:0\n\t"
      "ds_read_b128 %7, %14 offset:8192\n\t"
      "s_waitcnt lgkmcnt(5)\n\t"
      "v_mfma_f32_32x32x16_bf16 %0, %2, %8, %0\n\t"
      "ds_read_b128 %2, %15 offset:0\n\t"
      "s_waitcnt lgkmcnt(5)\n\t"
      "v_mfma_f32_32x32x16_bf16 %1, %3, %8, %1\n\t"
      "ds_read_b128 %3, %15 offset:8192\n\t"
      "s_waitcnt lgkmcnt(5)\n\t"
      "v_mfma_f32_32x32x16_bf16 %0, %4, %9, %0\n\t"
      "s_waitcnt lgkmcnt(4)\n\t"
      "v_mfma_f32_32x32x16_bf16 %1, %5, %9, %1\n\t"
      "s_waitcnt lgkmcnt(3)\n\t"
      "v_mfma_f32_32x32x16_bf16 %0, %6, %10, %0\n\t"
      "s_waitcnt lgkmcnt(2)\n\t"
      "v_mfma_f32_32x32x16_bf16 %1, %7, %10, %1\n\t"
      "s_waitcnt lgkmcnt(1)\n\t"
      "v_mfma_f32_32x32x16_bf16 %0, %2, %11, %0\n\t"
      "s_waitcnt lgkmcnt(0)\n\t"
      "v_mfma_f32_32x32x16_bf16 %1, %3, %11, %1\n\t"
      "s_nop 15\n\t"
      "s_nop 3\n\t"
      : "+v"(s[0]), "+v"(s[1]), "=&v"(t0), "=&v"(t1), "=&v"(t2), "=&v"(t3), "=&v"(t4), "=&v"(t5)
      : "v"(q[0]), "v"(q[1]), "v"(q[2]), "v"(q[3]), "v"(a[0]), "v"(a[1]), "v"(a[2]), "v"(a[3])
      : "memory");
}
DI void qk_asm_b(f32x16 (&s)[2], const bf16x8 (&q)[4], const unsigned (&a)[4]) {
  u32x4 t0, t1, t2, t3, t4, t5;
  asm volatile(
      "ds_read_b128 %2, %12 offset:0\n\t"
      "ds_read_b128 %3, %12 offset:4096\n\t"
      "ds_read_b128 %4, %13 offset:0\n\t"
      "ds_read_b128 %5, %13 offset:4096\n\t"
      "ds_read_b128 %6, %14 offset:0\n\t"
      "ds_read_b128 %7, %14 offset:4096\n\t"
      "s_waitcnt lgkmcnt(5)\n\t"
      "v_mfma_f32_32x32x16_bf16 %0, %2, %8, %0\n\t"
      "ds_read_b128 %2, %15 offset:0\n\t"
      "s_waitcnt lgkmcnt(5)\n\t"
      "v_mfma_f32_32x32x16_bf16 %1, %3, %8, %1\n\t"
      "ds_read_b128 %3, %15 offset:4096\n\t"
      "s_waitcnt lgkmcnt(5)\n\t"
      "v_mfma_f32_32x32x16_bf16 %0, %4, %9, %0\n\t"
      "s_waitcnt lgkmcnt(4)\n\t"
      "v_mfma_f32_32x32x16_bf16 %1, %5, %9, %1\n\t"
      "s_waitcnt lgkmcnt(3)\n\t"
      "v_mfma_f32_32x32x16_bf16 %0, %6, %10, %0\n\t"
      "s_waitcnt lgkmcnt(2)\n\t"
      "v_mfma_f32_32x32x16_bf16 %1, %7, %10, %1\n\t"
      "s_waitcnt lgkmcnt(1)\n\t"
      "v_mfma_f32_32x32x16_bf16 %0, %2, %11, %0\n\t"
      "s_waitcnt lgkmcnt(0)\n\t"
      "v_mfma_f32_32x32x16_bf16 %1, %3, %11, %1\n\t"
      "s_nop 15\n\t"
      "s_nop 3\n\t"
      : "+v"(s[0]), "+v"(s[1]), "=&v"(t0), "=&v"(t1), "=&v"(t2), "=&v"(t3), "=&v"(t4), "=&v"(t5)
      : "v"(q[0]), "v"(q[1]), "v"(q[2]), "v"(q[3]), "v"(a[0]), "v"(a[1]), "v"(a[2]), "v"(a[3])
      : "memory");
}
DI void qk_asm_c(f32x16 (&s)[1], const bf16x8 (&q)[12], const unsigned (&a)[4]) {
  u32x4 t0, t1, t2, t3, t4, t5;
  asm volatile(
      "ds_read_b128 %1, %19 offset:0\n\t"
      "ds_read_b128 %2, %20 offset:0\n\t"
      "ds_read_b128 %3, %21 offset:0\n\t"
      "ds_read_b128 %4, %22 offset:0\n\t"
      "ds_read_b128 %5, %19 offset:128\n\t"
      "ds_read_b128 %6, %20 offset:128\n\t"
      "s_waitcnt lgkmcnt(5)\n\t"
      "v_mfma_f32_32x32x16_bf16 %0, %1, %7, %0\n\t"
      "ds_read_b128 %1, %21 offset:128\n\t"
      "s_waitcnt lgkmcnt(5)\n\t"
      "v_mfma_f32_32x32x16_bf16 %0, %2, %8, %0\n\t"
      "ds_read_b128 %2, %22 offset:128\n\t"
      "s_waitcnt lgkmcnt(5)\n\t"
      "v_mfma_f32_32x32x16_bf16 %0, %3, %9, %0\n\t"
      "ds_read_b128 %3, %19 offset:256\n\t"
      "s_waitcnt lgkmcnt(5)\n\t"
      "v_mfma_f32_32x32x16_bf16 %0, %4, %10, %0\n\t"
      "ds_read_b128 %4, %20 offset:256\n\t"
      "s_waitcnt lgkmcnt(5)\n\t"
      "v_mfma_f32_32x32x16_bf16 %0, %5, %11, %0\n\t"
      "ds_read_b128 %5, %21 offset:256\n\t"
      "s_waitcnt lgkmcnt(5)\n\t"
      "v_mfma_f32_32x32x16_bf16 %0, %6, %12, %0\n\t"
      "ds_read_b128 %6, %22 offset:256\n\t"
      "s_waitcnt lgkmcnt(5)\n\t"
      "v_mfma_f32_32x32x16_bf16 %0, %1, %13, %0\n\t"
      "s_waitcnt lgkmcnt(4)\n\t"
      "v_mfma_f32_32x32x16_bf16 %0, %2, %14, %0\n\t"
      "s_waitcnt lgkmcnt(3)\n\t"
      "v_mfma_f32_32x32x16_bf16 %0, %3, %15, %0\n\t"
      "s_waitcnt lgkmcnt(2)\n\t"
      "v_mfma_f32_32x32x16_bf16 %0, %4, %16, %0\n\t"
      "s_waitcnt lgkmcnt(1)\n\t"
      "v_mfma_f32_32x32x16_bf16 %0, %5, %17, %0\n\t"
      "s_waitcnt lgkmcnt(0)\n\t"
      "v_mfma_f32_32x32x16_bf16 %0, %6, %18, %0\n\t"
      "s_nop 15\n\t"
      "s_nop 3\n\t"
      : "+v"(s[0]), "=&v"(t0), "=&v"(t1), "=&v"(t2), "=&v"(t3), "=&v"(t4), "=&v"(t5)
      : "v"(q[0]), "v"(q[1]), "v"(q[2]), "v"(q[3]), "v"(q[4]), "v"(q[5]), "v"(q[6]), "v"(q[7]), "v"(q[8]), "v"(q[9]), "v"(q[10]), "v"(q[11]), "v"(a[0]), "v"(a[1]), "v"(a[2]), "v"(a[3])
      : "memory");
}
DI void qk_asm_d(f32x16 (&s)[2], const bf16x8 (&q)[8], const unsigned (&a)[8]) {
  u32x4 t0, t1, t2, t3, t4, t5;
  asm volatile(
      "ds_read_b128 %2, %16 offset:0\n\t"
      "ds_read_b128 %3, %16 offset:8192\n\t"
      "ds_read_b128 %4, %17 offset:0\n\t"
      "ds_read_b128 %5, %17 offset:8192\n\t"
      "ds_read_b128 %6, %18 offset:0\n\t"
      "ds_read_b128 %7, %18 offset:8192\n\t"
      "s_waitcnt lgkmcnt(5)\n\t"
      "v_mfma_f32_32x32x16_bf16 %0, %2, %8, %0\n\t"
      "ds_read_b128 %2, %19 offset:0\n\t"
      "s_waitcnt lgkmcnt(5)\n\t"
      "v_mfma_f32_32x32x16_bf16 %1, %3, %8, %1\n\t"
      "ds_read_b128 %3, %19 offset:8192\n\t"
      "s_waitcnt lgkmcnt(5)\n\t"
      "v_mfma_f32_32x32x16_bf16 %0, %4, %9, %0\n\t"
      "ds_read_b128 %4, %20 offset:0\n\t"
      "s_waitcnt lgkmcnt(5)\n\t"
      "v_mfma_f32_32x32x16_bf16 %1, %5, %9, %1\n\t"
      "ds_read_b128 %5, %20 offset:8192\n\t"
      "s_waitcnt lgkmcnt(5)\n\t"
      "v_mfma_f32_32x32x16_bf16 %0, %6, %10, %0\n\t"
      "ds_read_b128 %6, %21 offset:0\n\t"
      "s_waitcnt lgkmcnt(5)\n\t"
      "v_mfma_f32_32x32x16_bf16 %1, %7, %10, %1\n\t"
      "ds_read_b128 %7, %21 offset:8192\n\t"
      "s_waitcnt lgkmcnt(5)\n\t"
      "v_mfma_f32_32x32x16_bf16 %0, %2, %11, %0\n\t"
      "ds_read_b128 %2, %22 offset:0\n\t"
      "s_waitcnt lgkmcnt(5)\n\t"
      "v_mfma_f32_32x32x16_bf16 %1, %3, %11, %1\n\t"
      "ds_read_b128 %3, %22 offset:8192\n\t"
      "s_waitcnt lgkmcnt(5)\n\t"
      "v_mfma_f32_32x32x16_bf16 %0, %4, %12, %0\n\t"
      "ds_read_b128 %4, %23 offset:0\n\t"
      "s_waitcnt lgkmcnt(5)\n\t"
      "v_mfma_f32_32x32x16_bf16 %1, %5, %12, %1\n\t"
      "ds_read_b128 %5, %23 offset:8192\n\t"
      "s_waitcnt lgkmcnt(5)\n\t"
      "v_mfma_f32_32x32x16_bf16 %0, %6, %13, %0\n\t"
      "s_waitcnt lgkmcnt(4)\n\t"
      "v_mfma_f32_32x32x16_bf16 %1, %7, %13, %1\n\t"
      "s_waitcnt lgkmcnt(3)\n\t"
      "v_mfma_f32_32x32x16_bf16 %0, %2, %14, %0\n\t"
      "s_waitcnt lgkmcnt(2)\n\t"
      "v_mfma_f32_32x32x16_bf16 %1, %3, %14, %1\n\t"
      "s_waitcnt lgkmcnt(1)\n\t"
      "v_mfma_f32_32x32x16_bf16 %0, %4, %15, %0\n\t"
      "s_waitcnt lgkmcnt(0)\n\t"
      "v_mfma_f32_32x32x16_bf16 %1, %5, %15, %1\n\t"
      "s_nop 15\n\t"
      "s_nop 3\n\t"
      : "+v"(s[0]), "+v"(s[1]), "=&v"(t0), "=&v"(t1), "=&v"(t2), "=&v"(t3), "=&v"(t4), "=&v"(t5)
      : "v"(q[0]), "v"(q[1]), "v"(q[2]), "v"(q[3]), "v"(q[4]), "v"(q[5]), "v"(q[6]), "v"(q[7]), "v"(a[0]), "v"(a[1]), "v"(a[2]), "v"(a[3]), "v"(a[4]), "v"(a[5]), "v"(a[6]), "v"(a[7])
      : "memory");
}
DI void pv_asm_42(f32x16 (&o)[4], const bf16x8 (&pb)[2][2], const unsigned (&a)[4]) {
  u32x4 t0, t1, t2, t3, t4, t5;
  asm volatile(
      "ds_read_b128 %4, %14 offset:0\n\t"
      "ds_read_b128 %5, %14 offset:4096\n\t"
      "ds_read_b128 %6, %14 offset:8192\n\t"
      "ds_read_b128 %7, %14 offset:12288\n\t"
      "ds_read_b128 %8, %15 offset:0\n\t"
      "ds_read_b128 %9, %15 offset:4096\n\t"
      "s_waitcnt lgkmcnt(5)\n\t"
      "v_mfma_f32_32x32x16_bf16 %0, %4, %10, %0\n\t"
      "ds_read_b128 %4, %15 offset:8192\n\t"
      "s_waitcnt lgkmcnt(5)\n\t"
      "v_mfma_f32_32x32x16_bf16 %1, %5, %10, %1\n\t"
      "ds_read_b128 %5, %15 offset:12288\n\t"
      "s_waitcnt lgkmcnt(5)\n\t"
      "v_mfma_f32_32x32x16_bf16 %2, %6, %10, %2\n\t"
      "ds_read_b128 %6, %16 offset:0\n\t"
      "s_waitcnt lgkmcnt(5)\n\t"
      "v_mfma_f32_32x32x16_bf16 %3, %7, %10, %3\n\t"
      "ds_read_b128 %7, %16 offset:4096\n\t"
      "s_waitcnt lgkmcnt(5)\n\t"
      "v_mfma_f32_32x32x16_bf16 %0, %8, %11, %0\n\t"
      "ds_read_b128 %8, %16 offset:8192\n\t"
      "s_waitcnt lgkmcnt(5)\n\t"
      "v_mfma_f32_32x32x16_bf16 %1, %9, %11, %1\n\t"
      "ds_read_b128 %9, %16 offset:12288\n\t"
      "s_waitcnt lgkmcnt(5)\n\t"
      "v_mfma_f32_32x32x16_bf16 %2, %4, %11, %2\n\t"
      "ds_read_b128 %4, %17 offset:0\n\t"
      "s_waitcnt lgkmcnt(5)\n\t"
      "v_mfma_f32_32x32x16_bf16 %3, %5, %11, %3\n\t"
      "ds_read_b128 %5, %17 offset:4096\n\t"
      "s_waitcnt lgkmcnt(5)\n\t"
      "v_mfma_f32_32x32x16_bf16 %0, %6, %12, %0\n\t"
      "ds_read_b128 %6, %17 offset:8192\n\t"
      "s_waitcnt lgkmcnt(5)\n\t"
      "v_mfma_f32_32x32x16_bf16 %1, %7, %12, %1\n\t"
      "ds_read_b128 %7, %17 offset:12288\n\t"
      "s_waitcnt lgkmcnt(5)\n\t"
      "v_mfma_f32_32x32x16_bf16 %2, %8, %12, %2\n\t"
      "s_waitcnt lgkmcnt(4)\n\t"
      "v_mfma_f32_32x32x16_bf16 %3, %9, %12, %3\n\t"
      "s_waitcnt lgkmcnt(3)\n\t"
      "v_mfma_f32_32x32x16_bf16 %0, %4, %13, %0\n\t"
      "s_waitcnt lgkmcnt(2)\n\t"
      "v_mfma_f32_32x32x16_bf16 %1, %5, %13, %1\n\t"
      "s_waitcnt lgkmcnt(1)\n\t"
      "v_mfma_f32_32x32x16_bf16 %2, %6, %13, %2\n\t"
      "s_waitcnt lgkmcnt(0)\n\t"
      "v_mfma_f32_32x32x16_bf16 %3, %7, %13, %3\n\t"
      "s_nop 15\n\t"
      "s_nop 3\n\t"
      : "+v"(o[0]), "+v"(o[1]), "+v"(o[2]), "+v"(o[3]), "=&v"(t0), "=&v"(t1), "=&v"(t2), "=&v"(t3), "=&v"(t4), "=&v"(t5)
      : "v"(pb[0][0]), "v"(pb[0][1]), "v"(pb[1][0]), "v"(pb[1][1]), "v"(a[0]), "v"(a[1]), "v"(a[2]), "v"(a[3])
      : "memory");
}
DI void pv_asm_22(f32x16 (&o)[2], const bf16x8 (&pb)[2][2], const unsigned (&a)[4]) {
  u32x4 t0, t1, t2, t3, t4, t5;
  asm volatile(
      "ds_read_b128 %2, %12 offset:0\n\t"
      "ds_read_b128 %3, %12 offset:4096\n\t"
      "ds_read_b128 %4, %13 offset:0\n\t"
      "ds_read_b128 %5, %13 offset:4096\n\t"
      "ds_read_b128 %6, %14 offset:0\n\t"
      "ds_read_b128 %7, %14 offset:4096\n\t"
      "s_waitcnt lgkmcnt(5)\n\t"
      "v_mfma_f32_32x32x16_bf16 %0, %2, %8, %0\n\t"
      "ds_read_b128 %2, %15 offset:0\n\t"
      "s_waitcnt lgkmcnt(5)\n\t"
      "v_mfma_f32_32x32x16_bf16 %1, %3, %8, %1\n\t"
      "ds_read_b128 %3, %15 offset:4096\n\t"
      "s_waitcnt lgkmcnt(5)\n\t"
      "v_mfma_f32_32x32x16_bf16 %0, %4, %9, %0\n\t"
      "s_waitcnt lgkmcnt(4)\n\t"
      "v_mfma_f32_32x32x16_bf16 %1, %5, %9, %1\n\t"
      "s_waitcnt lgkmcnt(3)\n\t"
      "v_mfma_f32_32x32x16_bf16 %0, %6, %10, %0\n\t"
      "s_waitcnt lgkmcnt(2)\n\t"
      "v_mfma_f32_32x32x16_bf16 %1, %7, %10, %1\n\t"
      "s_waitcnt lgkmcnt(1)\n\t"
      "v_mfma_f32_32x32x16_bf16 %0, %2, %11, %0\n\t"
      "s_waitcnt lgkmcnt(0)\n\t"
      "v_mfma_f32_32x32x16_bf16 %1, %3, %11, %1\n\t"
      "s_nop 15\n\t"
      "s_nop 3\n\t"
      : "+v"(o[0]), "+v"(o[1]), "=&v"(t0), "=&v"(t1), "=&v"(t2), "=&v"(t3), "=&v"(t4), "=&v"(t5)
      : "v"(pb[0][0]), "v"(pb[0][1]), "v"(pb[1][0]), "v"(pb[1][1]), "v"(a[0]), "v"(a[1]), "v"(a[2]), "v"(a[3])
      : "memory");
}
DI void pv_asm_41(f32x16 (&o)[4], const bf16x8 (&pb)[1][2], const unsigned (&a)[2]) {
  u32x4 t0, t1, t2, t3, t4, t5;
  asm volatile(
      "ds_read_b128 %4, %12 offset:0\n\t"
      "ds_read_b128 %5, %12 offset:4096\n\t"
      "ds_read_b128 %6, %12 offset:8192\n\t"
      "ds_read_b128 %7, %12 offset:12288\n\t"
      "ds_read_b128 %8, %13 offset:0\n\t"
      "ds_read_b128 %9, %13 offset:4096\n\t"
      "s_waitcnt lgkmcnt(5)\n\t"
      "v_mfma_f32_32x32x16_bf16 %0, %4, %10, %0\n\t"
      "ds_read_b128 %4, %13 offset:8192\n\t"
      "s_waitcnt lgkmcnt(5)\n\t"
      "v_mfma_f32_32x32x16_bf16 %1, %5, %10, %1\n\t"
      "ds_read_b128 %5, %13 offset:12288\n\t"
      "s_waitcnt lgkmcnt(5)\n\t"
      "v_mfma_f32_32x32x16_bf16 %2, %6, %10, %2\n\t"
      "s_waitcnt lgkmcnt(4)\n\t"
      "v_mfma_f32_32x32x16_bf16 %3, %7, %10, %3\n\t"
      "s_waitcnt lgkmcnt(3)\n\t"
      "v_mfma_f32_32x32x16_bf16 %0, %8, %11, %0\n\t"
      "s_waitcnt lgkmcnt(2)\n\t"
      "v_mfma_f32_32x32x16_bf16 %1, %9, %11, %1\n\t"
      "s_waitcnt lgkmcnt(1)\n\t"
      "v_mfma_f32_32x32x16_bf16 %2, %4, %11, %2\n\t"
      "s_waitcnt lgkmcnt(0)\n\t"
      "v_mfma_f32_32x32x16_bf16 %3, %5, %11, %3\n\t"
      "s_nop 15\n\t"
      "s_nop 3\n\t"
      : "+v"(o[0]), "+v"(o[1]), "+v"(o[2]), "+v"(o[3]), "=&v"(t0), "=&v"(t1), "=&v"(t2), "=&v"(t3), "=&v"(t4), "=&v"(t5)
      : "v"(pb[0][0]), "v"(pb[0][1]), "v"(a[0]), "v"(a[1])
      : "memory");
}

template <int KIND>
DI void attn_item(const Params& p, int b, int hh, int qt, char* smem, float lam, int nb, int nhh) {
  constexpr int DQK = KIND == 2 ? 192 : KIND == 3 ? 128 : 64;
  constexpr int DV = KIND == 1 ? 64 : 128;
  constexpr int KRB = KIND == 0 ? 256 : KIND == 1 ? 128 : KIND == 2 ? 384 : 256;
  constexpr int NQ = KIND == 0 ? 128 : 256;
  constexpr int NMB = KIND == 2 ? 1 : 2;
  constexpr int KCH = KRB / 16, NKC = 64 * KCH / 512, NVC = DV * 8 / 512, NC = DV / 32;
  constexpr int LDQ = KIND == 0 ? 2048 : KIND == 1 ? 1280 : 1536;
  constexpr int LDK = KIND == 0 ? 2048 : KIND == 1 ? 1280 : KIND == 2 ? 1024 : 1536;
  const int tid = tidx(), lane = tid & 63, wave = tid >> 6, h = lane >> 5, ql = lane & 31;
  const int grp = KIND == 0 ? (wave >> 2) : 0;
  const int wq = KIND == 0 ? (wave & 3) : wave;
  const int tokb = b * TPB;
  const int q0 = qt * NQ;
  const bool isctx = q0 < CTXL;
  int lo = 0, hi = 0;
  if (!isctx) {
    if (KIND == 1) {
      int s = q0 - CTXL;
      int a = s - 128; if (a < 0) a = 0;
      int e = s + 383; if (e > SEQ - 1) e = SEQ - 1;
      lo = (CTXL + a) >> 6; hi = ((CTXL + e) >> 6) + 1;
    } else { lo = 4; hi = 36; }
  }
  const int ntiles = 4 + (hi - lo);
  const float sl2 = (KIND == 2 ? 0.07216878364870322f : KIND == 3 ? 0.08838834764831845f : 0.125f) * 1.4426950408889634f;

  const u16* Ksrc; const u16* Vth; int qoff, aoff;
  if (KIND == 0) { qoff = (2 * hh + grp) * 64; Ksrc = p.QK + 1024 + hh * 128; Vth = p.Vt + (size_t)(hh * 128) * T; aoff = hh * 128; }
  else if (KIND == 1) { qoff = hh * 64; Ksrc = p.QK + 1024 + (hh >> 2) * 64; Vth = p.Vt + (size_t)((hh >> 2) * 64) * T; aoff = hh * 64; }
  else if (KIND == 2) { qoff = hh * 192; Ksrc = p.QK + (size_t)T * 1536 + hh * 128; Vth = p.Vt + (size_t)(hh * 128) * T; aoff = hh * 128; }
  else { qoff = hh * 128; Ksrc = p.QK + 1024 + (hh >> 1) * 128; Vth = p.Vt + (size_t)((hh >> 1) * 128) * T; aoff = hh * 128; }
  const int qtok = tokb + q0 + wq * 32 + ql;

  bf16x8 qf[DQK / 16];
  {
    const u16* qrow = p.QK + (size_t)qtok * LDQ + qoff;
#pragma unroll
    for (int ks = 0; ks < DQK / 16; ++ks) qf[ks] = *(const bf16x8*)(qrow + 16 * ks + 8 * h);
  }
  u32x4 rk[NKC], rv[NVC];
  auto gload = [&](int kt) {
    const int key0 = tokb + kt * 64;
#pragma unroll
    for (int i = 0; i < NKC; ++i) {
      int id = tid + 512 * i; int row = id / KCH, ch = id - row * KCH;
      const u16* src = (KIND == 2 && ch >= 16) ? p.KR + (size_t)(key0 + row) * 64 + (ch - 16) * 8
                                               : Ksrc + (size_t)(key0 + row) * LDK + ch * 8;
      rk[i] = *(const u32x4*)src;
    }
#pragma unroll
    for (int i = 0; i < NVC; ++i) {
      int id = tid + 512 * i; int row = id >> 3, ch = id & 7;
      rv[i] = *(const u32x4*)(Vth + (size_t)row * T + key0 + ch * 8);
    }
  };
  auto sstore = [&](int buf) {
    char* sK = smem + buf * 40960; char* sV = sK + 24576;
#pragma unroll
    for (int i = 0; i < NKC; ++i) {
      int id = tid + 512 * i; int row = id / KCH, ch = id - row * KCH;
      *(u32x4*)(sK + kswz<KRB>(row, ch)) = rk[i];
    }
#pragma unroll
    for (int i = 0; i < NVC; ++i) {
      int id = tid + 512 * i; int row = id >> 3, ch = id & 7;
      *(u32x4*)(sV + swz128(row, ch)) = rv[i];
    }
  };
  f32x16 oacc[NC];
#pragma unroll
  for (int c = 0; c < NC; ++c)
#pragma unroll
    for (int r = 0; r < 16; ++r) oacc[c][r] = 0.f;
  float m = -1e30f, l = 0.f;
  const int prow = (ql & 3) | ((ql & 4) << 1) | ((ql & 8) >> 1) | (ql & 16);
  const unsigned lds0 = (unsigned)(size_t)smem;
  const int qpos = q0 - CTXL + wq * 32 + ql;

  gload(0); sstore(0); __syncthreads();
#pragma unroll 1
  for (int ti = 0; ti < ntiles; ++ti) {
    const int kt = ti < 4 ? ti : lo + ti - 4;
    if (ti + 1 < ntiles) gload(ti + 1 < 4 ? ti + 1 : lo + ti + 1 - 4);
    const char* sK = smem + (ti & 1) * 40960; const char* sV = sK + 24576;
    const bool domask = (KIND == 1) && !isctx && kt >= 4;
#pragma unroll
    for (int hb = 0; hb < 2; hb += NMB) {
      f32x16 sacc[NMB];
#pragma unroll
      for (int mb = 0; mb < NMB; ++mb)
#pragma unroll
        for (int r = 0; r < 16; ++r) sacc[mb][r] = 0.f;
      {
        const unsigned kbase = lds0 + (unsigned)((ti & 1) * 40960) + (unsigned)((prow + 32 * hb) * KRB);
        if (KIND == 0) {
          unsigned ka[4];
#pragma unroll
          for (int ks = 0; ks < 4; ++ks) ka[ks] = kbase + ((unsigned)((8 * grp + 2 * ks + h) ^ (prow & 15)) << 4);
          qk_asm_a(*(f32x16(*)[2])&sacc, *(const bf16x8(*)[4])&qf, ka);
        } else if (KIND == 1) {
          unsigned ka[4];
#pragma unroll
          for (int ks = 0; ks < 4; ++ks) ka[ks] = kbase + ((unsigned)((2 * ks + h) ^ ((prow >> 1) & 7)) << 4);
          qk_asm_b(*(f32x16(*)[2])&sacc, *(const bf16x8(*)[4])&qf, ka);
        } else if (KIND == 2) {
          unsigned ka[4];
#pragma unroll
          for (int b4 = 0; b4 < 4; ++b4) ka[b4] = kbase + ((unsigned)((2 * b4 + h) ^ ((prow >> 1) & 7)) << 4);
          qk_asm_c(*(f32x16(*)[1])&sacc, *(const bf16x8(*)[12])&qf, ka);
        } else {
          unsigned ka[8];
#pragma unroll
          for (int ks = 0; ks < 8; ++ks) ka[ks] = kbase + ((unsigned)((2 * ks + h) ^ (prow & 15)) << 4);
          qk_asm_d(*(f32x16(*)[2])&sacc, *(const bf16x8(*)[8])&qf, ka);
        }
      }
      float mx = -1e30f;
      if (domask) {
#pragma unroll
        for (int mb = 0; mb < NMB; ++mb)
#pragma unroll
          for (int r = 0; r < 16; ++r) {
            int kpos = kt * 64 + 32 * (hb + mb) + 16 * (r >> 3) + 8 * h + (r & 7) - CTXL;
            int d = qpos - kpos; if (d < 0) d = -d;
            if (d > 128) sacc[mb][r] = -1e30f;
          }
      }
#pragma unroll
      for (int mb = 0; mb < NMB; ++mb)
#pragma unroll
        for (int r = 0; r < 16; r += 2) mx = fmaxf(mx, fmaxf(sacc[mb][r], sacc[mb][r + 1]));
      mx = xmax32(mx);
      const float mn = fmaxf(m, mx);
      const float nms = -mn * sl2;
      const float alpha = __builtin_amdgcn_exp2f((m - mn) * sl2);
      float sum = 0.f;
#pragma unroll
      for (int mb = 0; mb < NMB; ++mb)
#pragma unroll
        for (int r = 0; r < 16; ++r) { float pv = __builtin_amdgcn_exp2f(fmaf(sacc[mb][r], sl2, nms)); sacc[mb][r] = pv; sum += pv; }
      sum = xsum32(sum);
      l = l * alpha + sum; m = mn;
      if (__any(alpha != 1.f)) {
#pragma unroll
        for (int c = 0; c < NC; ++c)
#pragma unroll
          for (int r = 0; r < 16; ++r) oacc[c][r] *= alpha;
      }
      bf16x8 pb[NMB][2];
#pragma unroll
      for (int mb = 0; mb < NMB; ++mb)
#pragma unroll
        for (int s = 0; s < 2; ++s)
          pb[mb][s] = pack8(sacc[mb][8 * s], sacc[mb][8 * s + 1], sacc[mb][8 * s + 2], sacc[mb][8 * s + 3],
                            sacc[mb][8 * s + 4], sacc[mb][8 * s + 5], sacc[mb][8 * s + 6], sacc[mb][8 * s + 7]);
      {
        const unsigned vbase = lds0 + (unsigned)((ti & 1) * 40960 + 24576) + (unsigned)(ql * 128);
        unsigned va[NMB * 2];
#pragma unroll
        for (int mb = 0; mb < NMB; ++mb)
#pragma unroll
          for (int s = 0; s < 2; ++s) va[mb * 2 + s] = vbase + ((unsigned)((4 * (hb + mb) + 2 * s + h) ^ ((ql >> 1) & 7)) << 4);
        if (KIND == 1) pv_asm_22(*(f32x16(*)[2])&oacc, *(const bf16x8(*)[2][2])&pb, *(const unsigned(*)[4])&va);
        else if (KIND == 2) pv_asm_41(*(f32x16(*)[4])&oacc, *(const bf16x8(*)[1][2])&pb, *(const unsigned(*)[2])&va);
        else pv_asm_42(*(f32x16(*)[4])&oacc, *(const bf16x8(*)[2][2])&pb, *(const unsigned(*)[4])&va);
      }
    }
    if (ti + 1 < ntiles) sstore((ti + 1) & 1);
    __syncthreads();
  }
  unsigned pfa = 0u;
  if (nb >= 0) {
    const u16* K2; const u16* V2;
    if (KIND == 0) { K2 = p.QK + 1024 + nhh * 128; V2 = p.Vt + (size_t)(nhh * 128) * T; }
    else if (KIND == 1) { K2 = p.QK + 1024 + (nhh >> 2) * 64; V2 = p.Vt + (size_t)((nhh >> 2) * 64) * T; }
    else if (KIND == 2) { K2 = p.QK + (size_t)T * 1536 + nhh * 128; V2 = p.Vt + (size_t)(nhh * 128) * T; }
    else { K2 = p.QK + 1024 + (nhh >> 1) * 128; V2 = p.Vt + (size_t)((nhh >> 1) * 128) * T; }
    constexpr int LK = KRB / 128;
    const int tokb2 = nb * TPB;
    const char* pp = nullptr;
    if (tid < 64 * LK) {
      const int row = tid / LK, ln = tid - row * LK;
      if (KIND == 2 && ln == 2) pp = (const char*)(p.KR + (size_t)(tokb2 + row) * 64);
      else pp = (const char*)(K2 + (size_t)(tokb2 + row) * LDK + ln * 64);
    } else if (tid - 64 * LK < DV) {
      pp = (const char*)(V2 + (size_t)(tid - 64 * LK) * T + tokb2);
    }
    if (pp) asm volatile("global_load_dword %0, %1, off" : "=v"(pfa) : "v"(pp) : "memory");
  }
  float den = l;
  if (KIND == 1) den += __builtin_amdgcn_exp2f(p.b_sink[hh] * 1.4426950408889634f - m * sl2);
  const float inv = 1.f / den;
  constexpr int ORS = DV * 2 + 16;
  char* sO = smem + (KIND == 0 ? 65536 : 40960) + (KIND == 0 ? wq : wave) * (32 * ORS);
  if (KIND != 0) {
#pragma unroll
    for (int c = 0; c < NC; ++c)
#pragma unroll
      for (int r4 = 0; r4 < 4; ++r4) {
        int d = 32 * c + 8 * r4 + 4 * h;
        *(u32x2*)(sO + ql * ORS + d * 2) = u32x2{pack2(oacc[c][4 * r4] * inv, oacc[c][4 * r4 + 1] * inv),
                                                 pack2(oacc[c][4 * r4 + 2] * inv, oacc[c][4 * r4 + 3] * inv)};
      }
  } else {
    float* sX = (float*)smem;
    if (grp == 1) {
#pragma unroll
      for (int c = 0; c < NC; ++c)
#pragma unroll
        for (int r = 0; r < 16; ++r) sX[((wq * 4 + c) * 16 + r) * 64 + lane] = oacc[c][r] * inv;
    }
    __syncthreads();
    if (grp == 0) {
      float ss = 0.f;
#pragma unroll
      for (int c = 0; c < NC; ++c)
#pragma unroll
        for (int r = 0; r < 16; ++r) {
          float dv = oacc[c][r] * inv - lam * sX[((wq * 4 + c) * 16 + r) * 64 + lane];
          oacc[c][r] = dv; ss += dv * dv;
        }
      ss += __shfl_xor(ss, 32);
      const float rstd = rsqrtf(ss * (1.f / 128.f) + EPS) * 0.8f;
#pragma unroll
      for (int c = 0; c < NC; ++c)
#pragma unroll
        for (int r4 = 0; r4 < 4; ++r4) {
          int d = 32 * c + 8 * r4 + 4 * h;
          float4 g = *(const float4*)(p.a_subln + d);
          *(u32x2*)(sO + ql * ORS + d * 2) = u32x2{pack2(oacc[c][4 * r4] * rstd * g.x, oacc[c][4 * r4 + 1] * rstd * g.y),
                                                   pack2(oacc[c][4 * r4 + 2] * rstd * g.z, oacc[c][4 * r4 + 3] * rstd * g.w)};
        }
    }
  }
  if (KIND != 0 || grp == 0) {
    __threadfence_block();
    u16* obase = p.AO + (size_t)(tokb + q0 + wq * 32) * DM + aoff;
    constexpr int CPR = DV / 8;
#pragma unroll
    for (int k = 0; k < 32 * CPR / 64; ++k) {
      const int idx = k * 64 + lane;
      const int row = idx / CPR, ch = idx - row * CPR;
      const u32x4 v = *(const u32x4*)(sO + row * ORS + ch * 16);
      *(u32x4*)(obase + (size_t)row * DM + ch * 8) = v;
    }
  }
  asm volatile("s_waitcnt vmcnt(0)" :: "v"(pfa) : "memory");
  if (KIND == 0) __syncthreads();
}

template <int KIND>
DI void attn_phase_mfma(const Params& p, bool lat_only, char* smem) {
  constexpr int NH = KIND == 1 ? 16 : 8;
  constexpr int QTC = KIND == 0 ? 2 : 1, QTL = KIND == 0 ? 16 : 8;
  float lam = 0.f;
  if (KIND == 0) {
    const int lane = tidx() & 63;
    float s1 = wave_sum(p.a_lq1[lane] * p.a_lk1[lane]);
    float s2 = wave_sum(p.a_lq2[lane] * p.a_lk2[lane]);
    lam = __expf(s1) - __expf(s2) + 0.2f;
  }
  const int n_lat = NBATCH * NH * QTL, n_ctx = lat_only ? 0 : NBATCH * NH * QTC;
#pragma unroll 1
  for (int i = blockIdx.x; i < n_lat + n_ctx; i += gridDim.x) {
    int b, hh, qt;
    if (i < n_lat) { b = i & 7; int j = i >> 3; hh = j / QTL; qt = QTC + (j - hh * QTL); }
    else { int i2 = i - n_lat; b = i2 & 7; int j = i2 >> 3; hh = j / QTC; qt = j - hh * QTC; }
    int nb = -1, nhh = 0;
    {
      const int i3 = i + gridDim.x;
      if (i3 < n_lat + n_ctx) {
        if (i3 < n_lat) { nb = i3 & 7; nhh = (i3 >> 3) / QTL; }
        else { const int i4 = i3 - n_lat; nb = i4 & 7; nhh = (i4 >> 3) / QTC; }
      }
    }
    attn_item<KIND>(p, b, hh, qt, smem, lam, nb, nhh);
  }
}


#define XB_TMO      128
#define XB_XCNT(j)  (256  + 64 * (j))
#define XB_XSUB(j)  (1280 + 64 * (j))
#define XB_XGEN(j)  (2304 + 64 * (j))
#define XB_TOP      3328
#define XB_TOPGEN   3392
#define XCD_BAR_WORDS 3456
#define XB_SPIN_CAP (1u << 18)
#define LAS __attribute__((address_space(3)))
DI unsigned xb_ld(unsigned* p)              { return __hip_atomic_load(p, __ATOMIC_RELAXED, __HIP_MEMORY_SCOPE_AGENT); }
DI unsigned xb_add(unsigned* p, unsigned v) { return __hip_atomic_fetch_add(p, v, __ATOMIC_RELAXED, __HIP_MEMORY_SCOPE_AGENT); }
DI unsigned xb_xcc_id() { return (unsigned)__builtin_amdgcn_s_getreg((3 << 11) | 20) & 0xFu; }
#define XB_SPIN(cond, bar) do { unsigned _sp = 0; while (cond) { __builtin_amdgcn_s_sleep(1); \
    if ((++_sp & 255u) == 0u) { if (xb_ld(&(bar)[XB_TMO])) break; if (_sp > XB_SPIN_CAP) { atomicAdd(&(bar)[XB_TMO], 1u); break; } } } } while (0)
struct XcdBarrier { unsigned* bar; unsigned x; volatile LAS unsigned* st; };
DI XcdBarrier xcd_barrier_post(unsigned* bar, volatile LAS unsigned* st) {
    XcdBarrier b; b.bar = bar; b.x = xb_xcc_id(); b.st = st;
    if (threadIdx.x == 0) (void)xb_add(&bar[XB_XCNT(b.x)], 1u);
    return b;
}
DI void xcd_barrier_complete(unsigned* bar, unsigned x, unsigned& nloc, unsigned& nx) {
    const unsigned G = gridDim.x * gridDim.y * gridDim.z;
    unsigned sum, cnt, mine, sp = 0u;
    for (;;) {
        sum = 0u; cnt = 0u; mine = 0u;
#pragma unroll
        for (unsigned j = 0; j < 16; ++j) { const unsigned c = xb_ld(&bar[XB_XCNT(j)]); sum += c; cnt += (c > 0u) ? 1u : 0u; mine = (j == x) ? c : mine; }
        if (sum == G) break;
        __builtin_amdgcn_s_sleep(1);
        if ((++sp & 255u) == 0u) { if (xb_ld(&bar[XB_TMO])) break; if (sp > XB_SPIN_CAP) { atomicAdd(&bar[XB_TMO], 1u); break; } }
    }
    nloc = mine > 0u ? mine : 1u; nx = cnt > 0u ? cnt : 1u;
}
DI void xcd_barrier(const XcdBarrier& b) {
    asm volatile("s_waitcnt vmcnt(0)" ::: "memory");
    __syncthreads();
    if (threadIdx.x == 0) {
        unsigned* bar = b.bar;
        __builtin_amdgcn_s_waitcnt(0);
        unsigned nloc = b.st[0], nx = b.st[1];
        if (nloc == 0u) { xcd_barrier_complete(bar, b.x, nloc, nx); b.st[0] = nloc; b.st[1] = nx; }
        const unsigned old = xb_add(&bar[XB_XSUB(b.x)], 1u);
        const unsigned gen = old / nloc;
        if (old + 1u == (gen + 1u) * nloc) {
            __builtin_amdgcn_fence(__ATOMIC_RELEASE, "agent");
            asm volatile("s_waitcnt vmcnt(0)" ::: "memory");
            const unsigned og = xb_add(&bar[XB_TOP], 1u);
            const unsigned tg = og / nx;
            if (og + 1u == (tg + 1u) * nx) xb_add(&bar[XB_TOPGEN], 1u);
            else XB_SPIN(xb_ld(&bar[XB_TOPGEN]) == tg, bar);
            __builtin_amdgcn_fence(__ATOMIC_ACQUIRE, "agent");
            xb_add(&bar[XB_XGEN(b.x)], 1u);
            asm volatile("s_waitcnt vmcnt(0)" ::: "memory");
        } else {
            XB_SPIN(xb_ld(&bar[XB_XGEN(b.x)]) == gen, bar);
            __builtin_amdgcn_fence(__ATOMIC_ACQUIRE, "agent");
            asm volatile("s_waitcnt vmcnt(0)" ::: "memory");
        }
    }
    __syncthreads();
}

__global__ void __launch_bounds__(NTHR) mega(Params p) {
  __shared__ __attribute__((aligned(16))) char smem[SMEM_BYTES];
  cg::grid_group grid = cg::this_grid();
  __shared__ uint4 xb_words;
  if (threadIdx.x == 0) xb_words = make_uint4(0u, 0u, 0u, 0u);
  __syncthreads();
  const XcdBarrier xb = xcd_barrier_post(p.bar, (volatile LAS unsigned*)&xb_words);
  for (int ph = p.ph_lo; ph < p.ph_hi; ++ph) {
    if (ph > p.ph_lo) { if (p.ph_hi < 0) grid.sync(); else xcd_barrier(xb); }
    const int code = p.prog[ph];
    const int layer = (code >> 4) & 15, op = code & 15;
    const bool last = layer == 3;
    const float gs = (code & 256) ? 0.f : 1.f;
    switch (op) {
      case OP_PRO: prologue(p, smem); break;
      case OP_NORM1: norm_phase(p, layer, 0, false); break;
      case OP_QKV: qkv_phase(p, layer, smem); break;
      case OP_MLA_DOWN: mla_down_phase(p, smem); break;
      case OP_MLA_UP: mla_up_phase(p, smem); break;
      case OP_ATTN:
        if (layer == 0) attn_phase_mfma<0>(p, false, smem);
        else if (layer == 1) attn_phase_mfma<1>(p, false, smem);
        else if (layer == 2) attn_phase_mfma<2>(p, false, smem);
        else attn_phase_mfma<3>(p, true, smem);
        break;
      case OP_OPROJ: resid_gemm_phase(p, layer, p.AO, DM, DM, p.Wo[layer], 2, last, smem, gs); break;
      case OP_NORM2: norm_phase(p, layer, 1, last); break;
      case OP_FFN_UP: ffn_up_phase(p, layer, last, smem); break;
      case OP_FFN_DOWN: resid_gemm_phase(p, layer, p.G, DFF, DFF, p.Wdn[layer], 5, last, smem, gs); break;
      case OP_FINAL: final_phase(p); break;
      default: break;
    }
  }
}

static inline size_t al256(size_t x) { return (x + 255) & ~(size_t)255; }

extern "C" void kernel_launch(void* const* d_in, const int* in_sizes, int n_in, void* d_out, int out_size, void* d_ws,
                              size_t ws_size, hipStream_t stream) {
  Params p;
  memset(&p, 0, sizeof(p));
  auto F = [&](int i) { return (const float*)d_in[i]; };
  p.x = F(0); p.c = F(1); p.ctx = F(2); p.c_ctx = F(3); p.ada_w = F(4); p.ada_b = F(5); p.norm1_g = F(6); p.norm2_g = F(7);
  const float* ffn_up = F(8); p.conv_w = F(9); p.conv_b = F(10); const float* ffn_down = F(11);
  const float* a_w_qkv = F(12); const float* a_w_o = F(13);
  p.a_lq1 = F(14); p.a_lk1 = F(15); p.a_lq2 = F(16); p.a_lk2 = F(17); p.a_subln = F(18);
  const float* b_w_qkv = F(19); const float* b_w_o = F(20); p.b_sink = F(21);
  const float* c_w_down = F(22); const float* c_qg = F(23); const float* c_kvg = F(24);
  const float* c_w_uq = F(25); const float* c_w_ukv = F(26); const float* c_w_o = F(27);
  const float* d_w_qkv = F(28); p.d_qg = F(29); p.d_kg = F(30); const float* d_w_o = F(31);
  p.final_g = F(32);
  p.out = (float*)d_out;

  char* ws = (char*)d_ws; size_t off = 0;
  auto take = [&](size_t bytes) { char* r = ws + off; off = al256(off + bytes); return r; };
  p.bar = (unsigned*)take((size_t)XCD_BAR_WORDS * 4);
  p.Rctx = (float*)take((size_t)NBATCH * CTXL * DM * 4);
  p.MOD = (float*)take((size_t)4 * 9 * 6144 * 4);
  p.rope64 = (float*)take((size_t)131072 * 4);
  p.rope128 = (float*)take((size_t)262144 * 4);
  p.H = (u16*)take((size_t)T * DM * 2 + 4096);
  char* region = take((size_t)T * 2560 * 2 + (size_t)T * 1024 * 2 * 2 + (size_t)T * 768 * 2 + (size_t)T * 64 * 2);
  p.QK = (u16*)region;
  p.Vt = p.QK + (size_t)T * 2560;
  p.AO = p.Vt + (size_t)T * 1024;
  p.T1 = p.AO + (size_t)T * 1024;
  p.KR = p.T1 + (size_t)T * 768;
  p.G = (u16*)region;
  for (int l = 0; l < 4; ++l) {
    p.Wup[l] = (u16*)take((size_t)5632 * 1024 * 2);
    p.Wdn[l] = (u16*)take((size_t)1024 * 2816 * 2);
    p.Wo[l] = (u16*)take((size_t)1024 * 1024 * 2);
  }
  p.Wa_qkv = (u16*)take((size_t)3072 * 1024 * 2);
  p.Wb_qkv = (u16*)take((size_t)1536 * 1024 * 2);
  p.Wc_d = (u16*)take((size_t)768 * 1024 * 2);
  p.Wc_uq = (u16*)take((size_t)1536 * 384 * 2);
  p.Wc_uk = (u16*)take((size_t)1024 * 256 * 2);
  p.Wc_uv = (u16*)take((size_t)1024 * 256 * 2);
  p.Wd_qkv = (u16*)take((size_t)2048 * 1024 * 2);
  if (off > ws_size) { fprintf(stderr, "workspace too small: need %zu have %zu\n", off, ws_size); return; }

  int nj = 0, tiles = 0;
  auto job = [&](const float* src, u16* dst, const float* g, int K, int N, int ld, int grp, int gstride, int o, int mode) {
    Job& j = p.jobs[nj++];
    j.src = src; j.dst = dst; j.g = g; j.K = K; j.N = N; j.ld = ld; j.grp = grp; j.gstride = gstride; j.off = o; j.mode = mode; j.tile0 = tiles;
    tiles += (K / 64) * (N / 64);
  };
  const int BIG = 1 << 30;
  const float* wo_src[4] = {a_w_o, b_w_o, c_w_o, d_w_o};
  for (int l = 0; l < 4; ++l) {
    p.ltile[l] = tiles;
    if (l == 0) job(a_w_qkv, p.Wa_qkv, nullptr, 1024, 3072, 3072, BIG, 0, 0, 0);
    if (l == 1) job(b_w_qkv, p.Wb_qkv, nullptr, 1024, 1536, 1536, BIG, 0, 0, 0);
    if (l == 2) {
      job(c_w_down, p.Wc_d, nullptr, 1024, 768, 704, BIG, 0, 0, 2);
      job(c_w_uq, p.Wc_uq, c_qg, 384, 1536, 1536, BIG, 0, 0, 0);
      job(c_w_ukv, p.Wc_uk, c_kvg, 256, 1024, 2048, 128, 256, 0, 0);
      job(c_w_ukv, p.Wc_uv, c_kvg, 256, 1024, 2048, 128, 256, 128, 0);
    }
    if (l == 3) job(d_w_qkv, p.Wd_qkv, nullptr, 1024, 2048, 2048, BIG, 0, 0, 0);
    job(wo_src[l], p.Wo[l], nullptr, 1024, 1024, 1024, BIG, 0, 0, 0);
    job(ffn_up + (size_t)l * 1024 * 5632, p.Wup[l], nullptr, 1024, 5632, 5632, BIG, 0, 0, 1);
    job(ffn_down + (size_t)l * 2816 * 1024, p.Wdn[l], nullptr, 2816, 1024, 1024, BIG, 0, 0, 0);
  }
  p.ltile[4] = tiles; p.ltile[5] = 0;
  p.njobs = nj; p.conv_tiles = tiles;

  int np = 0;
  p.prog[np++] = OP_PRO;
  for (int l = 0; l < 4; ++l) {
    p.prog[np++] = l * 16 + OP_NORM1;
    if (l == 2) { p.prog[np++] = l * 16 + OP_MLA_DOWN; p.prog[np++] = l * 16 + OP_MLA_UP; }
    else p.prog[np++] = l * 16 + OP_QKV;
    p.prog[np++] = l * 16 + OP_ATTN;
    p.prog[np++] = l * 16 + OP_OPROJ;
    p.prog[np++] = l * 16 + OP_NORM2;
    p.prog[np++] = l * 16 + OP_FFN_UP;
    p.prog[np++] = l * 16 + OP_FFN_DOWN;
  }
  p.prog[np++] = 3 * 16 + OP_FINAL;
#ifdef PROBE_DUP_OP
  {
    int tmp[48]; int n2 = 0;
    for (int i = 0; i < np; ++i) { tmp[n2++] = p.prog[i]; if ((p.prog[i] & 15) == PROBE_DUP_OP) tmp[n2++] = p.prog[i] | 256; }
    for (int i = 0; i < n2; ++i) p.prog[i] = tmp[i];
    np = n2;
  }
#endif
  p.nprog = np;

  static int grid_blocks = 0;
  if (!grid_blocks) {
    int dev = 0, cus = 0, per_cu = 0;
    hipGetDevice(&dev);
    hipDeviceGetAttribute(&cus, hipDeviceAttributeMultiprocessorCount, dev);
    hipOccupancyMaxActiveBlocksPerMultiprocessor(&per_cu, mega, NTHR, 0);
    if (per_cu < 1) per_cu = 1;
    grid_blocks = cus * per_cu;
  }
#if MULTI_LAUNCH
  for (int ph = 0; ph < np; ++ph) {
    p.ph_lo = ph; p.ph_hi = ph + 1;
    hipLaunchKernelGGL(mega, dim3(grid_blocks), dim3(NTHR), 0, stream, p);
  }
#else
  p.ph_lo = 0; p.ph_hi = np;
  hipMemsetAsync(p.bar, 0, (size_t)XCD_BAR_WORDS * 4, stream);
  void* args[] = {&p};
  hipError_t e = hipLaunchCooperativeKernel((void*)mega, dim3(grid_blocks), dim3(NTHR), args, 0, stream);
  if (e != hipSuccess) fprintf(stderr, "cooperative launch failed: %s (grid %d)\n", hipGetErrorString(e), grid_blocks);
#endif
}
```

```cpp
#include <hip/hip_runtime.h>
#include <hip/hip_cooperative_groups.h>
#include <cstdio>
#include <cstring>
namespace cg = cooperative_groups;

#ifndef REF_ATTN
#define REF_ATTN 0
#endif
#ifndef MULTI_LAUNCH
#define MULTI_LAUNCH 0
#endif

typedef unsigned short u16;
using bf16x8 = __attribute__((ext_vector_type(8))) short;
using f32x16 = __attribute__((ext_vector_type(16))) float;
using u32x4 = __attribute__((ext_vector_type(4))) unsigned;
using u32x2 = __attribute__((ext_vector_type(2))) unsigned;
using f32x4 = __attribute__((ext_vector_type(4))) float;
using f32x2 = __attribute__((ext_vector_type(2))) float;
#define DI __device__ __forceinline__
DI int threadIdx_x_raw() { return (int)__builtin_amdgcn_workitem_id_x(); }

constexpr int DM = 1024, NBATCH = 8, SEQ = 2048, CTXL = 256, TPB = 2304, T = 18432, DFF = 2816;
constexpr int NTHR = 512;
constexpr int CLD = 260;
constexpr int STAGE_BYTES = 131072;
constexpr int BND_OFF = 128 * CLD * 4;
constexpr int RS_OFF = BND_OFF + 4 * 256 * 4;
constexpr int SMEM_BYTES = RS_OFF + 1024;
constexpr float EPS = 1e-6f;

enum { OP_PRO = 0, OP_NORM1, OP_QKV, OP_MLA_DOWN, OP_MLA_UP, OP_ATTN, OP_OPROJ, OP_NORM2, OP_FFN_UP, OP_FFN_DOWN, OP_FINAL };

struct Job { const float* src; u16* dst; const float* g; int K, N, ld, grp, gstride, off, mode, tile0; };

struct Params {
  const float *x, *c, *ctx, *c_ctx, *ada_w, *ada_b, *norm1_g, *norm2_g, *conv_w, *conv_b;
  const float *a_lq1, *a_lk1, *a_lq2, *a_lk2, *a_subln, *b_sink, *d_qg, *d_kg, *final_g;
  float *out, *Rctx, *MOD, *rope64, *rope128;
  u16 *H, *QK, *Vt, *AO, *T1, *KR, *G;
  unsigned* bar;
  u16 *Wup[4], *Wdn[4], *Wo[4];
  u16 *Wa_qkv, *Wb_qkv, *Wc_d, *Wc_uq, *Wc_uk, *Wc_uv, *Wd_qkv;
  Job jobs[20];
  int njobs, conv_tiles, nprog, ph_lo, ph_hi, pad0;
  int ltile[6];
  int prog[48];
};

DI int tidx() { int t = threadIdx_x_raw(); asm volatile("" : "+v"(t)); return t; }
DI u16 f2bf(float x) { unsigned u = __float_as_uint(x); u += 0x7fffu + ((u >> 16) & 1u); return (u16)(u >> 16); }
DI float bf2f(u16 h) { return __uint_as_float(((unsigned)h) << 16); }
DI float bflo(unsigned w) { return __uint_as_float(w << 16); }
DI float bfhi(unsigned w) { return __uint_as_float(w & 0xffff0000u); }
DI unsigned pack2(float a, float b) { unsigned r; asm("v_cvt_pk_bf16_f32 %0, %1, %2" : "=v"(r) : "v"(a), "v"(b)); return r; }
DI float wave_sum(float v) { for (int o = 32; o; o >>= 1) v += __shfl_xor(v, o); return v; }
DI float wave_max(float v) { for (int o = 32; o; o >>= 1) v = fmaxf(v, __shfl_xor(v, o)); return v; }
DI void swap32(float x, float& lo, float& hi) {
  auto r = __builtin_amdgcn_permlane32_swap(__float_as_uint(x), __float_as_uint(x), false, false);
  lo = __uint_as_float(r[0]); hi = __uint_as_float(r[1]);
}
DI float xmax32(float x) { float a, b; swap32(x, a, b); return fmaxf(a, b); }
DI float xsum32(float x) { float a, b; swap32(x, a, b); return a + b; }
DI float siluf(float v) { return v * __builtin_amdgcn_rcpf(1.f + __expf(-v)); }

DI float* rrow(const Params& p, int t) {
  int b = t / TPB, r = t - b * TPB;
  return r < CTXL ? p.Rctx + (size_t)(b * CTXL + r) * DM : p.out + (size_t)(b * SEQ + r - CTXL) * DM;
}
DI const float* xrow(const Params& p, int t) {
  int b = t / TPB, r = t - b * TPB;
  const float* px = p.x; const float* pc = p.ctx;
  asm volatile("" : "+s"(px), "+s"(pc));
  return r < CTXL ? pc + (size_t)(b * CTXL + r) * DM : px + (size_t)(b * SEQ + r - CTXL) * DM;
}
DI int modrow(int t) { int b = t / TPB, r = t - b * TPB; return r < CTXL ? 8 : b; }
DI int lat_token(int li) { int b = li >> 11; return b * TPB + CTXL + (li & 2047); }

struct CvT { const float* src; u16* dst; const float* g; int ld, K, k0, n0, col; bool ok, okcol; };
DI CvT cv_decode(const Params& p, int tile, bool ok, int t) {
  CvT c;
  int jb = 0;
  for (int q = 1; q < p.njobs; ++q) if (tile >= p.jobs[q].tile0) jb = q;
  const Job& j = p.jobs[jb];
  const int tl = tile - j.tile0;
  const int ntn = j.N >> 6;
  const int kt = tl / ntn, nt = tl - kt * ntn;
  c.k0 = kt * 64; c.n0 = nt * 64;
  const int n = c.n0 + (t & 63);
  c.okcol = true;
  if (j.mode == 1) c.col = (n >> 8) * 128 + (n & 127) + ((n >> 7) & 1) * DFF;
  else if (j.mode == 2) { c.col = n; c.okcol = n < 704; }
  else c.col = (n / j.grp) * j.gstride + (n % j.grp) + j.off;
  c.src = j.src; c.dst = j.dst; c.g = j.g; c.ld = j.ld; c.K = j.K; c.ok = ok;
  return c;
}
DI void convert_tiles(const Params& p, int tile0, int ntiles, char* smem) {
  const int tid = tidx();
  const int half = tid >> 8, t = tid & 255;
  const int nl = t & 63, kk = t >> 6;
  const int tA = tile0 + half * 2, tB = tA + 1;
  const CvT ca = cv_decode(p, tA < ntiles ? tA : 0, tA < ntiles, t), cb = cv_decode(p, tB < ntiles ? tB : 0, tB < ntiles, t);
  float* stA = (float*)smem + (half * 2) * (64 * 65); float* stB = stA + 64 * 65;
  float va[16], vb[16];
#pragma unroll
  for (int i = 0; i < 16; ++i) va[i] = (ca.ok && ca.okcol) ? __builtin_nontemporal_load(ca.src + (size_t)(ca.k0 + kk + 4 * i) * ca.ld + ca.col) : 0.f;
#pragma unroll
  for (int i = 0; i < 16; ++i) vb[i] = (cb.ok && cb.okcol) ? __builtin_nontemporal_load(cb.src + (size_t)(cb.k0 + kk + 4 * i) * cb.ld + cb.col) : 0.f;
#pragma unroll
  for (int i = 0; i < 16; ++i) {
    const int kl = kk + 4 * i;
    float x = va[i]; if (ca.g) x *= ca.g[ca.k0 + kl];
    stA[kl * 65 + nl] = x;
    float y = vb[i]; if (cb.g) y *= cb.g[cb.k0 + kl];
    stB[kl * 65 + nl] = y;
  }
  __syncthreads();
  {
    const int n2 = t >> 2, kc = t & 3;
    if (ca.ok) {
      unsigned w[8];
#pragma unroll
      for (int i = 0; i < 8; ++i) w[i] = pack2(stA[(kc * 16 + 2 * i) * 65 + n2], stA[(kc * 16 + 2 * i + 1) * 65 + n2]);
      u32x4* d = (u32x4*)(ca.dst + (size_t)(ca.n0 + n2) * ca.K + ca.k0 + kc * 16);
      d[0] = u32x4{w[0], w[1], w[2], w[3]}; d[1] = u32x4{w[4], w[5], w[6], w[7]};
    }
    if (cb.ok) {
      unsigned w[8];
#pragma unroll
      for (int i = 0; i < 8; ++i) w[i] = pack2(stB[(kc * 16 + 2 * i) * 65 + n2], stB[(kc * 16 + 2 * i + 1) * 65 + n2]);
      u32x4* d = (u32x4*)(cb.dst + (size_t)(cb.n0 + n2) * cb.K + cb.k0 + kc * 16);
      d[0] = u32x4{w[0], w[1], w[2], w[3]}; d[1] = u32x4{w[4], w[5], w[6], w[7]};
    }
  }
  __syncthreads();
}

DI void mod_item2(const Params& p, int item, bool ok_item, char* smem) {
  float* ss = (float*)smem;
  const int tid = tidx();
  const int half = tid >> 8, t = tid & 255;
  float* red = ss + 9 * 1024 + half * (4 * 576);
  const int layer = item / 96, n0 = (item % 96) * 64;
  for (int i = tid; i < 9 * 1024; i += NTHR) {
    int r = i >> 10, k = i & 1023;
    float v = r < 8 ? p.c[r * 1024 + k] : p.c_ctx[k];
    ss[i] = siluf(v);
  }
  __syncthreads();
  const int cq = t & 15, kg = t >> 4;
  f32x4 acc[9];
#pragma unroll
  for (int r = 0; r < 9; ++r) acc[r] = f32x4{0.f, 0.f, 0.f, 0.f};
  if (ok_item) {
    const float* w = p.ada_w + (size_t)layer * 1024 * 6144 + n0 + cq * 4 + (size_t)(kg * 64) * 6144;
#pragma unroll 1
    for (int kb = 0; kb < 64; kb += 8) {
      f32x4 wv[8];
#pragma unroll
      for (int u = 0; u < 8; ++u) wv[u] = *(const f32x4*)(w + (size_t)(kb + u) * 6144);
#pragma unroll
      for (int u = 0; u < 8; ++u) {
        const int k = kg * 64 + kb + u;
#pragma unroll
        for (int r = 0; r < 9; ++r) acc[r] += ss[r * 1024 + k] * wv[u];
      }
    }
  }
#pragma unroll
  for (int r = 0; r < 9; ++r)
#pragma unroll
    for (int e = 0; e < 4; ++e) {
      float x = acc[r][e];
      x += __shfl_xor(x, 16); x += __shfl_xor(x, 32);
      acc[r][e] = x;
    }
  const int wv4 = t >> 6, lane = t & 63;
  if (lane < 16) {
#pragma unroll
    for (int r = 0; r < 9; ++r) *(f32x4*)(red + (wv4 * 9 + r) * 64 + lane * 4) = acc[r];
  }
  __syncthreads();
  if (ok_item) {
    for (int i = t; i < 576; i += 256) {
      int c = i & 63;
      float v = red[i] + red[576 + i] + red[1152 + i] + red[1728 + i] + p.ada_b[layer * 6144 + n0 + c];
      p.MOD[((size_t)layer * 9 + (i >> 6)) * 6144 + n0 + c] = v;
    }
  }
  __syncthreads();
}

DI void sincos_acc(float ang, float& c, float& s) {
  float k = rintf(ang * 0.15915494309189535f);
  float x = fmaf(-k, 6.28318548202514648f, ang);
  x = fmaf(-k, -1.7484555e-7f, x);
  c = __cosf(x); s = __sinf(x);
}

DI void rope_item(const Params& p, int item) {
  int e = item * NTHR + tidx();
  if (e < 65536) {
    int pos = e >> 5, i = e & 31;
    int f = i & 15; float posv = (i < 16) ? (float)(pos >> 6) : (float)(pos & 63);
    float inv = exp2f(-(float)f / 16.f * 13.287712379549449f);
    float c, s; sincos_acc(posv * inv, c, s);
    p.rope64[e] = c; p.rope64[65536 + e] = s;
  } else {
    e -= 65536;
    int pos = e >> 6, i = e & 63;
    int f = i & 31; float posv = (i < 32) ? (float)(pos >> 6) : (float)(pos & 63);
    float inv = exp2f(-(float)f / 32.f * 13.287712379549449f);
    float c, s; sincos_acc(posv * inv, c, s);
    p.rope128[e] = c; p.rope128[131072 + e] = s;
  }
}

DI void prologue(const Params& p, char* smem) {
  const int n_mod2 = 48, n_rope = 384;
  const int G = gridDim.x;
#pragma unroll 1
  for (int i = blockIdx.x; i < n_mod2; i += G) mod_item2(p, 2 * i + (tidx() >> 8), true, smem);
  const int nconv0 = p.ltile[1];
  const int nct2 = (nconv0 + 3) >> 2;
  int start = (blockIdx.x + G - (n_mod2 % G)) % G;
#pragma unroll 1
  for (int i = start; i < nct2; i += G) convert_tiles(p, 4 * i, nconv0, smem);
#pragma unroll 1
  for (int i = blockIdx.x; i < n_rope; i += G) rope_item(p, i);
}

DI void norm_phase(const Params& p, int layer, int which  , bool lat_only) {
  const int lane = tidx() & 63, wave = tidx() >> 6;
  const int nrows = lat_only ? SEQ : TPB;
  const int grp8 = blockIdx.x & 7, slot = blockIdx.x >> 3, per = gridDim.x >> 3;
  const int tbase = grp8 * TPB + (lat_only ? CTXL : 0);
  const float* g = (which ? p.norm2_g : p.norm1_g) + layer * DM;
#pragma unroll 1
  for (int it = slot; it * 16 < nrows && slot < per; it += per) {
    f32x4 v[2][4];
    int tt[2];
#pragma unroll
    for (int u = 0; u < 2; ++u) {
      int ri = it * 16 + wave * 2 + u;
      tt[u] = tbase + ri;
      const float* xr = (layer == 0 && which == 0) ? xrow(p, tt[u]) : (const float*)rrow(p, tt[u]);
#pragma unroll
      for (int q = 0; q < 2; ++q) {
        v[u][2 * q] = *(const f32x4*)(xr + q * 512 + lane * 8);
        v[u][2 * q + 1] = *(const f32x4*)(xr + q * 512 + lane * 8 + 4);
      }
    }
#pragma unroll
    for (int u = 0; u < 2; ++u) {
      const int t = tt[u];
      const float* md = p.MOD + ((size_t)layer * 9 + modrow(t)) * 6144 + which * 3072;
      float ss = 0;
#pragma unroll
      for (int q = 0; q < 4; ++q) ss += v[u][q][0] * v[u][q][0] + v[u][q][1] * v[u][q][1] + v[u][q][2] * v[u][q][2] + v[u][q][3] * v[u][q][3];
      ss = wave_sum(ss);
      const float rstd = rsqrtf(ss * (1.f / DM) + EPS);
#pragma unroll
      for (int q = 0; q < 2; ++q) {
        const int cidx = q * 512 + lane * 8;
        unsigned w[4];
#pragma unroll
        for (int e = 0; e < 2; ++e) {
          const f32x4 gg = *(const f32x4*)(g + cidx + 4 * e);
          const f32x4 sh = *(const f32x4*)(md + cidx + 4 * e);
          const f32x4 sc = *(const f32x4*)(md + 1024 + cidx + 4 * e);
          const f32x4 y = v[u][2 * q + e] * rstd * gg * (sc + 1.f) + sh;
          w[2 * e] = pack2(y[0], y[1]); w[2 * e + 1] = pack2(y[2], y[3]);
        }
        *(u32x4*)(p.H + (size_t)t * DM + cidx) = u32x4{w[0], w[1], w[2], w[3]};
      }
    }
  }
}

DI void final_phase(const Params& p) {
  const int lane = tidx() & 63, wave = tidx() >> 6;
  const int grp8 = blockIdx.x & 7, slot = blockIdx.x >> 3, per = gridDim.x >> 3;
#pragma unroll 1
  for (int it = slot; it * 8 < SEQ && slot < per; it += per) {
    int ri = grp8 * SEQ + it * 8 + wave;
    float* xr = p.out + (size_t)ri * DM;
    float4 v[4]; float ss = 0;
#pragma unroll
    for (int q = 0; q < 4; ++q) {
      v[q] = *(const float4*)(xr + q * 256 + lane * 4);
      ss += v[q].x * v[q].x + v[q].y * v[q].y + v[q].z * v[q].z + v[q].w * v[q].w;
    }
    ss = wave_sum(ss);
    float rstd = rsqrtf(ss * (1.f / DM) + EPS);
#pragma unroll
    for (int q = 0; q < 4; ++q) {
      int cidx = q * 256 + lane * 4;
      float4 gg = *(const float4*)(p.final_g + cidx);
      float4 o = {v[q].x * rstd * gg.x, v[q].y * rstd * gg.y, v[q].z * rstd * gg.z, v[q].w * rstd * gg.w};
      *(float4*)(xr + cidx) = o;
    }
  }
}

DI int swz128(int row, int chunk) { return row * 128 + ((chunk ^ ((row >> 1) & 7)) << 4); }


DI void mma_ktile(f32x16 (&acc)[4][2], unsigned a0, unsigned a1, unsigned a2, unsigned a3, unsigned b0, unsigned b1, unsigned b2, unsigned b3) {
  u32x4 f0, f1, f2, f3, f4, f5, f6, f7, f8, f9;
  asm volatile(
      "ds_read_b128 %8, %18 offset:0\n\t"
      "ds_read_b128 %9, %18 offset:4096\n\t"
      "ds_read_b128 %10, %18 offset:8192\n\t"
      "ds_read_b128 %11, %18 offset:12288\n\t"
      "ds_read_b128 %16, %22 offset:0\n\t"
      "ds_read_b128 %17, %22 offset:4096\n\t"
      "ds_read_b128 %12, %19 offset:0\n\t"
      "ds_read_b128 %13, %19 offset:4096\n\t"
      "ds_read_b128 %14, %19 offset:8192\n\t"
      "ds_read_b128 %15, %19 offset:12288\n\t"
      "s_waitcnt lgkmcnt(4)\n\t"
      "v_mfma_f32_32x32x16_bf16 %0, %8, %16, %0\n\t"
      "v_mfma_f32_32x32x16_bf16 %2, %9, %16, %2\n\t"
      "v_mfma_f32_32x32x16_bf16 %4, %10, %16, %4\n\t"
      "v_mfma_f32_32x32x16_bf16 %6, %11, %16, %6\n\t"
      "ds_read_b128 %16, %23 offset:0\n\t"
      "v_mfma_f32_32x32x16_bf16 %1, %8, %17, %1\n\t"
      "v_mfma_f32_32x32x16_bf16 %3, %9, %17, %3\n\t"
      "v_mfma_f32_32x32x16_bf16 %5, %10, %17, %5\n\t"
      "v_mfma_f32_32x32x16_bf16 %7, %11, %17, %7\n\t"
      "ds_read_b128 %17, %23 offset:4096\n\t"
      "ds_read_b128 %8, %20 offset:0\n\t"
      "ds_read_b128 %9, %20 offset:4096\n\t"
      "ds_read_b128 %10, %20 offset:8192\n\t"
      "ds_read_b128 %11, %20 offset:12288\n\t"
      "s_waitcnt lgkmcnt(5)\n\t"
      "v_mfma_f32_32x32x16_bf16 %0, %12, %16, %0\n\t"
      "v_mfma_f32_32x32x16_bf16 %2, %13, %16, %2\n\t"
      "v_mfma_f32_32x32x16_bf16 %4, %14, %16, %4\n\t"
      "v_mfma_f32_32x32x16_bf16 %6, %15, %16, %6\n\t"
      "ds_read_b128 %16, %24 offset:0\n\t"
      "s_waitcnt lgkmcnt(5)\n\t"
      "v_mfma_f32_32x32x16_bf16 %1, %12, %17, %1\n\t"
      "v_mfma_f32_32x32x16_bf16 %3, %13, %17, %3\n\t"
      "v_mfma_f32_32x32x16_bf16 %5, %14, %17, %5\n\t"
      "v_mfma_f32_32x32x16_bf16 %7, %15, %17, %7\n\t"
      "ds_read_b128 %17, %24 offset:4096\n\t"
      "ds_read_b128 %12, %21 offset:0\n\t"
      "ds_read_b128 %13, %21 offset:4096\n\t"
      "ds_read_b128 %14, %21 offset:8192\n\t"
      "ds_read_b128 %15, %21 offset:12288\n\t"
      "s_waitcnt lgkmcnt(5)\n\t"
      "v_mfma_f32_32x32x16_bf16 %0, %8, %16, %0\n\t"
      "v_mfma_f32_32x32x16_bf16 %2, %9, %16, %2\n\t"
      "v_mfma_f32_32x32x16_bf16 %4, %10, %16, %4\n\t"
      "v_mfma_f32_32x32x16_bf16 %6, %11, %16, %6\n\t"
      "ds_read_b128 %16, %25 offset:0\n\t"
      "s_waitcnt lgkmcnt(5)\n\t"
      "v_mfma_f32_32x32x16_bf16 %1, %8, %17, %1\n\t"
      "v_mfma_f32_32x32x16_bf16 %3, %9, %17, %3\n\t"
      "v_mfma_f32_32x32x16_bf16 %5, %10, %17, %5\n\t"
      "v_mfma_f32_32x32x16_bf16 %7, %11, %17, %7\n\t"
      "ds_read_b128 %17, %25 offset:4096\n\t"
      "s_waitcnt lgkmcnt(1)\n\t"
      "v_mfma_f32_32x32x16_bf16 %0, %12, %16, %0\n\t"
      "v_mfma_f32_32x32x16_bf16 %2, %13, %16, %2\n\t"
      "v_mfma_f32_32x32x16_bf16 %4, %14, %16, %4\n\t"
      "v_mfma_f32_32x32x16_bf16 %6, %15, %16, %6\n\t"
      "s_waitcnt lgkmcnt(0)\n\t"
      "v_mfma_f32_32x32x16_bf16 %1, %12, %17, %1\n\t"
      "v_mfma_f32_32x32x16_bf16 %3, %13, %17, %3\n\t"
      "v_mfma_f32_32x32x16_bf16 %5, %14, %17, %5\n\t"
      "v_mfma_f32_32x32x16_bf16 %7, %15, %17, %7\n\t"
      "s_nop 15\n\t"
      "s_nop 7\n\t"
      : "+v"(acc[0][0]), "+v"(acc[0][1]), "+v"(acc[1][0]), "+v"(acc[1][1]), "+v"(acc[2][0]), "+v"(acc[2][1]), "+v"(acc[3][0]), "+v"(acc[3][1]),
        "=&v"(f0), "=&v"(f1), "=&v"(f2), "=&v"(f3), "=&v"(f4), "=&v"(f5), "=&v"(f6), "=&v"(f7), "=&v"(f8), "=&v"(f9)
      : "v"(a0), "v"(a1), "v"(a2), "v"(a3), "v"(b0), "v"(b1), "v"(b2), "v"(b3)
      : "memory");
}

struct NoPre { DI void operator()() const {} };
struct NextTile { const u16* Ap; const u16* Bp; int vlo, vhi; };
template <bool BND, class Epi, class Pre = NoPre>
DI void gemm_tile(const u16* __restrict__ Ap, int lda, int vlo, int vhi, const u16* __restrict__ Bp, int ldb, int K,
                  char* smem, NextTile nx, Epi&& epi, Pre&& pre = Pre()) {
  const int tid = tidx(), lane = tid & 63, wave = tid >> 6;
  const int wm = wave >> 2, wn = wave & 3;
  const int lr = tid >> 3, lc = tid & 7;
  f32x16 acc[4][2];
#pragma unroll
  for (int i = 0; i < 4; ++i)
#pragma unroll
    for (int j = 0; j < 2; ++j)
#pragma unroll
      for (int r = 0; r < 16; ++r) acc[i][j][r] = 0.f;
  u32x4 ra[4], rb[4];
  const unsigned offA = (unsigned)(lr * lda + lc * 8) * 2u, offB = (unsigned)(lr * ldb + lc * 8) * 2u;
  const unsigned strA = (unsigned)lda * 128u, strB = (unsigned)ldb * 128u;
  auto gload = [&](int k0) {
    const char* Ak = (const char*)Ap + (long)k0 * 2;
    const char* Bk = (const char*)Bp + (long)k0 * 2;
#pragma unroll
    for (int i = 0; i < 4; ++i) {
      int row = lr + 64 * i;
      u32x4 z = {0u, 0u, 0u, 0u};
      if (row >= vlo && row < vhi) z = *(const u32x4*)(Ak + (offA + (unsigned)i * strA));
      ra[i] = z;
      rb[i] = *(const u32x4*)(Bk + (offB + (unsigned)i * strB));
    }
  };
  auto sstore = [&](int buf) {
    char* sA = smem + buf * 65536; char* sB = sA + 32768;
#pragma unroll
    for (int i = 0; i < 4; ++i) {
      int row = lr + 64 * i;
      *(u32x4*)(sA + swz128(row, lc)) = ra[i];
      *(u32x4*)(sB + swz128(row, lc)) = rb[i];
    }
  };
  const int nk = K >> 6;
  const int half = wave >> 2;
  const unsigned lds0 = (unsigned)(size_t)smem;
  const unsigned offl = (unsigned)((lane & 31) * 128);
  const unsigned fx = (unsigned)((lane >> 1) & 7), hh = (unsigned)(lane >> 5);
  const unsigned aw = lds0 + (unsigned)(wm * 128 * 128) + offl, bw = lds0 + 32768u + (unsigned)(wn * 64 * 128) + offl;
  const unsigned o0 = ((0u + hh) ^ fx) << 4, o1 = ((2u + hh) ^ fx) << 4, o2 = ((4u + hh) ^ fx) << 4, o3 = ((6u + hh) ^ fx) << 4;
  auto compute = [&](int buf) {
    const unsigned bo = (unsigned)buf * 65536u;
    mma_ktile(acc, aw + bo + o0, aw + bo + o1, aw + bo + o2, aw + bo + o3, bw + bo + o0, bw + bo + o1, bw + bo + o2, bw + bo + o3);
  };
  gload(0); sstore(0);
  if (nk > 1) gload(64);
  __syncthreads();
#pragma unroll 1
  for (int it = 0; it < nk; ++it) {
    if (half == 0) compute(it & 1);
    else { if (it + 1 < nk) sstore((it + 1) & 1); if (it + 2 < nk) gload((it + 2) * 64); }
    __syncthreads();
    if (half == 1) compute(it & 1);
    else { if (it + 1 < nk) sstore((it + 1) & 1); if (it + 2 < nk) gload((it + 2) * 64); }
    __syncthreads();
  }
  float* sC = (float*)smem;
  const int h = lane >> 5;
  unsigned pf0 = 0u;
  if (nx.Ap != nullptr) {
    const int prow_ = tid & 255;
    const bool isb = tid >= 256;
    const char* pp = isb ? (const char*)(nx.Bp + (long)prow_ * ldb) : (const char*)(nx.Ap + (long)prow_ * lda);
    if (isb || (prow_ >= nx.vlo && prow_ < nx.vhi)) {
      asm volatile("global_load_dword %0, %1, off\n\tglobal_load_dword %0, %1, off offset:128" : "=&v"(pf0) : "v"(pp) : "memory");
    }
  }
  pre();
  if (BND) {
    float* bnd = (float*)(smem + BND_OFF);
#pragma unroll
    for (int j = 0; j < 2; ++j) {
      const int col = wn * 64 + j * 32 + (lane & 31);
      if (h == 0) bnd[(2 * wm) * 256 + col] = acc[0][j][0];
      else bnd[(2 * wm + 1) * 256 + col] = acc[3][j][15];
    }
  }
#pragma unroll
  for (int q = 0; q < 2; ++q) {
    if (wm == q) {
#pragma unroll
      for (int i = 0; i < 4; ++i)
#pragma unroll
        for (int j = 0; j < 2; ++j)
#pragma unroll
          for (int r = 0; r < 16; ++r) {
            int rl = i * 32 + (r & 3) + 8 * (r >> 2) + 4 * h;
            int col = wn * 64 + j * 32 + (lane & 31);
            sC[rl * CLD + col] = acc[i][j][r];
          }
    }
    __syncthreads();
    epi(sC, q);
    __syncthreads();
  }
  asm volatile("s_waitcnt vmcnt(0)" :: "v"(pf0) : "memory");
}

DI void epi_store(const float* sC, int q, u16* dst, long ldd, const float* rowscale  , f32x4 cs) {
  const int lane = tidx() & 63, wave = tidx() >> 6;
#pragma unroll
  for (int rr = 0; rr < 16; ++rr) {
    const int lr = wave * 16 + rr, R = q * 128 + lr;
    f32x4 v = *(const f32x4*)(sC + lr * CLD + lane * 4);
    const float rs = rowscale ? rowscale[R] : 1.f;
    v = v * rs * cs;
    *(u32x2*)(dst + R * ldd + lane * 4) = u32x2{pack2(v[0], v[1]), pack2(v[2], v[3])};
  }
}

DI void epi_rope64(const Params& p, const float* sC, int q, u16* dst, long ldd, int tok0, int ropemask, const float* rowscale) {
  const int lane = tidx() & 63, wave = tidx() >> 6;
  const int rsel = lane >> 5, g = (lane >> 3) & 3, j = lane & 7;
  const int c1 = g * 64 + 4 * j, c2 = c1 + 32;
  const int r0 = tok0 % TPB;
  const bool rot = (r0 >= CTXL) && ((ropemask >> g) & 1);
  f32x4 cs[8], sn[8];
  if (rot) {
#pragma unroll
    for (int rr = 0; rr < 8; ++rr) {
      const int pos = r0 - CTXL + q * 128 + wave * 16 + 2 * rr + rsel;
      cs[rr] = *(const f32x4*)(p.rope64 + pos * 32 + 4 * j);
      sn[rr] = *(const f32x4*)(p.rope64 + 65536 + pos * 32 + 4 * j);
    }
  }
#pragma unroll
  for (int rr = 0; rr < 8; ++rr) {
    const int lr = wave * 16 + 2 * rr + rsel, R = q * 128 + lr;
    const float rs = rowscale ? rowscale[R] : 1.f;
    f32x4 x1 = *(const f32x4*)(sC + lr * CLD + c1) * rs, x2 = *(const f32x4*)(sC + lr * CLD + c2) * rs;
    if (rot) {
      const f32x4 a = x1 * cs[rr] - x2 * sn[rr], b = x1 * sn[rr] + x2 * cs[rr];
      x1 = a; x2 = b;
    }
    *(u32x2*)(dst + R * ldd + c1) = u32x2{pack2(x1[0], x1[1]), pack2(x1[2], x1[3])};
    *(u32x2*)(dst + R * ldd + c2) = u32x2{pack2(x2[0], x2[1]), pack2(x2[2], x2[3])};
  }
}

DI void epi_qknorm128(const Params& p, const float* sC, int q, u16* dst, long ldd, int tok0, const float* gvec) {
  const int lane = tidx() & 63, wave = tidx() >> 6;
  const int rsel = lane >> 5, hd = (lane >> 4) & 1, j = lane & 15;
  const int c1 = hd * 128 + 4 * j, c2 = c1 + 64;
  const int r0 = tok0 % TPB;
  const bool lat = r0 >= CTXL;
  const f32x4 g1 = *(const f32x4*)(gvec + 4 * j), g2 = *(const f32x4*)(gvec + 64 + 4 * j);
  f32x4 cs[8], sn[8];
  if (lat) {
#pragma unroll
    for (int rr = 0; rr < 8; ++rr) {
      const int pos = r0 - CTXL + q * 128 + wave * 16 + 2 * rr + rsel;
      cs[rr] = *(const f32x4*)(p.rope128 + pos * 64 + 4 * j);
      sn[rr] = *(const f32x4*)(p.rope128 + 131072 + pos * 64 + 4 * j);
    }
  }
#pragma unroll
  for (int rr = 0; rr < 8; ++rr) {
    const int lr = wave * 16 + 2 * rr + rsel, R = q * 128 + lr;
    f32x4 x1 = *(const f32x4*)(sC + lr * CLD + c1), x2 = *(const f32x4*)(sC + lr * CLD + c2);
    float ss = x1[0] * x1[0] + x1[1] * x1[1] + x1[2] * x1[2] + x1[3] * x1[3] + x2[0] * x2[0] + x2[1] * x2[1] + x2[2] * x2[2] + x2[3] * x2[3];
    ss += __shfl_xor(ss, 1); ss += __shfl_xor(ss, 2); ss += __shfl_xor(ss, 4); ss += __shfl_xor(ss, 8);
    const float rstd = rsqrtf(ss * (1.f / 128.f) + EPS);
    x1 = x1 * rstd * g1; x2 = x2 * rstd * g2;
    if (lat) {
      const f32x4 a = x1 * cs[rr] - x2 * sn[rr], b = x1 * sn[rr] + x2 * cs[rr];
      x1 = a; x2 = b;
    }
    *(u32x2*)(dst + R * ldd + c1) = u32x2{pack2(x1[0], x1[1]), pack2(x1[2], x1[3])};
    *(u32x2*)(dst + R * ldd + c2) = u32x2{pack2(x2[0], x2[1]), pack2(x2[2], x2[3])};
  }
}

DI void resid_load(const float* Rsrc, int q, int col0, f32x4 (&rv)[16]) {
  const int lane = tidx() & 63, wave = tidx() >> 6;
  const float* R = Rsrc + col0 + lane * 4 + (size_t)(q * 128 + wave * 16) * DM;
#pragma unroll
  for (int rr = 0; rr < 16; ++rr) rv[rr] = *(const f32x4*)(R + (size_t)rr * DM);
}
DI void epi_resid(const Params& p, const float* Rsrc, const float* sC, int q, int tok0, int col0, f32x4 g, f32x4 (&rv)[16]) {
  const int lane = tidx() & 63, wave = tidx() >> 6;
  float* R = rrow(p, tok0) + col0 + lane * 4 + (size_t)(q * 128 + wave * 16) * DM;
#pragma unroll
  for (int rr = 0; rr < 16; ++rr) {
    const f32x4 c = *(const f32x4*)(sC + (wave * 16 + rr) * CLD + lane * 4);
    *(f32x4*)(R + (size_t)rr * DM) = rv[rr] + g * c;
  }
  if (q < 1) resid_load(Rsrc, q + 1, col0, rv);
}

struct ConvW { float2 wa0, wa1, wa2, ba, wg0, wg1, wg2, bg; };
DI void conv_load(const Params& p, int layer, int nt, ConvW& w) {
  const int lane = tidx() & 63;
  const int j0 = nt * 128;
  const float* cw = p.conv_w + (size_t)layer * 3 * 5632;
  const float* cb = p.conv_b + (size_t)layer * 5632;
  const int ca = j0 + 2 * lane, cg_ = DFF + j0 + 2 * lane;
  w.wa0 = *(const float2*)(cw + ca); w.wa1 = *(const float2*)(cw + 5632 + ca); w.wa2 = *(const float2*)(cw + 2 * 5632 + ca); w.ba = *(const float2*)(cb + ca);
  w.wg0 = *(const float2*)(cw + cg_); w.wg1 = *(const float2*)(cw + 5632 + cg_); w.wg2 = *(const float2*)(cw + 2 * 5632 + cg_); w.bg = *(const float2*)(cb + cg_);
}
DI void epi_convgate(const Params& p, const float* sC, const float* bnd, int q, int tokbase, int pos0, int L, int seam, int nt, const ConvW& w) {
  const int lane = tidx() & 63, wave = tidx() >> 6;
  const int j0 = nt * 128;
  const float2 wa0 = w.wa0, wa1 = w.wa1, wa2 = w.wa2, ba = w.ba, wg0 = w.wg0, wg1 = w.wg1, wg2 = w.wg2, bg = w.bg;
#pragma unroll 1
  for (int hb = 0; hb < 2; ++hb) {
    const int lr0 = wave * 16 + hb * 8;
    float2 va[10], vg[10];
#pragma unroll
    for (int k = 0; k < 10; ++k) {
      const int lrk = lr0 - 1 + k;
      const float* rowp = lrk < 0 ? bnd + (2 * q - 1) * 256 : (lrk > 127 ? bnd + (2 * q + 2) * 256 : sC + lrk * CLD);
      va[k] = *(const float2*)(rowp + 2 * lane); vg[k] = *(const float2*)(rowp + 128 + 2 * lane);
    }
#pragma unroll
    for (int k = 0; k < 8; ++k) {
      const int R = q * 128 + lr0 + k;
      const int pos = pos0 + R;
      if (R == 0 || R == 255 || pos >= L) continue;
      f32x2 pa = {va[k].x, va[k].y}, pg = {vg[k].x, vg[k].y}, na = {va[k + 2].x, va[k + 2].y}, ng = {vg[k + 2].x, vg[k + 2].y};
      const f32x2 ca2 = {va[k + 1].x, va[k + 1].y}, cg2 = {vg[k + 1].x, vg[k + 1].y};
      if (pos == seam) { pa = f32x2{0.f, 0.f}; pg = f32x2{0.f, 0.f}; }
      if (pos + 1 == seam) { na = f32x2{0.f, 0.f}; ng = f32x2{0.f, 0.f}; }
      const f32x2 ya = f32x2{ba.x, ba.y} + f32x2{wa0.x, wa0.y} * pa + f32x2{wa1.x, wa1.y} * ca2 + f32x2{wa2.x, wa2.y} * na;
      const f32x2 yg = f32x2{bg.x, bg.y} + f32x2{wg0.x, wg0.y} * pg + f32x2{wg1.x, wg1.y} * cg2 + f32x2{wg2.x, wg2.y} * ng;
      const float ya0 = ya[0], ya1 = ya[1], yg0 = yg[0], yg1 = yg[1];
      *(unsigned*)(p.G + (size_t)(tokbase + pos) * DFF + j0 + 2 * lane) = pack2(siluf(ya0) * yg0, siluf(ya1) * yg1);
    }
  }
}

DI void tile_rstd(const Params& p, int tok0, int c0, int len, float* rs) {
  const int tid = tidx();
  const int row = tid >> 1, part = tid & 1;
  const u16* tp = p.T1 + (size_t)(tok0 + row) * 768 + c0 + part * (len >> 1);
  float ss = 0;
#pragma unroll 8
  for (int c = 0; c < (len >> 4); ++c) {
    u32x4 v = *(const u32x4*)(tp + c * 8);
#pragma unroll
    for (int j = 0; j < 4; ++j) { float a = bflo(v[j]), b = bfhi(v[j]); ss += a * a + b * b; }
  }
  ss += __shfl_xor(ss, 1);
  if (!part) rs[row] = rsqrtf(ss / (float)len + EPS);
}

DI bool xcd_tile(int round, int Mx, int NT, int GM, int& mt, int& nt) {
  const int xcd = blockIdx.x & 7, slot = blockIdx.x >> 3;
  int per = gridDim.x >> 3;
  const int j = round * per + slot;
  if (slot >= per || j >= Mx * NT) return false;
  int gsz = __builtin_amdgcn_readfirstlane(GM * NT);
  asm volatile("" : "+s"(gsz));
  const int g = j / gsz, w = j - g * gsz;
  int gm = Mx - g * GM; if (gm > GM) gm = GM;
  gm = __builtin_amdgcn_readfirstlane(gm);
  asm volatile("" : "+s"(gm));
  const int q = w / gm;
  mt = xcd * Mx + g * GM + (w - q * gm); nt = q;
  return true;
}

DI bool xcd_tile_j(int j, int ntot, int Mx, int NT, int& mt, int& nt) {
  if (j >= ntot) return false;
  const int xcd = blockIdx.x & 7;
  int mx = __builtin_amdgcn_readfirstlane(Mx);
  asm volatile("" : "+s"(mx));
  const int q = j / mx;
  mt = xcd * Mx + (j - q * mx); nt = q;
  (void)NT;
  return true;
}

DI void qkv_phase(const Params& p, int kind, char* smem) {
  const u16* W = kind == 0 ? p.Wa_qkv : kind == 1 ? p.Wb_qkv : p.Wd_qkv;
  const int nqk = kind == 0 ? 2048 : kind == 1 ? 1280 : 1536;
  const int dvt = kind == 0 ? 1024 : kind == 1 ? 256 : 512;
  const int ntq = nqk >> 8, ntv = dvt >> 8;
  const int slot = blockIdx.x >> 3, per = gridDim.x >> 3;
  if (slot >= per) return;
  const int n1 = 9 * ntq, ntot = n1 + 9 * ntv;
  auto desc = [&](int j, const u16*& Ap, const u16*& Bp, int& tok0, int& c0, bool& isv) {
    int mt, nt;
    isv = j >= n1;
    xcd_tile_j(isv ? j - n1 : j, 1 << 30, 9, 0, mt, nt);
    tok0 = mt * 256; c0 = nt * 256;
    const u16* Hp = p.H + (size_t)tok0 * DM;
    const u16* Wp = W + (size_t)((isv ? nqk : 0) + c0) * DM;
    Ap = isv ? Wp : Hp; Bp = isv ? Hp : Wp;
  };
#pragma unroll 1
  for (int j = slot; j < ntot; j += per) {
    const u16 *Ap, *Bp; int tok0, c0; bool isv;
    desc(j, Ap, Bp, tok0, c0, isv);
    NextTile nx; nx.Ap = nullptr; nx.Bp = nullptr; nx.vlo = 0; nx.vhi = 256;
    if (j + per < ntot) { int t2, c2; bool v2; desc(j + per, nx.Ap, nx.Bp, t2, c2, v2); }
    gemm_tile<false>(Ap, DM, 0, 256, Bp, DM, DM, smem, nx, [&](const float* sC, int q) {
      if (isv) epi_store(sC, q, p.Vt + (size_t)c0 * T + tok0, T, nullptr, f32x4{1.f, 1.f, 1.f, 1.f});
      else if (kind == 3) epi_qknorm128(p, sC, q, p.QK + (size_t)tok0 * nqk + c0, nqk, tok0, c0 < 1024 ? p.d_qg : p.d_kg);
      else epi_rope64(p, sC, q, p.QK + (size_t)tok0 * nqk + c0, nqk, tok0, 15, nullptr);
    });
  }
}

DI void mla_down_phase(const Params& p, char* smem) {
  int mt, nt;
#pragma unroll 1
  for (int r = 0; xcd_tile(r, 9, 3, 9, mt, nt); ++r) {
    int tok0 = mt * 256, col0 = nt * 256;
    NextTile nx; nx.Ap = nullptr; nx.Bp = nullptr; nx.vlo = 0; nx.vhi = 0;
    gemm_tile<false>(p.H + (size_t)tok0 * DM, DM, 0, 256, p.Wc_d + (size_t)col0 * DM, DM, DM, smem, nx, [&](const float* sC, int q) {
      epi_store(sC, q, p.T1 + (size_t)tok0 * 768 + col0, 768, nullptr, f32x4{1.f, 1.f, 1.f, 1.f});
    });
  }
}

DI void mla_up_phase(const Params& p, char* smem) {
  float* rs = (float*)(smem + RS_OFF);
  u16* Qb = p.QK; u16* Kb = p.QK + (size_t)T * 1536;
  const int slot = blockIdx.x >> 3, per = gridDim.x >> 3;
#pragma unroll 1
  for (int j = slot; j < 126 && slot < per; j += per) {
    int mt, nt;
    const int ty = j < 54 ? 0 : j < 90 ? 1 : 2;
    xcd_tile_j(j - (ty == 0 ? 0 : ty == 1 ? 54 : 90), 1 << 30, 9, 0, mt, nt);
    const int tok0 = mt * 256, c0 = nt * 256;
    const int K = ty == 0 ? 384 : 256;
    const u16* Tp = p.T1 + (size_t)tok0 * 768 + (ty == 0 ? 0 : 384);
    const u16* Wp = (ty == 0 ? p.Wc_uq : ty == 1 ? p.Wc_uk : p.Wc_uv) + (size_t)c0 * K;
    NextTile nx; nx.Ap = nullptr; nx.Bp = nullptr; nx.vlo = 0; nx.vhi = 0;
    gemm_tile<false>(ty == 2 ? Wp : Tp, ty == 2 ? K : 768, 0, 256, ty == 2 ? Tp : Wp, ty == 2 ? 768 : K, K, smem, nx, [&](const float* sC, int q) {
      if (q == 0) { tile_rstd(p, tok0, ty == 0 ? 0 : 384, K, rs); __syncthreads(); }
      if (ty == 0) {
        int mask = 0;
#pragma unroll
        for (int g = 0; g < 4; ++g) if (((c0 + 64 * g) % 192) == 128) mask |= 1 << g;
        epi_rope64(p, sC, q, Qb + (size_t)tok0 * 1536 + c0, 1536, tok0, mask, rs);
      } else if (ty == 1) {
        epi_store(sC, q, Kb + (size_t)tok0 * 1024 + c0, 1024, rs, f32x4{1.f, 1.f, 1.f, 1.f});
      } else {
        const int lane = tidx() & 63;
        epi_store(sC, q, p.Vt + (size_t)c0 * T + tok0, T, nullptr, *(const f32x4*)(rs + lane * 4));
      }
    });
  }
#pragma unroll 1
  for (int mt2 = blockIdx.x; mt2 < 72; mt2 += gridDim.x) {
    int tok0 = mt2 * 256;
    const bool lat = (tok0 % TPB) >= CTXL;
    for (int e = tidx(); e < 8192; e += NTHR) {
      int row = e >> 5, i = e & 31;
      const u16* tp = p.T1 + (size_t)(tok0 + row) * 768 + 640;
      float x1 = bf2f(tp[i]), x2 = bf2f(tp[i + 32]);
      if (lat) {
        int pos = (tok0 % TPB) - CTXL + row;
        float cs = p.rope64[pos * 32 + i], sn = p.rope64[65536 + pos * 32 + i];
        float y1 = x1 * cs - x2 * sn, y2 = x1 * sn + x2 * cs;
        x1 = y1; x2 = y2;
      }
      p.KR[(size_t)(tok0 + row) * 64 + i] = f2bf(x1);
      p.KR[(size_t)(tok0 + row) * 64 + i + 32] = f2bf(x2);
    }
  }
}

DI int tile_token(int mt, bool lat_only) {
  if (!lat_only) return mt * 256;
  int b = mt >> 3; return b * TPB + CTXL + (mt & 7) * 256;
}

DI void resid_gemm_phase(const Params& p, int layer, const u16* A, int lda, int K, const u16* W, int chunk, bool lat_only, char* smem, float gs) {
  const int Mx = lat_only ? 8 : 9;
  int mt, nt; bool has = xcd_tile(0, Mx, 4, 3, mt, nt);
#pragma unroll 1
  for (int r = 0; has; ++r) {
    int mt2, nt2; const bool has2 = xcd_tile(r + 1, Mx, 4, 3, mt2, nt2);
    const int tok0 = tile_token(mt, lat_only), col0 = nt * 256;
    NextTile nx; nx.Ap = has2 ? A + (size_t)tile_token(mt2, lat_only) * lda : nullptr; nx.Bp = W + (size_t)nt2 * 256 * K; nx.vlo = 0; nx.vhi = 256;
    const float* gate = p.MOD + ((size_t)layer * 9 + modrow(tok0)) * 6144 + chunk * 1024;
    f32x4 rv[16]; f32x4 gv;
    const float* Rsrc = (layer == 0 && chunk == 2) ? xrow(p, tok0) : (const float*)rrow(p, tok0);
    gemm_tile<false>(A + (size_t)tok0 * lda, lda, 0, 256, W + (size_t)col0 * K, K, K, smem, nx, [&](const float* sC, int q) {
      epi_resid(p, Rsrc, sC, q, tok0, col0, gv, rv);
    }, [&]() { gv = *(const f32x4*)(gate + col0 + (tidx() & 63) * 4) * gs; resid_load(Rsrc, 0, col0, rv); });
    mt = mt2; nt = nt2; has = has2;
    if (!has2 && r == 0 && chunk == 2 && layer < 3) {
      const int per = gridDim.x >> 3, slot = blockIdx.x >> 3, xcd = blockIdx.x & 7;
      const int nbusy = Mx * 4 - per;
      const int me = (slot - nbusy) * 8 + xcd;
      const int nidle = (per - nbusy) * 8;
      if (nbusy >= 0 && nbusy < per && me >= 0) {
#pragma unroll 1
        for (int i = me; i < 48; i += nidle) mod_item2(p, (layer + 1) * 96 + 2 * i + (tidx() >> 8), true, smem);
      }
    }
    if (!has2 && r == 0 && chunk == 5 && layer < 3) {
      const int per = gridDim.x >> 3, slot = blockIdx.x >> 3, xcd = blockIdx.x & 7;
      const int nbusy = Mx * 4 - per;
      const int nidle = (per - nbusy) * 8;
      const int me = (slot - nbusy) * 8 + xcd;
      const int t0 = p.ltile[layer + 1], t1 = p.ltile[layer + 2];
      if (nbusy >= 0 && nbusy < per && me >= 0) {
#pragma unroll 1
        for (int i = me; t0 + 4 * i < t1; i += nidle) convert_tiles(p, t0 + 4 * i, t1, smem);
      }
    }
  }
}

DI void ffn_up_phase(const Params& p, int layer, bool lat_only, char* smem) {
  const int tpb = lat_only ? 9 : 10;
  const int L = lat_only ? SEQ : TPB;
  const int seam = lat_only ? -1 : CTXL;
  const float* bnd = (const float*)(smem + BND_OFF);
  int mt, nt; bool has = xcd_tile(0, tpb, 22, 5, mt, nt);
#pragma unroll 1
  for (int r = 0; has; ++r) {
    int mt2, nt2; const bool has2 = xcd_tile(r + 1, tpb, 22, 5, mt2, nt2);
    const int b = mt / tpb, ti = mt - b * tpb;
    const int tokbase = b * TPB + (lat_only ? CTXL : 0);
    const int pos0 = ti * 254 - 1;
    const int vlo = (ti == 0) ? 1 : 0;
    int vhi = L - pos0; if (vhi > 256) vhi = 256;
    NextTile nx; nx.Ap = nullptr; nx.Bp = nullptr; nx.vlo = 0; nx.vhi = 0;
    if (has2) {
      const int b2 = mt2 / tpb, ti2 = mt2 - b2 * tpb;
      const int pos02 = ti2 * 254 - 1;
      nx.Ap = p.H + ((long)(b2 * TPB + (lat_only ? CTXL : 0)) + pos02) * DM; nx.Bp = p.Wup[layer] + (size_t)nt2 * 256 * DM;
      nx.vlo = (ti2 == 0) ? 1 : 0; nx.vhi = L - pos02; if (nx.vhi > 256) nx.vhi = 256;
    }
    ConvW cwv;
    gemm_tile<true>(p.H + ((long)tokbase + pos0) * DM, DM, vlo, vhi, p.Wup[layer] + (size_t)nt * 256 * DM, DM, DM, smem, nx, [&](const float* sC, int q) {
      epi_convgate(p, sC, bnd, q, tokbase, pos0, L, seam, nt, cwv);
    }, [&]() { conv_load(p, layer, nt, cwv); });
    mt = mt2; nt = nt2; has = has2;
  }
}

template <int RB> DI int kswz(int row, int ch) {
  if (RB == 256) return row * RB + ((ch ^ (row & 15)) << 4);
  return row * RB + ((((ch & 7) ^ ((row >> 1) & 7)) | (ch & ~7)) << 4);
}
DI bf16x8 pack8(float a0, float a1, float a2, float a3, float a4, float a5, float a6, float a7) {
  u32x4 w = {pack2(a0, a1), pack2(a2, a3), pack2(a4, a5), pack2(a6, a7)};
  return __builtin_bit_cast(bf16x8, w);
}

DI void qk_asm_a(f32x16 (&s)[2], const bf16x8 (&q)[4], const unsigned (&a)[4]) {
  u32x4 t0, t1, t2, t3, t4, t5;
  asm volatile(
      "ds_read_b128 %2, %12 offset:0\n\t"
      "ds_read_b128 %3, %12 offset:8192\n\t"
      "ds_read_b128 %4, %13 offset:0\n\t"
      "ds_read_b128 %5, %13 offset:8192\n\t"
      "ds_read_b128 %6, %14 offset:0\n\t"
      "ds_read_b128 %7, %14 offset:8192\n\t"
      "s_waitcnt lgkmcnt(5)\n\t"
      "v_mfma_f32_32x32x16_bf16 %0, %2, %8, %0\n\t"
      "ds_read_b128 %2, %15 offset:0\n\t"
      "s_waitcnt lgkmcnt(5)\n\t"
      "v_mfma_f32_32x32x16_bf16 %1, %3, %8, %1\n\t"
      "ds_read_b128 %3, %15 offset:8192\n\t"
      "s_waitcnt lgkmcnt(5)\n\t"
      "v_mfma_f32_32x32x16_bf16 %0, %4, %9, %0\n\t"
      "s_waitcnt lgkmcnt(4)\n\t"
      "v_mfma_f32_32x32x16_bf16 %1, %5, %9, %1\n\t"
      "s_waitcnt lgkmcnt(3)\n\t"
      "v_mfma_f32_32x32x16_bf16 %0, %6, %10, %0\n\t"
      "s_waitcnt lgkmcnt(2)\n\t"
      "v_mfma_f32_32x32x16_bf16 %1, %7, %10, %1\n\t"
      "s_waitcnt lgkmcnt(1)\n\t"
      "v_mfma_f32_32x32x16_bf16 %0, %2, %11, %0\n\t"
      "s_waitcnt lgkmcnt(0)\n\t"
      "v_mfma_f32_32x32x16_bf16 %1, %3, %11, %1\n\t"
      "s_nop 15\n\t"
      "s_nop 3\n\t"
      : "+v"(s[0]), "+v"(s[1]), "=&v"(t0), "=&v"(t1), "=&v"(t2), "=&v"(t3), "=&v"(t4), "=&v"(t5)
      : "v"(q[0]), "v"(q[1]), "v"(q[2]), "v"(q[3]), "v"(a[0]), "v"(a[1]), "v"(a[2]), "v"(a[3])
      : "memory");
}
DI void qk_asm_b(f32x16 (&s)[2], const bf16x8 (&q)[4], const unsigned (&a)[4]) {
  u32x4 t0, t1, t2, t3, t4, t5;
  asm volatile(
      "ds_read_b128 %2, %12 offset:0\n\t"
      "ds_read_b128 %3, %12 offset:4096\n\t"
      "ds_read_b128 %4, %13 offset:0\n\t"
      "ds_read_b128 %5, %13 offset:4096\n\t"
      "ds_read_b128 %6, %14 offset:0\n\t"
      "ds_read_b128 %7, %14 offset:4096\n\t"
      "s_waitcnt lgkmcnt(5)\n\t"
      "v_mfma_f32_32x32x16_bf16 %0, %2, %8, %0\n\t"
      "ds_read_b128 %2, %15 offset:0\n\t"
      "s_waitcnt lgkmcnt(5)\n\t"
      "v_mfma_f32_32x32x16_bf16 %1, %3, %8, %1\n\t"
      "ds_read_b128 %3, %15 offset:4096\n\t"
      "s_waitcnt lgkmcnt(5)\n\t"
      "v_mfma_f32_32x32x16_bf16 %0, %4, %9, %0\n\t"
      "s_waitcnt lgkmcnt(4)\n\t"
      "v_mfma_f32_32x32x16_bf16 %1, %5, %9, %1\n\t"
      "s_waitcnt lgkmcnt(3)\n\t"
      "v_mfma_f32_32x32x16_bf16 %0, %6, %10, %0\n\t"
      "s_waitcnt lgkmcnt(2)\n\t"
      "v_mfma_f32_32x32x16_bf16 %1, %7, %10, %1\n\t"
      "s_waitcnt lgkmcnt(1)\n\t"
      "v_mfma_f32_32x32x16_bf16 %0, %2, %11, %0\n\t"
      "s_waitcnt lgkmcnt(0)\n\t"
      "v_mfma_f32_32x32x16_bf16 %1, %3, %11, %1\n\t"
      "s_nop 15\n\t"
      "s_nop 3\n\t"
      : "+v"(s[0]), "+v"(s[1]), "=&v"(t0), "=&v"(t1), "=&v"(t2), "=&v"(t3), "=&v"(t4), "=&v"(t5)
      : "v"(q[0]), "v"(q[1]), "v"(q[2]), "v"(q[3]), "v"(a[0]), "v"(a[1]), "v"(a[2]), "v"(a[3])
      : "memory");
}
DI void qk_asm_c(f32x16 (&s)[1], const bf16x8 (&q)[12], const unsigned (&a)[4]) {
  u32x4 t0, t1, t2, t3, t4, t5;
  asm volatile(
      "ds_read_b128 %1, %19 offset:0\n\t"
      "ds_read_b128 %2, %20 offset:0\n\t"
      "ds_read_b128 %3, %21 offset:0\n\t"
      "ds_read_b128 %4, %22 offset:0\n\t"
      "ds_read_b128 %5, %19 offset:128\n\t"
      "ds_read_b128 %6, %20 offset:128\n\t"
      "s_waitcnt lgkmcnt(5)\n\t"
      "v_mfma_f32_32x32x16_bf16 %0, %1, %7, %0\n\t"
      "ds_read_b128 %1, %21 offset:128\n\t"
      "s_waitcnt lgkmcnt(5)\n\t"
      "v_mfma_f32_32x32x16_bf16 %0, %2, %8, %0\n\t"
      "ds_read_b128 %2, %22 offset:128\n\t"
      "s_waitcnt lgkmcnt(5)\n\t"
      "v_mfma_f32_32x32x16_bf16 %0, %3, %9, %0\n\t"
      "ds_read_b128 %3, %19 offset:256\n\t"
      "s_waitcnt lgkmcnt(5)\n\t"
      "v_mfma_f32_32x32x16_bf16 %0, %4, %10, %0\n\t"
      "ds_read_b128 %4, %20 offset:256\n\t"
      "s_waitcnt lgkmcnt(5)\n\t"
      "v_mfma_f32_32x32x16_bf16 %0, %5, %11, %0\n\t"
      "ds_read_b128 %5, %21 offset:256\n\t"
      "s_waitcnt lgkmcnt(5)\n\t"
      "v_mfma_f32_32x32x16_bf16 %0, %6, %12, %0\n\t"
      "ds_read_b128 %6, %22 offset:256\n\t"
      "s_waitcnt lgkmcnt(5)\n\t"
      "v_mfma_f32_32x32x16_bf16 %0, %1, %13, %0\n\t"
      "s_waitcnt lgkmcnt(4)\n\t"
      "v_mfma_f32_32x32x16_bf16 %0, %2, %14, %0\n\t"
      "s_waitcnt lgkmcnt(3)\n\t"
      "v_mfma_f32_32x32x16_bf16 %0, %3, %15, %0\n\t"
      "s_waitcnt lgkmcnt(2)\n\t"
      "v_mfma_f32_32x32x16_bf16 %0, %4, %16, %0\n\t"
      "s_waitcnt lgkmcnt(1)\n\t"
      "v_mfma_f32_32x32x16_bf16 %0, %5, %17, %0\n\t"
      "s_waitcnt lgkmcnt(0)\n\t"
      "v_mfma_f32_32x32x16_bf16 %0, %6, %18, %0\n\t"
      "s_nop 15\n\t"
      "s_nop 3\n\t"
      : "+v"(s[0]), "=&v"(t0), "=&v"(t1), "=&v"(t2), "=&v"(t3), "=&v"(t4), "=&v"(t5)
      : "v"(q[0]), "v"(q[1]), "v"(q[2]), "v"(q[3]), "v"(q[4]), "v"(q[5]), "v"(q[6]), "v"(q[7]), "v"(q[8]), "v"(q[9]), "v"(q[10]), "v"(q[11]), "v"(a[0]), "v"(a[1]), "v"(a[2]), "v"(a[3])
      : "memory");
}
DI void qk_asm_d(f32x16 (&s)[2], const bf16x8 (&q)[8], const unsigned (&a)[8]) {
  u32x4 t0, t1, t2, t3, t4, t5;
  asm volatile(
      "ds_read_b128 %2, %16 offset:0\n\t"
      "ds_read_b128 %3, %16 offset:8192\n\t"
      "ds_read_b128 %4, %17 offset:0\n\t"
      "ds_read_b128 %5, %17 offset:8192\n\t"
      "ds_read_b128 %6, %18 offset:0\n\t"
      "ds_read_b128 %7, %18 offset:8192\n\t"
      "s_waitcnt lgkmcnt(5)\n\t"
      "v_mfma_f32_32x32x16_bf16 %0, %2, %8, %0\n\t"
      "ds_read_b128 %2, %19 offset:0\n\t"
      "s_waitcnt lgkmcnt(5)\n\t"
      "v_mfma_f32_32x32x16_bf16 %1, %3, %8, %1\n\t"
      "ds_read_b128 %3, %19 offset:8192\n\t"
      "s_waitcnt lgkmcnt(5)\n\t"
      "v_mfma_f32_32x32x16_bf16 %0, %4, %9, %0\n\t"
      "ds_read_b128 %4, %20 offset:0\n\t"
      "s_waitcnt lgkmcnt(5)\n\t"
      "v_mfma_f32_32x32x16_bf16 %1, %5, %9, %1\n\t"
      "ds_read_b128 %5, %20 offset:8192\n\t"
      "s_waitcnt lgkmcnt(5)\n\t"
      "v_mfma_f32_32x32x16_bf16 %0, %6, %10, %0\n\t"
      "ds_read_b128 %6, %21 offset:0\n\t"
      "s_waitcnt lgkmcnt(5)\n\t"
      "v_mfma_f32_32x32x16_bf16 %1, %7, %10, %1\n\t"
      "ds_read_b128 %7, %21 offset:8192\n\t"
      "s_waitcnt lgkmcnt(5)\n\t"
      "v_mfma_f32_32x32x16_bf16 %0, %2, %11, %0\n\t"
      "ds_read_b128 %2, %22 offset:0\n\t"
      "s_waitcnt lgkmcnt(5)\n\t"
      "v_mfma_f32_32x32x16_bf16 %1, %3, %11, %1\n\t"
      "ds_read_b128 %3, %22 offset:8192\n\t"
      "s_waitcnt lgkmcnt(5)\n\t"
      "v_mfma_f32_32x32x16_bf16 %0, %4, %12, %0\n\t"
      "ds_read_b128 %4, %23 offset:0\n\t"
      "s_waitcnt lgkmcnt(5)\n\t"
      "v_mfma_f32_32x32x16_bf16 %1, %5, %12, %1\n\t"
      "ds_read_b128 %5, %23 offset:8192\n\t"
      "s_waitcnt lgkmcnt(5)\n\t"
      "v_mfma_f32_32x32x16_bf16 %0, %6, %13, %0\n\t"
      "s_waitcnt lgkmcnt(4)\n\t"
      "v_mfma_f32_32x32x16_bf16 %1, %7, %13, %1\n\t"
      "s_waitcnt lgkmcnt(3)\n\t"
      "v_mfma_f32_32x32x16_bf16 %0, %2, %14, %0\n\t"
      "s_waitcnt lgkmcnt(2)\n\t"
      "v_mfma_f32_32x32x16_bf16 %1, %3, %14, %1\n\t"
      "s_waitcnt lgkmcnt(1)\n\t"
      "v_mfma_f32_32x32x16_bf16 %0, %4, %15, %0\n\t"
      "s_waitcnt lgkmcnt(0)\n\t"
      "v_mfma_f32_32x32x16_bf16 %1, %5, %15, %1\n\t"
      "s_nop 15\n\t"
      "s_nop 3\n\t"
      : "+v"(s[0]), "+v"(s[1]), "=&v"(t0), "=&v"(t1), "=&v"(t2), "=&v"(t3), "=&v"(t4), "=&v"(t5)
      : "v"(q[0]), "v"(q[1]), "v"(q[2]), "v"(q[3]), "v"(q[4]), "v"(q[5]), "v"(q[6]), "v"(q[7]), "v"(a[0]), "v"(a[1]), "v"(a[2]), "v"(a[3]), "v"(a[4]), "v"(a[5]), "v"(a[6]), "v"(a[7])
      : "memory");
}
DI void pv_asm_42(f32x16 (&o)[4], const bf16x8 (&pb)[2][2], const unsigned (&a)[4]) {
  u32x4 t0, t1, t2, t3, t4, t5;
  asm volatile(
      "ds_read_b128 %4, %14 offset:0\n\t"
      "ds_read_b128 %5, %14 offset:4096\n\t"
      "ds_read_b128 %6, %14 offset:8192\n\t"
      "ds_read_b128 %7, %14 offset:12288\n\t"
      "ds_read_b128 %8, %15 offset:0\n\t"
      "ds_read_b128 %9, %15 offset:4096\n\t"
      "s_waitcnt lgkmcnt(5)\n\t"
      "v_mfma_f32_32x32x16_bf16 %0, %4, %10, %0\n\t"
      "ds_read_b128 %4, %15 offset:8192\n\t"
      "s_waitcnt lgkmcnt(5)\n\t"
      "v_mfma_f32_32x32x16_bf16 %1, %5, %10, %1\n\t"
      "ds_read_b128 %5, %15 offset:12288\n\t"
      "s_waitcnt lgkmcnt(5)\n\t"
      "v_mfma_f32_32x32x16_bf16 %2, %6, %10, %2\n\t"
      "ds_read_b128 %6, %16 offset:0\n\t"
      "s_waitcnt lgkmcnt(5)\n\t"
      "v_mfma_f32_32x32x16_bf16 %3, %7, %10, %3\n\t"
      "ds_read_b128 %7, %16 offset:4096\n\t"
      "s_waitcnt lgkmcnt(5)\n\t"
      "v_mfma_f32_32x32x16_bf16 %0, %8, %11, %0\n\t"
      "ds_read_b128 %8, %16 offset:8192\n\t"
      "s_waitcnt lgkmcnt(5)\n\t"
      "v_mfma_f32_32x32x16_bf16 %1, %9, %11, %1\n\t"
      "ds_read_b128 %9, %16 offset:12288\n\t"
      "s_waitcnt lgkmcnt(5)\n\t"
      "v_mfma_f32_32x32x16_bf16 %2, %4, %11, %2\n\t"
      "ds_read_b128 %4, %17 offset:0\n\t"
      "s_waitcnt lgkmcnt(5)\n\t"
      "v_mfma_f32_32x32x16_bf16 %3, %5, %11, %3\n\t"
      "ds_read_b128 %5, %17 offset:4096\n\t"
      "s_waitcnt lgkmcnt(5)\n\t"
      "v_mfma_f32_32x32x16_bf16 %0, %6, %12, %0\n\t"
      "ds_read_b128 %6, %17 offset:8192\n\t"
      "s_waitcnt lgkmcnt(5)\n\t"
      "v_mfma_f32_32x32x16_bf16 %1, %7, %12, %1\n\t"
      "ds_read_b128 %7, %17 offset:12288\n\t"
      "s_waitcnt lgkmcnt(5)\n\t"
      "v_mfma_f32_32x32x16_bf16 %2, %8, %12, %2\n\t"
      "s_waitcnt lgkmcnt(4)\n\t"
      "v_mfma_f32_32x32x16_bf16 %3, %9, %12, %3\n\t"
      "s_waitcnt lgkmcnt(3)\n\t"
      "v_mfma_f32_32x32x16_bf16 %0, %4, %13, %0\n\t"
      "s_waitcnt lgkmcnt(2)\n\t"
      "v_mfma_f32_32x32x16_bf16 %1, %5, %13, %1\n\t"
      "s_waitcnt lgkmcnt(1)\n\t"
      "v_mfma_f32_32x32x16_bf16 %2, %6, %13, %2\n\t"
      "s_waitcnt lgkmcnt(0)\n\t"
      "v_mfma_f32_32x32x16_bf16 %3, %7, %13, %3\n\t"
      "s_nop 15\n\t"
      "s_nop 3\n\t"
      : "+v"(o[0]), "+v"(o[1]), "+v"(o[2]), "+v"(o[3]), "=&v"(t0), "=&v"(t1), "=&v"(t2), "=&v"(t3), "=&v"(t4), "=&v"(t5)
      : "v"(pb[0][0]), "v"(pb[0][1]), "v"(pb[1][0]), "v"(pb[1][1]), "v"(a[0]), "v"(a[1]), "v"(a[2]), "v"(a[3])
      : "memory");
}
DI void pv_asm_22(f32x16 (&o)[2], const bf16x8 (&pb)[2][2], const unsigned (&a)[4]) {
  u32x4 t0, t1, t2, t3, t4, t5;
  asm volatile(
      "ds_read_b128 %2, %12 offset:0\n\t"
      "ds_read_b128 %3, %12 offset:4096\n\t"
      "ds_read_b128 %4, %13 offset:0\n\t"
      "ds_read_b128 %5, %13 offset:4096\n\t"
      "ds_read_b128 %6, %14 offset:0\n\t"
      "ds_read_b128 %7, %14 offset:4096\n\t"
      "s_waitcnt lgkmcnt(5)\n\t"
      "v_mfma_f32_32x32x16_bf16 %0, %2, %8, %0\n\t"
      "ds_read_b128 %2, %15 offset:0\n\t"
      "s_waitcnt lgkmcnt(5)\n\t"
      "v_mfma_f32_32x32x16_bf16 %1, %3, %8, %1\n\t"
      "ds_read_b128 %3, %15 offset:4096\n\t"
      "s_waitcnt lgkmcnt(5)\n\t"
      "v_mfma_f32_32x32x16_bf16 %0, %4, %9, %0\n\t"
      "s_waitcnt lgkmcnt(4)\n\t"
      "v_mfma_f32_32x32x16_bf16 %1, %5, %9, %1\n\t"
      "s_waitcnt lgkmcnt(3)\n\t"
      "v_mfma_f32_32x32x16_bf16 %0, %6, %10, %0\n\t"
      "s_waitcnt lgkmcnt(2)\n\t"
      "v_mfma_f32_32x32x16_bf16 %1, %7, %10, %1\n\t"
      "s_waitcnt lgkmcnt(1)\n\t"
      "v_mfma_f32_32x32x16_bf16 %0, %2, %11, %0\n\t"
      "s_waitcnt lgkmcnt(0)\n\t"
      "v_mfma_f32_32x32x16_bf16 %1, %3, %11, %1\n\t"
      "s_nop 15\n\t"
      "s_nop 3\n\t"
      : "+v"(o[0]), "+v"(o[1]), "=&v"(t0), "=&v"(t1), "=&v"(t2), "=&v"(t3), "=&v"(t4), "=&v"(t5)
      : "v"(pb[0][0]), "v"(pb[0][1]), "v"(pb[1][0]), "v"(pb[1][1]), "v"(a[0]), "v"(a[1]), "v"(a[2]), "v"(a[3])
      : "memory");
}
DI void pv_asm_41(f32x16 (&o)[4], const bf16x8 (&pb)[1][2], const unsigned (&a)[2]) {
  u32x4 t0, t1, t2, t3, t4, t5;
  asm volatile(
      "ds_read_b128 %4, %12 offset:0\n\t"
      "ds_read_b128 %5, %12 offset:4096\n\t"
      "ds_read_b128 %6, %12 offset:8192\n\t"
      "ds_read_b128 %7, %12 offset:12288\n\t"
      "ds_read_b128 %8, %13 offset:0\n\t"
      "ds_read_b128 %9, %13 offset:4096\n\t"
      "s_waitcnt lgkmcnt(5)\n\t"
      "v_mfma_f32_32x32x16_bf16 %0, %4, %10, %0\n\t"
      "ds_read_b128 %4, %13 offset:8192\n\t"
      "s_waitcnt lgkmcnt(5)\n\t"
      "v_mfma_f32_32x32x16_bf16 %1, %5, %10, %1\n\t"
      "ds_read_b128 %5, %13 offset:12288\n\t"
      "s_waitcnt lgkmcnt(5)\n\t"
      "v_mfma_f32_32x32x16_bf16 %2, %6, %10, %2\n\t"
      "s_waitcnt lgkmcnt(4)\n\t"
      "v_mfma_f32_32x32x16_bf16 %3, %7, %10, %3\n\t"
      "s_waitcnt lgkmcnt(3)\n\t"
      "v_mfma_f32_32x32x16_bf16 %0, %8, %11, %0\n\t"
      "s_waitcnt lgkmcnt(2)\n\t"
      "v_mfma_f32_32x32x16_bf16 %1, %9, %11, %1\n\t"
      "s_waitcnt lgkmcnt(1)\n\t"
      "v_mfma_f32_32x32x16_bf16 %2, %4, %11, %2\n\t"
      "s_waitcnt lgkmcnt(0)\n\t"
      "v_mfma_f32_32x32x16_bf16 %3, %5, %11, %3\n\t"
      "s_nop 15\n\t"
      "s_nop 3\n\t"
      : "+v"(o[0]), "+v"(o[1]), "+v"(o[2]), "+v"(o[3]), "=&v"(t0), "=&v"(t1), "=&v"(t2), "=&v"(t3), "=&v"(t4), "=&v"(t5)
      : "v"(pb[0][0]), "v"(pb[0][1]), "v"(a[0]), "v"(a[1])
      : "memory");
}

template <int KIND>
DI void attn_item(const Params& p, int b, int hh, int qt, char* smem, float lam, int nb, int nhh) {
  constexpr int DQK = KIND == 2 ? 192 : KIND == 3 ? 128 : 64;
  constexpr int DV = KIND == 1 ? 64 : 128;
  constexpr int KRB = KIND == 0 ? 256 : KIND == 1 ? 128 : KIND == 2 ? 384 : 256;
  constexpr int NQ = KIND == 0 ? 128 : 256;
  constexpr int NMB = KIND == 2 ? 1 : 2;
  constexpr int KCH = KRB / 16, NKC = 64 * KCH / 512, NVC = DV * 8 / 512, NC = DV / 32;
  constexpr int LDQ = KIND == 0 ? 2048 : KIND == 1 ? 1280 : 1536;
  constexpr int LDK = KIND == 0 ? 2048 : KIND == 1 ? 1280 : KIND == 2 ? 1024 : 1536;
  const int tid = tidx(), lane = tid & 63, wave = tid >> 6, h = lane >> 5, ql = lane & 31;
  const int grp = KIND == 0 ? (wave >> 2) : 0;
  const int wq = KIND == 0 ? (wave & 3) : wave;
  const int tokb = b * TPB;
  const int q0 = qt * NQ;
  const bool isctx = q0 < CTXL;
  int lo = 0, hi = 0;
  if (!isctx) {
    if (KIND == 1) {
      int s = q0 - CTXL;
      int a = s - 128; if (a < 0) a = 0;
      int e = s + 383; if (e > SEQ - 1) e = SEQ - 1;
      lo = (CTXL + a) >> 6; hi = ((CTXL + e) >> 6) + 1;
    } else { lo = 4; hi = 36; }
  }
  const int ntiles = 4 + (hi - lo);
  const float sl2 = (KIND == 2 ? 0.07216878364870322f : KIND == 3 ? 0.08838834764831845f : 0.125f) * 1.4426950408889634f;

  const u16* Ksrc; const u16* Vth; int qoff, aoff;
  if (KIND == 0) { qoff = (2 * hh + grp) * 64; Ksrc = p.QK + 1024 + hh * 128; Vth = p.Vt + (size_t)(hh * 128) * T; aoff = hh * 128; }
  else if (KIND == 1) { qoff = hh * 64; Ksrc = p.QK + 1024 + (hh >> 2) * 64; Vth = p.Vt + (size_t)((hh >> 2) * 64) * T; aoff = hh * 64; }
  else if (KIND == 2) { qoff = hh * 192; Ksrc = p.QK + (size_t)T * 1536 + hh * 128; Vth = p.Vt + (size_t)(hh * 128) * T; aoff = hh * 128; }
  else { qoff = hh * 128; Ksrc = p.QK + 1024 + (hh >> 1) * 128; Vth = p.Vt + (size_t)((hh >> 1) * 128) * T; aoff = hh * 128; }
  const int qtok = tokb + q0 + wq * 32 + ql;

  bf16x8 qf[DQK / 16];
  {
    const u16* qrow = p.QK + (size_t)qtok * LDQ + qoff;
#pragma unroll
    for (int ks = 0; ks < DQK / 16; ++ks) qf[ks] = *(const bf16x8*)(qrow + 16 * ks + 8 * h);
  }
  u32x4 rk[NKC], rv[NVC];
  auto gload = [&](int kt) {
    const int key0 = tokb + kt * 64;
#pragma unroll
    for (int i = 0; i < NKC; ++i) {
      int id = tid + 512 * i; int row = id / KCH, ch = id - row * KCH;
      const u16* src = (KIND == 2 && ch >= 16) ? p.KR + (size_t)(key0 + row) * 64 + (ch - 16) * 8
                                               : Ksrc + (size_t)(key0 + row) * LDK + ch * 8;
      rk[i] = *(const u32x4*)src;
    }
#pragma unroll
    for (int i = 0; i < NVC; ++i) {
      int id = tid + 512 * i; int row = id >> 3, ch = id & 7;
      rv[i] = *(const u32x4*)(Vth + (size_t)row * T + key0 + ch * 8);
    }
  };
  auto sstore = [&](int buf) {
    char* sK = smem + buf * 40960; char* sV = sK + 24576;
#pragma unroll
    for (int i = 0; i < NKC; ++i) {
      int id = tid + 512 * i; int row = id / KCH, ch = id - row * KCH;
      *(u32x4*)(sK + kswz<KRB>(row, ch)) = rk[i];
    }
#pragma unroll
    for (int i = 0; i < NVC; ++i) {
      int id = tid + 512 * i; int row = id >> 3, ch = id & 7;
      *(u32x4*)(sV + swz128(row, ch)) = rv[i];
    }
  };
  f32x16 oacc[NC];
#pragma unroll
  for (int c = 0; c < NC; ++c)
#pragma unroll
    for (int r = 0; r < 16; ++r) oacc[c][r] = 0.f;
  float m = -1e30f, l = 0.f;
  const int prow = (ql & 3) | ((ql & 4) << 1) | ((ql & 8) >> 1) | (ql & 16);
  const unsigned lds0 = (unsigned)(size_t)smem;
  const int qpos = q0 - CTXL + wq * 32 + ql;

  gload(0); sstore(0); __syncthreads();
#pragma unroll 1
  for (int ti = 0; ti < ntiles; ++ti) {
    const int kt = ti < 4 ? ti : lo + ti - 4;
    if (ti + 1 < ntiles) gload(ti + 1 < 4 ? ti + 1 : lo + ti + 1 - 4);
    const char* sK = smem + (ti & 1) * 40960; const char* sV = sK + 24576;
    const bool domask = (KIND == 1) && !isctx && kt >= 4;
#pragma unroll
    for (int hb = 0; hb < 2; hb += NMB) {
      f32x16 sacc[NMB];
#pragma unroll
      for (int mb = 0; mb < NMB; ++mb)
#pragma unroll
        for (int r = 0; r < 16; ++r) sacc[mb][r] = 0.f;
      {
        const unsigned kbase = lds0 + (unsigned)((ti & 1) * 40960) + (unsigned)((prow + 32 * hb) * KRB);
        if (KIND == 0) {
          unsigned ka[4];
#pragma unroll
          for (int ks = 0; ks < 4; ++ks) ka[ks] = kbase + ((unsigned)((8 * grp + 2 * ks + h) ^ (prow & 15)) << 4);
          qk_asm_a(*(f32x16(*)[2])&sacc, *(const bf16x8(*)[4])&qf, ka);
        } else if (KIND == 1) {
          unsigned ka[4];
#pragma unroll
          for (int ks = 0; ks < 4; ++ks) ka[ks] = kbase + ((unsigned)((2 * ks + h) ^ ((prow >> 1) & 7)) << 4);
          qk_asm_b(*(f32x16(*)[2])&sacc, *(const bf16x8(*)[4])&qf, ka);
        } else if (KIND == 2) {
          unsigned ka[4];
#pragma unroll
          for (int b4 = 0; b4 < 4; ++b4) ka[b4] = kbase + ((unsigned)((2 * b4 + h) ^ ((prow >> 1) & 7)) << 4);
          qk_asm_c(*(f32x16(*)[1])&sacc, *(const bf16x8(*)[12])&qf, ka);
        } else {
          unsigned ka[8];
#pragma unroll
          for (int ks = 0; ks < 8; ++ks) ka[ks] = kbase + ((unsigned)((2 * ks + h) ^ (prow & 15)) << 4);
          qk_asm_d(*(f32x16(*)[2])&sacc, *(const bf16x8(*)[8])&qf, ka);
        }
      }
      float mx = -1e30f;
      if (domask) {
#pragma unroll
        for (int mb = 0; mb < NMB; ++mb)
#pragma unroll
          for (int r = 0; r < 16; ++r) {
            int kpos = kt * 64 + 32 * (hb + mb) + 16 * (r >> 3) + 8 * h + (r & 7) - CTXL;
            int d = qpos - kpos; if (d < 0) d = -d;
            if (d > 128) sacc[mb][r] = -1e30f;
          }
      }
#pragma unroll
      for (int mb = 0; mb < NMB; ++mb)
#pragma unroll
        for (int r = 0; r < 16; r += 2) mx = fmaxf(mx, fmaxf(sacc[mb][r], sacc[mb][r + 1]));
      mx = xmax32(mx);
      const float mn = fmaxf(m, mx);
      const float nms = -mn * sl2;
      const float alpha = __builtin_amdgcn_exp2f((m - mn) * sl2);
      float sum = 0.f;
#pragma unroll
      for (int mb = 0; mb < NMB; ++mb)
#pragma unroll
        for (int r = 0; r < 16; ++r) { float pv = __builtin_amdgcn_exp2f(fmaf(sacc[mb][r], sl2, nms)); sacc[mb][r] = pv; sum += pv; }
      sum = xsum32(sum);
      l = l * alpha + sum; m = mn;
      if (__any(alpha != 1.f)) {
#pragma unroll
        for (int c = 0; c < NC; ++c)
#pragma unroll
          for (int r = 0; r < 16; ++r) oacc[c][r] *= alpha;
      }
      bf16x8 pb[NMB][2];
#pragma unroll
      for (int mb = 0; mb < NMB; ++mb)
#pragma unroll
        for (int s = 0; s < 2; ++s)
          pb[mb][s] = pack8(sacc[mb][8 * s], sacc[mb][8 * s + 1], sacc[mb][8 * s + 2], sacc[mb][8 * s + 3],
                            sacc[mb][8 * s + 4], sacc[mb][8 * s + 5], sacc[mb][8 * s + 6], sacc[mb][8 * s + 7]);
      {
        const unsigned vbase = lds0 + (unsigned)((ti & 1) * 40960 + 24576) + (unsigned)(ql * 128);
        unsigned va[NMB * 2];
#pragma unroll
        for (int mb = 0; mb < NMB; ++mb)
#pragma unroll
          for (int s = 0; s < 2; ++s) va[mb * 2 + s] = vbase + ((unsigned)((4 * (hb + mb) + 2 * s + h) ^ ((ql >> 1) & 7)) << 4);
        if (KIND == 1) pv_asm_22(*(f32x16(*)[2])&oacc, *(const bf16x8(*)[2][2])&pb, *(const unsigned(*)[4])&va);
        else if (KIND == 2) pv_asm_41(*(f32x16(*)[4])&oacc, *(const bf16x8(*)[1][2])&pb, *(const unsigned(*)[2])&va);
        else pv_asm_42(*(f32x16(*)[4])&oacc, *(const bf16x8(*)[2][2])&pb, *(const unsigned(*)[4])&va);
      }
    }
    if (ti + 1 < ntiles) sstore((ti + 1) & 1);
    __syncthreads();
  }
  unsigned pfa = 0u;
  if (nb >= 0) {
    const u16* K2; const u16* V2;
    if (KIND == 0) { K2 = p.QK + 1024 + nhh * 128; V2 = p.Vt + (size_t)(nhh * 128) * T; }
    else if (KIND == 1) { K2 = p.QK + 1024 + (nhh >> 2) * 64; V2 = p.Vt + (size_t)((nhh >> 2) * 64) * T; }
    else if (KIND == 2) { K2 = p.QK + (size_t)T * 1536 + nhh * 128; V2 = p.Vt + (size_t)(nhh * 128) * T; }
    else { K2 = p.QK + 1024 + (nhh >> 1) * 128; V2 = p.Vt + (size_t)((nhh >> 1) * 128) * T; }
    constexpr int LK = KRB / 128;
    const int tokb2 = nb * TPB;
    const char* pp = nullptr;
    if (tid < 64 * LK) {
      const int row = tid / LK, ln = tid - row * LK;
      if (KIND == 2 && ln == 2) pp = (const char*)(p.KR + (size_t)(tokb2 + row) * 64);
      else pp = (const char*)(K2 + (size_t)(tokb2 + row) * LDK + ln * 64);
    } else if (tid - 64 * LK < DV) {
      pp = (const char*)(V2 + (size_t)(tid - 64 * LK) * T + tokb2);
    }
    if (pp) asm volatile("global_load_dword %0, %1, off" : "=v"(pfa) : "v"(pp) : "memory");
  }
  float den = l;
  if (KIND == 1) den += __builtin_amdgcn_exp2f(p.b_sink[hh] * 1.4426950408889634f - m * sl2);
  const float inv = 1.f / den;
  constexpr int ORS = DV * 2 + 16;
  char* sO = smem + (KIND == 0 ? 65536 : 40960) + (KIND == 0 ? wq : wave) * (32 * ORS);
  if (KIND != 0) {
#pragma unroll
    for (int c = 0; c < NC; ++c)
#pragma unroll
      for (int r4 = 0; r4 < 4; ++r4) {
        int d = 32 * c + 8 * r4 + 4 * h;
        *(u32x2*)(sO + ql * ORS + d * 2) = u32x2{pack2(oacc[c][4 * r4] * inv, oacc[c][4 * r4 + 1] * inv),
                                                 pack2(oacc[c][4 * r4 + 2] * inv, oacc[c][4 * r4 + 3] * inv)};
      }
  } else {
    float* sX = (float*)smem;
    if (grp == 1) {
#pragma unroll
      for (int c = 0; c < NC; ++c)
#pragma unroll
        for (int r = 0; r < 16; ++r) sX[((wq * 4 + c) * 16 + r) * 64 + lane] = oacc[c][r] * inv;
    }
    __syncthreads();
    if (grp == 0) {
      float ss = 0.f;
#pragma unroll
      for (int c = 0; c < NC; ++c)
#pragma unroll
        for (int r = 0; r < 16; ++r) {
          float dv = oacc[c][r] * inv - lam * sX[((wq * 4 + c) * 16 + r) * 64 + lane];
          oacc[c][r] = dv; ss += dv * dv;
        }
      ss += __shfl_xor(ss, 32);
      const float rstd = rsqrtf(ss * (1.f / 128.f) + EPS) * 0.8f;
#pragma unroll
      for (int c = 0; c < NC; ++c)
#pragma unroll
        for (int r4 = 0; r4 < 4; ++r4) {
          int d = 32 * c + 8 * r4 + 4 * h;
          float4 g = *(const float4*)(p.a_subln + d);
          *(u32x2*)(sO + ql * ORS + d * 2) = u32x2{pack2(oacc[c][4 * r4] * rstd * g.x, oacc[c][4 * r4 + 1] * rstd * g.y),
                                                   pack2(oacc[c][4 * r4 + 2] * rstd * g.z, oacc[c][4 * r4 + 3] * rstd * g.w)};
        }
    }
  }
  if (KIND != 0 || grp == 0) {
    __threadfence_block();
    u16* obase = p.AO + (size_t)(tokb + q0 + wq * 32) * DM + aoff;
    constexpr int CPR = DV / 8;
#pragma unroll
    for (int k = 0; k < 32 * CPR / 64; ++k) {
      const int idx = k * 64 + lane;
      const int row = idx / CPR, ch = idx - row * CPR;
      const u32x4 v = *(const u32x4*)(sO + row * ORS + ch * 16);
      *(u32x4*)(obase + (size_t)row * DM + ch * 8) = v;
    }
  }
  asm volatile("s_waitcnt vmcnt(0)" :: "v"(pfa) : "memory");
  if (KIND == 0) __syncthreads();
}

template <int KIND>
DI void attn_phase_mfma(const Params& p, bool lat_only, char* smem) {
  constexpr int NH = KIND == 1 ? 16 : 8;
  constexpr int QTC = KIND == 0 ? 2 : 1, QTL = KIND == 0 ? 16 : 8;
  float lam = 0.f;
  if (KIND == 0) {
    const int lane = tidx() & 63;
    float s1 = wave_sum(p.a_lq1[lane] * p.a_lk1[lane]);
    float s2 = wave_sum(p.a_lq2[lane] * p.a_lk2[lane]);
    lam = __expf(s1) - __expf(s2) + 0.2f;
  }
  const int n_lat = NBATCH * NH * QTL, n_ctx = lat_only ? 0 : NBATCH * NH * QTC;
#pragma unroll 1
  for (int i = blockIdx.x; i < n_lat + n_ctx; i += gridDim.x) {
    int b, hh, qt;
    if (i < n_lat) { b = i & 7; int j = i >> 3; hh = j / QTL; qt = QTC + (j - hh * QTL); }
    else { int i2 = i - n_lat; b = i2 & 7; int j = i2 >> 3; hh = j / QTC; qt = j - hh * QTC; }
    int nb = -1, nhh = 0;
    {
      const int i3 = i + gridDim.x;
      if (i3 < n_lat + n_ctx) {
        if (i3 < n_lat) { nb = i3 & 7; nhh = (i3 >> 3) / QTL; }
        else { const int i4 = i3 - n_lat; nb = i4 & 7; nhh = (i4 >> 3) / QTC; }
      }
    }
    attn_item<KIND>(p, b, hh, qt, smem, lam, nb, nhh);
  }
}


#define XB_TMO      128
#define XB_XCNT(j)  (256  + 64 * (j))
#define XB_XSUB(j)  (1280 + 64 * (j))
#define XB_XGEN(j)  (2304 + 64 * (j))
#define XB_TOP      3328
#define XB_TOPGEN   3392
#define XCD_BAR_WORDS 3456
#define XB_SPIN_CAP (1u << 18)
#define LAS __attribute__((address_space(3)))
DI unsigned xb_ld(unsigned* p)              { return __hip_atomic_load(p, __ATOMIC_RELAXED, __HIP_MEMORY_SCOPE_AGENT); }
DI unsigned xb_add(unsigned* p, unsigned v) { return __hip_atomic_fetch_add(p, v, __ATOMIC_RELAXED, __HIP_MEMORY_SCOPE_AGENT); }
DI unsigned xb_xcc_id() { return (unsigned)__builtin_amdgcn_s_getreg((3 << 11) | 20) & 0xFu; }
#define XB_SPIN(cond, bar) do { unsigned _sp = 0; while (cond) { __builtin_amdgcn_s_sleep(1); \
    if ((++_sp & 255u) == 0u) { if (xb_ld(&(bar)[XB_TMO])) break; if (_sp > XB_SPIN_CAP) { atomicAdd(&(bar)[XB_TMO], 1u); break; } } } } while (0)
struct XcdBarrier { unsigned* bar; unsigned x; volatile LAS unsigned* st; };
DI XcdBarrier xcd_barrier_post(unsigned* bar, volatile LAS unsigned* st) {
    XcdBarrier b; b.bar = bar; b.x = xb_xcc_id(); b.st = st;
    if (threadIdx.x == 0) (void)xb_add(&bar[XB_XCNT(b.x)], 1u);
    return b;
}
DI void xcd_barrier_complete(unsigned* bar, unsigned x, unsigned& nloc, unsigned& nx) {
    const unsigned G = gridDim.x * gridDim.y * gridDim.z;
    unsigned sum, cnt, mine, sp = 0u;
    for (;;) {
        sum = 0u; cnt = 0u; mine = 0u;
#pragma unroll
        for (unsigned j = 0; j < 16; ++j) { const unsigned c = xb_ld(&bar[XB_XCNT(j)]); sum += c; cnt += (c > 0u) ? 1u : 0u; mine = (j == x) ? c : mine; }
        if (sum == G) break;
        __builtin_amdgcn_s_sleep(1);
        if ((++sp & 255u) == 0u) { if (xb_ld(&bar[XB_TMO])) break; if (sp > XB_SPIN_CAP) { atomicAdd(&bar[XB_TMO], 1u); break; } }
    }
    nloc = mine > 0u ? mine : 1u; nx = cnt > 0u ? cnt : 1u;
}
DI void xcd_barrier(const XcdBarrier& b) {
    asm volatile("s_waitcnt vmcnt(0)" ::: "memory");
    __syncthreads();
    if (threadIdx.x == 0) {
        unsigned* bar = b.bar;
        __builtin_amdgcn_s_waitcnt(0);
        unsigned nloc = b.st[0], nx = b.st[1];
        if (nloc == 0u) { xcd_barrier_complete(bar, b.x, nloc, nx); b.st[0] = nloc; b.st[1] = nx; }
        const unsigned old = xb_add(&bar[XB_XSUB(b.x)], 1u);
        const unsigned gen = old / nloc;
        if (old + 1u == (gen + 1u) * nloc) {
            __builtin_amdgcn_fence(__ATOMIC_RELEASE, "agent");
            asm volatile("s_waitcnt vmcnt(0)" ::: "memory");
            const unsigned og = xb_add(&bar[XB_TOP], 1u);
            const unsigned tg = og / nx;
            if (og + 1u == (tg + 1u) * nx) xb_add(&bar[XB_TOPGEN], 1u);
            else XB_SPIN(xb_ld(&bar[XB_TOPGEN]) == tg, bar);
            __builtin_amdgcn_fence(__ATOMIC_ACQUIRE, "agent");
            xb_add(&bar[XB_XGEN(b.x)], 1u);
            asm volatile("s_waitcnt vmcnt(0)" ::: "memory");
        } else {
            XB_SPIN(xb_ld(&bar[XB_XGEN(b.x)]) == gen, bar);
            __builtin_amdgcn_fence(__ATOMIC_ACQUIRE, "agent");
            asm volatile("s_waitcnt vmcnt(0)" ::: "memory");
        }
    }
    __syncthreads();
}

__global__ void __launch_bounds__(NTHR) mega(Params p) {
  __shared__ __attribute__((aligned(16))) char smem[SMEM_BYTES];
  cg::grid_group grid = cg::this_grid();
  __shared__ uint4 xb_words;
  if (threadIdx.x == 0) xb_words = make_uint4(0u, 0u, 0u, 0u);
  __syncthreads();
  const XcdBarrier xb = xcd_barrier_post(p.bar, (volatile LAS unsigned*)&xb_words);
  for (int ph = p.ph_lo; ph < p.ph_hi; ++ph) {
    if (ph > p.ph_lo) { if (p.ph_hi < 0) grid.sync(); else xcd_barrier(xb); }
    const int code = p.prog[ph];
    const int layer = (code >> 4) & 15, op = code & 15;
    const bool last = layer == 3;
    const float gs = (code & 256) ? 0.f : 1.f;
    switch (op) {
      case OP_PRO: prologue(p, smem); break;
      case OP_NORM1: norm_phase(p, layer, 0, false); break;
      case OP_QKV: qkv_phase(p, layer, smem); break;
      case OP_MLA_DOWN: mla_down_phase(p, smem); break;
      case OP_MLA_UP: mla_up_phase(p, smem); break;
      case OP_ATTN:
        if (layer == 0) attn_phase_mfma<0>(p, false, smem);
        else if (layer == 1) attn_phase_mfma<1>(p, false, smem);
        else if (layer == 2) attn_phase_mfma<2>(p, false, smem);
        else attn_phase_mfma<3>(p, true, smem);
        break;
      case OP_OPROJ: resid_gemm_phase(p, layer, p.AO, DM, DM, p.Wo[layer], 2, last, smem, gs); break;
      case OP_NORM2: norm_phase(p, layer, 1, last); break;
      case OP_FFN_UP: ffn_up_phase(p, layer, last, smem); break;
      case OP_FFN_DOWN: resid_gemm_phase(p, layer, p.G, DFF, DFF, p.Wdn[layer], 5, last, smem, gs); break;
      case OP_FINAL: final_phase(p); break;
      default: break;
    }
  }
}

static inline size_t al256(size_t x) { return (x + 255) & ~(size_t)255; }

extern "C" void kernel_launch(void* const* d_in, const int* in_sizes, int n_in, void* d_out, int out_size, void* d_ws,
                              size_t ws_size, hipStream_t stream) {
  Params p;
  memset(&p, 0, sizeof(p));
  auto F = [&](int i) { return (const float*)d_in[i]; };
  p.x = F(0); p.c = F(1); p.ctx = F(2); p.c_ctx = F(3); p.ada_w = F(4); p.ada_b = F(5); p.norm1_g = F(6); p.norm2_g = F(7);
  const float* ffn_up = F(8); p.conv_w = F(9); p.conv_b = F(10); const float* ffn_down = F(11);
  const float* a_w_qkv = F(12); const float* a_w_o = F(13);
  p.a_lq1 = F(14); p.a_lk1 = F(15); p.a_lq2 = F(16); p.a_lk2 = F(17); p.a_subln = F(18);
  const float* b_w_qkv = F(19); const float* b_w_o = F(20); p.b_sink = F(21);
  const float* c_w_down = F(22); const float* c_qg = F(23); const float* c_kvg = F(24);
  const float* c_w_uq = F(25); const float* c_w_ukv = F(26); const float* c_w_o = F(27);
  const float* d_w_qkv = F(28); p.d_qg = F(29); p.d_kg = F(30); const float* d_w_o = F(31);
  p.final_g = F(32);
  p.out = (float*)d_out;

  char* ws = (char*)d_ws; size_t off = 0;
  auto take = [&](size_t bytes) { char* r = ws + off; off = al256(off + bytes); return r; };
  p.bar = (unsigned*)take((size_t)XCD_BAR_WORDS * 4);
  p.Rctx = (float*)take((size_t)NBATCH * CTXL * DM * 4);
  p.MOD = (float*)take((size_t)4 * 9 * 6144 * 4);
  p.rope64 = (float*)take((size_t)131072 * 4);
  p.rope128 = (float*)take((size_t)262144 * 4);
  p.H = (u16*)take((size_t)T * DM * 2 + 4096);
  char* region = take((size_t)T * 2560 * 2 + (size_t)T * 1024 * 2 * 2 + (size_t)T * 768 * 2 + (size_t)T * 64 * 2);
  p.QK = (u16*)region;
  p.Vt = p.QK + (size_t)T * 2560;
  p.AO = p.Vt + (size_t)T * 1024;
  p.T1 = p.AO + (size_t)T * 1024;
  p.KR = p.T1 + (size_t)T * 768;
  p.G = (u16*)region;
  for (int l = 0; l < 4; ++l) {
    p.Wup[l] = (u16*)take((size_t)5632 * 1024 * 2);
    p.Wdn[l] = (u16*)take((size_t)1024 * 2816 * 2);
    p.Wo[l] = (u16*)take((size_t)1024 * 1024 * 2);
  }
  p.Wa_qkv = (u16*)take((size_t)3072 * 1024 * 2);
  p.Wb_qkv = (u16*)take((size_t)1536 * 1024 * 2);
  p.Wc_d = (u16*)take((size_t)768 * 1024 * 2);
  p.Wc_uq = (u16*)take((size_t)1536 * 384 * 2);
  p.Wc_uk = (u16*)take((size_t)1024 * 256 * 2);
  p.Wc_uv = (u16*)take((size_t)1024 * 256 * 2);
  p.Wd_qkv = (u16*)take((size_t)2048 * 1024 * 2);
  if (off > ws_size) { fprintf(stderr, "workspace too small: need %zu have %zu\n", off, ws_size); return; }

  int nj = 0, tiles = 0;
  auto job = [&](const float* src, u16* dst, const float* g, int K, int N, int ld, int grp, int gstride, int o, int mode) {
    Job& j = p.jobs[nj++];
    j.src = src; j.dst = dst; j.g = g; j.K = K; j.N = N; j.ld = ld; j.grp = grp; j.gstride = gstride; j.off = o; j.mode = mode; j.tile0 = tiles;
    tiles += (K / 64) * (N / 64);
  };
  const int BIG = 1 << 30;
  const float* wo_src[4] = {a_w_o, b_w_o, c_w_o, d_w_o};
  for (int l = 0; l < 4; ++l) {
    p.ltile[l] = tiles;
    if (l == 0) job(a_w_qkv, p.Wa_qkv, nullptr, 1024, 3072, 3072, BIG, 0, 0, 0);
    if (l == 1) job(b_w_qkv, p.Wb_qkv, nullptr, 1024, 1536, 1536, BIG, 0, 0, 0);
    if (l == 2) {
      job(c_w_down, p.Wc_d, nullptr, 1024, 768, 704, BIG, 0, 0, 2);
      job(c_w_uq, p.Wc_uq, c_qg, 384, 1536, 1536, BIG, 0, 0, 0);
      job(c_w_ukv, p.Wc_uk, c_kvg, 256, 1024, 2048, 128, 256, 0, 0);
      job(c_w_ukv, p.Wc_uv, c_kvg, 256, 1024, 2048, 128, 256, 128, 0);
    }
    if (l == 3) job(d_w_qkv, p.Wd_qkv, nullptr, 1024, 2048, 2048, BIG, 0, 0, 0);
    job(wo_src[l], p.Wo[l], nullptr, 1024, 1024, 1024, BIG, 0, 0, 0);
    job(ffn_up + (size_t)l * 1024 * 5632, p.Wup[l], nullptr, 1024, 5632, 5632, BIG, 0, 0, 1);
    job(ffn_down + (size_t)l * 2816 * 1024, p.Wdn[l], nullptr, 2816, 1024, 1024, BIG, 0, 0, 0);
  }
  p.ltile[4] = tiles; p.ltile[5] = 0;
  p.njobs = nj; p.conv_tiles = tiles;

  int np = 0;
  p.prog[np++] = OP_PRO;
  for (int l = 0; l < 4; ++l) {
    p.prog[np++] = l * 16 + OP_NORM1;
    if (l == 2) { p.prog[np++] = l * 16 + OP_MLA_DOWN; p.prog[np++] = l * 16 + OP_MLA_UP; }
    else p.prog[np++] = l * 16 + OP_QKV;
    p.prog[np++] = l * 16 + OP_ATTN;
    p.prog[np++] = l * 16 + OP_OPROJ;
    p.prog[np++] = l * 16 + OP_NORM2;
    p.prog[np++] = l * 16 + OP_FFN_UP;
    p.prog[np++] = l * 16 + OP_FFN_DOWN;
  }
  p.prog[np++] = 3 * 16 + OP_FINAL;
#ifdef PROBE_DUP_OP
  {
    int tmp[48]; int n2 = 0;
    for (int i = 0; i < np; ++i) { tmp[n2++] = p.prog[i]; if ((p.prog[i] & 15) == PROBE_DUP_OP) tmp[n2++] = p.prog[i] | 256; }
    for (int i = 0; i < n2; ++i) p.prog[i] = tmp[i];
    np = n2;
  }
#endif
  p.nprog = np;

  static int grid_blocks = 0;
  if (!grid_blocks) {
    int dev = 0, cus = 0, per_cu = 0;
    hipGetDevice(&dev);
    hipDeviceGetAttribute(&cus, hipDeviceAttributeMultiprocessorCount, dev);
    hipOccupancyMaxActiveBlocksPerMultiprocessor(&per_cu, mega, NTHR, 0);
    if (per_cu < 1) per_cu = 1;
    grid_blocks = cus * per_cu;
  }
#if MULTI_LAUNCH
  for (int ph = 0; ph < np; ++ph) {
    p.ph_lo = ph; p.ph_hi = ph + 1;
    hipLaunchKernelGGL(mega, dim3(grid_blocks), dim3(NTHR), 0, stream, p);
  }
#else
  p.ph_lo = 0; p.ph_hi = np;
  hipMemsetAsync(p.bar, 0, (size_t)XCD_BAR_WORDS * 4, stream);
  void* args[] = {&p};
  hipError_t e = hipLaunchCooperativeKernel((void*)mega, dim3(grid_blocks), dim3(NTHR), args, 0, stream);
  if (e != hipSuccess) fprintf(stderr, "cooperative launch failed: %s (grid %d)\n", hipGetErrorString(e), grid_blocks);
#endif
}
```
